# Optimizing an MI355X kernel written in HIP

```python
import math
import jax, jax.numpy as jnp
from jax import lax
import numpy as np

D_MODEL = 1024
BATCH = 8
SEQ = 2048
DEPTH = 4
DEC_BATCH = 32
DEC_SEQ = 1
PAST_LEN = 16384
PAGE_SIZE = 128

D_MIX = D_MODEL
S5_WIDTH = D_MIX // 4
S5_GROUP = 16
S5_GROUPS = S5_WIDTH // S5_GROUP
S5_STATE = 64
S5_DT_MIN = 1e-3
S5_DT_MAX = 1e-1
MLA_HEADS = 8
MLA_NOPE = 64
MLA_ROPE = 32
MLA_V = 64
MLA_WIDTH = MLA_HEADS * MLA_V
MLA_Q_LORA = D_MODEL // 4
MLA_KV_LORA = D_MODEL // 8
MLA_SCALE = (MLA_NOPE + MLA_ROPE) ** -0.5
ROPE_THETA = 10000.0
GLA_HEADS = 4
GLA_WIDTH = D_MIX - S5_WIDTH - MLA_WIDTH
GLA_DV = GLA_WIDTH // GLA_HEADS
GLA_DK = GLA_DV // 2
GLA_GATE_RANK = 16
GLA_GATE_NORM = 16.0
GLA_CHUNK = 64
D_FF = 11 * D_MODEL // 4
CONV_W = 3
QBLOCK = 128
RMS_EPS = 1e-6
NEG_INF = -1e30
IN_SPLITS = (S5_WIDTH, MLA_Q_LORA, MLA_KV_LORA, MLA_ROPE, GLA_HEADS * GLA_DK, GLA_HEADS * GLA_DK, GLA_WIDTH, GLA_GATE_RANK, GLA_WIDTH)
D_IN = sum(IN_SPLITS)

kernel_name = 'hymba_style_s5_mla_gla_convglu_step'


def _rmsnorm(x, g):
    x32 = x.astype(jnp.float32)
    y = x32 * lax.rsqrt(jnp.mean(x32 * x32, axis=-1, keepdims=True) + RMS_EPS)
    return (y * g.astype(jnp.float32)).astype(x.dtype)


def _rope(x, pos):
    half = MLA_ROPE // 2
    inv = ROPE_THETA ** (-jnp.arange(half, dtype=jnp.float32) / half)
    ang = pos.astype(jnp.float32)[:, None] * inv[None, :]
    cos = jnp.cos(ang)[None, :, None, :]
    sin = jnp.sin(ang)[None, :, None, :]
    x32 = x.astype(jnp.float32)
    x1, x2 = x32[..., :half], x32[..., half:]
    return jnp.concatenate([x1 * cos - x2 * sin, x1 * sin + x2 * cos], axis=-1).astype(x.dtype)


def _s5_combine(e1, e2):
    a1, b1 = e1
    a2, b2 = e2
    return a1 * a2, a2 * b1 + b2


def _s5_mixer(u, h0, a_re, a_im, log_dt, b_re, b_im, c_re, c_im, d, w_glu, b_glu):
    bsz, s = u.shape[:2]
    u32 = u.astype(jnp.float32).reshape(bsz, s, S5_GROUPS, S5_GROUP)
    lam = lax.complex(a_re.astype(jnp.float32), a_im.astype(jnp.float32))
    dt = jnp.exp(log_dt.astype(jnp.float32))[:, None]
    a_bar = jnp.exp(lam * dt)
    b_c = lax.complex(b_re.astype(jnp.float32), b_im.astype(jnp.float32))
    b_bar = ((a_bar - 1.0) / lam)[..., None] * b_c
    bu = jnp.einsum('bsgc,gpc->bsgp', u32.astype(jnp.complex64), b_bar)
    bu = bu.at[:, 0].add(a_bar[None] * h0)
    a_seq = jnp.broadcast_to(a_bar, bu.shape)
    _, h = lax.associative_scan(_s5_combine, (a_seq, bu), axis=1)
    c_c = lax.complex(c_re.astype(jnp.float32), c_im.astype(jnp.float32))
    y = jnp.real(jnp.einsum('bsgp,gcp->bsgc', h, c_c)) + d.astype(jnp.float32).reshape(S5_GROUPS, S5_GROUP) * u32
    y = jax.nn.gelu(y.reshape(bsz, s, S5_WIDTH))
    out = y * jax.nn.sigmoid(y @ w_glu.astype(jnp.float32) + b_glu.astype(jnp.float32))
    return out.astype(u.dtype), h[:, -1]


def _attn_block(q_lat, q_pe, q_pos, ckv, kpe, k_pos):
    s = (jnp.einsum('bqhl,bkl->bhqk', q_lat, ckv, preferred_element_type=jnp.float32)
         + jnp.einsum('bqhr,bkr->bhqk', q_pe, kpe, preferred_element_type=jnp.float32))
    mask = (k_pos[None, :] <= q_pos[:, None])[None, None]
    s = jnp.where(mask, s * MLA_SCALE, NEG_INF)
    p = jax.nn.softmax(s, axis=-1).astype(ckv.dtype)
    return jnp.einsum('bhqk,bkl->bqhl', p, ckv)


def _mla_attend(q_lat, q_pe, q_pos, ckv, kpe, k_pos):
    bsz, sq, h, l = q_lat.shape
    if sq > QBLOCK and sq % QBLOCK == 0:
        nb = sq // QBLOCK
        qb = q_lat.reshape(bsz, nb, QBLOCK, h, l).swapaxes(0, 1)
        pb = q_pe.reshape(bsz, nb, QBLOCK, h, MLA_ROPE).swapaxes(0, 1)
        posb = q_pos.reshape(nb, QBLOCK)
        out = lax.map(lambda a: _attn_block(a[0], a[1], a[2], ckv, kpe, k_pos), (qb, pb, posb))
        return out.swapaxes(0, 1).reshape(bsz, sq, h, l)
    return _attn_block(q_lat, q_pe, q_pos, ckv, kpe, k_pos)


def _mla_mixer(cq, ckv_raw, kpe_raw, pos, past, q_norm_g, w_qb, kv_norm_g, w_uk, w_uv):
    bsz, s = cq.shape[:2]
    q = (_rmsnorm(cq, q_norm_g) @ w_qb).reshape(bsz, s, MLA_HEADS, MLA_NOPE + MLA_ROPE)
    q_lat = jnp.einsum('bshn,lhn->bshl', q[..., :MLA_NOPE], w_uk)
    q_pe = _rope(q[..., MLA_NOPE:], pos)
    ckv = _rmsnorm(ckv_raw, kv_norm_g)
    kpe = _rope(kpe_raw[:, :, None, :], pos)[:, :, 0]
    if past is None:
        keys_ckv, keys_kpe, k_pos = ckv, kpe, pos
    else:
        past_ckv, past_kpe, past_pos = past
        keys_ckv = jnp.concatenate([past_ckv.astype(ckv.dtype), ckv], axis=1)
        keys_kpe = jnp.concatenate([past_kpe.astype(kpe.dtype), kpe], axis=1)
        k_pos = jnp.concatenate([past_pos, pos])
    o_lat = _mla_attend(q_lat, q_pe, pos, keys_ckv, keys_kpe, k_pos)
    o = jnp.einsum('bshl,lhv->bshv', o_lat, w_uv).reshape(bsz, s, MLA_WIDTH)
    return o, ckv, kpe


def _gla_chunked(q, k, v, logg, s0):
    bsz, s, h, dk = q.shape
    dv = v.shape[-1]
    c = math.gcd(s, GLA_CHUNK)
    n = s // c
    q = q.reshape(bsz, n, c, h, dk)
    k = k.reshape(bsz, n, c, h, dk)
    v = v.reshape(bsz, n, c, h, dv)
    b = jnp.cumsum(logg.reshape(bsz, n, c, h, dk), axis=2)
    b_last = b[:, :, -1:]
    qe = q * jnp.exp(b)
    ke = k * jnp.exp(-b)
    causal = jnp.tril(jnp.ones((c, c), dtype=bool))
    att = jnp.where(causal, jnp.einsum('bnihd,bnjhd->bnhij', qe, ke), 0.0)
    o_intra = jnp.einsum('bnhij,bnjhv->bnihv', att, v)
    u = jnp.einsum('bnjhd,bnjhv->bnhdv', k * jnp.exp(b_last - b), v)
    decay = jnp.exp(b_last[:, :, 0])

    def step(state, xs):
        dec, uc = xs
        return dec[..., None] * state + uc, state

    s_fin, s_prev = lax.scan(step, s0, (jnp.moveaxis(decay, 1, 0), jnp.moveaxis(u, 1, 0)))
    o_inter = jnp.einsum('bnihd,nbhdv->bnihv', qe, s_prev)
    return (o_intra + o_inter).reshape(bsz, s, h, dv), s_fin


def _gla_mixer(gq, gk, gv, glow, gr, s0, w_gate, b_gate, norm_g):
    bsz, s = gq.shape[:2]
    logg = jax.nn.log_sigmoid((glow @ w_gate + b_gate).astype(jnp.float32)) / GLA_GATE_NORM
    q = gq.astype(jnp.float32).reshape(bsz, s, GLA_HEADS, GLA_DK) * (GLA_DK ** -0.5)
    k = gk.astype(jnp.float32).reshape(bsz, s, GLA_HEADS, GLA_DK)
    v = gv.astype(jnp.float32).reshape(bsz, s, GLA_HEADS, GLA_DV)
    o, s_fin = _gla_chunked(q, k, v, logg.reshape(bsz, s, GLA_HEADS, GLA_DK), s0)
    o = _rmsnorm(o, norm_g.reshape(GLA_HEADS, GLA_DV)).reshape(bsz, s, GLA_WIDTH)
    out = o * jax.nn.silu(gr.astype(jnp.float32))
    return out.astype(gq.dtype), s_fin


def _conv_glu(x, buf, g, w_in, conv_w, conv_b, w_out):
    s = x.shape[1]
    hv = _rmsnorm(x, g) @ w_in
    val, gate = hv[..., :D_FF], hv[..., D_FF:]
    full = jnp.concatenate([buf.astype(gate.dtype), gate], axis=1)
    conv = conv_b + sum(conv_w[i] * full[:, i:i + s] for i in range(CONV_W))
    out = (jax.nn.gelu(conv) * val) @ w_out
    return out, full[:, -(CONV_W - 1):]


def _layer(x, pos, past, s5_h0, gla_s0, conv_buf, lw):
    h = _rmsnorm(x, lw['norm_mix_g'])
    p = h @ lw['w_in']
    cuts = np.cumsum(IN_SPLITS)[:-1].tolist()
    u_s5, cq, ckv_raw, kpe_raw, gq, gk, gv, glow, gr = jnp.split(p, cuts, axis=-1)
    o_s5, s5_h = _s5_mixer(u_s5, s5_h0, lw['s5_a_re'], lw['s5_a_im'], lw['s5_log_dt'], lw['s5_b_re'], lw['s5_b_im'],
                           lw['s5_c_re'], lw['s5_c_im'], lw['s5_d'], lw['s5_w_glu'], lw['s5_b_glu'])
    o_mla, ckv, kpe = _mla_mixer(cq, ckv_raw, kpe_raw, pos, past, lw['mla_q_norm_g'], lw['mla_w_qb'],
                                 lw['mla_kv_norm_g'], lw['mla_w_uk'], lw['mla_w_uv'])
    o_gla, gla_s = _gla_mixer(gq, gk, gv, glow, gr, gla_s0, lw['gla_w_gate'], lw['gla_b_gate'], lw['gla_norm_g'])
    mix = jnp.concatenate([o_s5, o_mla.astype(x.dtype), o_gla], axis=-1) @ lw['w_out']
    x = x + mix
    f, new_buf = _conv_glu(x, conv_buf, lw['norm_ffn_g'], lw['w_ffn_in'], lw['ffn_conv_w'], lw['ffn_conv_b'], lw['w_ffn_out'])
    x = x + f
    s5_out = jnp.stack([jnp.real(s5_h), jnp.imag(s5_h)], axis=-1)
    return x, ckv, kpe, s5_out, gla_s, new_buf


def setup_inputs(seed: int = 0) -> dict:
    key = jax.random.key(seed)
    ks = jax.random.split(key, 36)
    f32 = jnp.float32
    n_pages = PAST_LEN // PAGE_SIZE
    n_pool = (DEC_BATCH * n_pages * 5) // 4

    def nrm(i, shape, scale=1.0):
        return jax.random.normal(ks[i], shape, f32) * scale

    def gain(i, shape):
        return 1.0 + nrm(i, shape, 0.05)

    page_table = jax.random.permutation(ks[0], n_pool)[:DEC_BATCH * n_pages].reshape(DEC_BATCH, n_pages).astype(jnp.int32)
    return {
        'x_prompt': nrm(1, (BATCH, SEQ, D_MODEL)),
        'x_sample': nrm(2, (DEC_BATCH, DEC_SEQ, D_MODEL)),
        'cache_mla_ckv': nrm(3, (DEPTH, n_pool, PAGE_SIZE, MLA_KV_LORA)),
        'cache_mla_krope': nrm(4, (DEPTH, n_pool, PAGE_SIZE, MLA_ROPE)),
        'page_table': page_table,
        'state_s5': nrm(5, (DEPTH, DEC_BATCH, S5_GROUPS, S5_STATE, 2), 0.1),
        'state_gla': nrm(6, (DEPTH, DEC_BATCH, GLA_HEADS, GLA_DK, GLA_DV)),
        'state_ffn_conv': nrm(7, (DEPTH, DEC_BATCH, CONV_W - 1, D_FF)),
        'norm_mix_g': gain(8, (DEPTH, D_MODEL)),
        'w_in': nrm(9, (DEPTH, D_MODEL, D_IN), D_MODEL ** -0.5),
        's5_a_re': -0.5 + nrm(10, (DEPTH, S5_GROUPS, S5_STATE), 0.01),
        's5_a_im': math.pi * jnp.arange(S5_STATE, dtype=f32) + nrm(11, (DEPTH, S5_GROUPS, S5_STATE), 0.01),
        's5_log_dt': jax.random.uniform(ks[12], (DEPTH, S5_GROUPS), f32, math.log(S5_DT_MIN), math.log(S5_DT_MAX)),
        's5_b_re': nrm(13, (DEPTH, S5_GROUPS, S5_STATE, S5_GROUP), (2 * S5_GROUP) ** -0.5),
        's5_b_im': nrm(14, (DEPTH, S5_GROUPS, S5_STATE, S5_GROUP), (2 * S5_GROUP) ** -0.5),
        's5_c_re': nrm(15, (DEPTH, S5_GROUPS, S5_GROUP, S5_STATE), S5_STATE ** -0.5),
        's5_c_im': nrm(16, (DEPTH, S5_GROUPS, S5_GROUP, S5_STATE), S5_STATE ** -0.5),
        's5_d': nrm(17, (DEPTH, S5_WIDTH)),
        's5_w_glu': nrm(18, (DEPTH, S5_WIDTH, S5_WIDTH), S5_WIDTH ** -0.5),
        's5_b_glu': nrm(19, (DEPTH, S5_WIDTH), 0.01),
        'mla_q_norm_g': gain(20, (DEPTH, MLA_Q_LORA)),
        'mla_w_qb': nrm(21, (DEPTH, MLA_Q_LORA, MLA_HEADS * (MLA_NOPE + MLA_ROPE)), MLA_Q_LORA ** -0.5),
        'mla_kv_norm_g': gain(22, (DEPTH, MLA_KV_LORA)),
        'mla_w_uk': nrm(23, (DEPTH, MLA_KV_LORA, MLA_HEADS, MLA_NOPE), MLA_KV_LORA ** -0.5),
        'mla_w_uv': nrm(24, (DEPTH, MLA_KV_LORA, MLA_HEADS, MLA_V), MLA_KV_LORA ** -0.5),
        'gla_w_gate': nrm(25, (DEPTH, GLA_GATE_RANK, GLA_HEADS * GLA_DK), GLA_GATE_RANK ** -0.5),
        'gla_b_gate': nrm(26, (DEPTH, GLA_HEADS * GLA_DK), 0.01),
        'gla_norm_g': gain(27, (DEPTH, GLA_WIDTH)),
        'w_out': nrm(28, (DEPTH, D_MIX, D_MODEL), D_MIX ** -0.5),
        'norm_ffn_g': gain(29, (DEPTH, D_MODEL)),
        'w_ffn_in': nrm(30, (DEPTH, D_MODEL, 2 * D_FF), D_MODEL ** -0.5),
        'ffn_conv_w': nrm(31, (DEPTH, CONV_W, D_FF), CONV_W ** -0.5),
        'ffn_conv_b': nrm(32, (DEPTH, D_FF), 0.01),
        'w_ffn_out': nrm(33, (DEPTH, D_FF, D_MODEL), D_FF ** -0.5),
        'norm_final_g': gain(34, (D_MODEL,)),
    }


def reference(x_prompt, x_sample, cache_mla_ckv, cache_mla_krope, page_table, state_s5, state_gla, state_ffn_conv,
              norm_mix_g, w_in, s5_a_re, s5_a_im, s5_log_dt, s5_b_re, s5_b_im, s5_c_re, s5_c_im, s5_d, s5_w_glu, s5_b_glu,
              mla_q_norm_g, mla_w_qb, mla_kv_norm_g, mla_w_uk, mla_w_uv, gla_w_gate, gla_b_gate, gla_norm_g, w_out,
              norm_ffn_g, w_ffn_in, ffn_conv_w, ffn_conv_b, w_ffn_out, norm_final_g):
    bp, sp = x_prompt.shape[:2]
    bs, ss = x_sample.shape[:2]
    past_len = page_table.shape[1] * cache_mla_ckv.shape[2]
    pos_p = jnp.arange(sp)
    pos_s = past_len + jnp.arange(ss)
    past_pos = jnp.arange(past_len)
    xp, xd = x_prompt, x_sample
    ckv_p, kpe_p, s5_p, gla_p, conv_p = [], [], [], [], []
    ckv_s, kpe_s, s5_s, gla_s, conv_s = [], [], [], [], []
    for l in range(DEPTH):
        lw = dict(norm_mix_g=norm_mix_g[l], w_in=w_in[l], s5_a_re=s5_a_re[l], s5_a_im=s5_a_im[l], s5_log_dt=s5_log_dt[l],
                  s5_b_re=s5_b_re[l], s5_b_im=s5_b_im[l], s5_c_re=s5_c_re[l], s5_c_im=s5_c_im[l], s5_d=s5_d[l],
                  s5_w_glu=s5_w_glu[l], s5_b_glu=s5_b_glu[l], mla_q_norm_g=mla_q_norm_g[l], mla_w_qb=mla_w_qb[l],
                  mla_kv_norm_g=mla_kv_norm_g[l], mla_w_uk=mla_w_uk[l], mla_w_uv=mla_w_uv[l], gla_w_gate=gla_w_gate[l],
                  gla_b_gate=gla_b_gate[l], gla_norm_g=gla_norm_g[l], w_out=w_out[l], norm_ffn_g=norm_ffn_g[l],
                  w_ffn_in=w_ffn_in[l], ffn_conv_w=ffn_conv_w[l], ffn_conv_b=ffn_conv_b[l], w_ffn_out=w_ffn_out[l])
        xp, c1, k1, h1, g1, b1 = _layer(
            xp, pos_p, None,
            jnp.zeros((bp, S5_GROUPS, S5_STATE), jnp.complex64),
            jnp.zeros((bp, GLA_HEADS, GLA_DK, GLA_DV), jnp.float32),
            jnp.zeros((bp, CONV_W - 1, D_FF), xp.dtype), lw)
        ckv_p.append(c1.reshape(bp, sp // PAGE_SIZE, PAGE_SIZE, MLA_KV_LORA))
        kpe_p.append(k1.reshape(bp, sp // PAGE_SIZE, PAGE_SIZE, MLA_ROPE))
        s5_p.append(h1)
        gla_p.append(g1)
        conv_p.append(b1)
        past = (cache_mla_ckv[l][page_table].reshape(bs, past_len, MLA_KV_LORA),
                cache_mla_krope[l][page_table].reshape(bs, past_len, MLA_ROPE),
                past_pos)
        h0 = lax.complex(state_s5[l, ..., 0].astype(jnp.float32), state_s5[l, ..., 1].astype(jnp.float32))
        xd, c2, k2, h2, g2, b2 = _layer(xd, pos_s, past, h0, state_gla[l].astype(jnp.float32), state_ffn_conv[l], lw)
        ckv_s.append(c2)
        kpe_s.append(k2)
        s5_s.append(h2)
        gla_s.append(g2)
        conv_s.append(b2)
    y_prompt = _rmsnorm(xp, norm_final_g)
    y_sample = _rmsnorm(xd, norm_final_g)
    return (y_prompt, y_sample,
            jnp.stack(ckv_p), jnp.stack(kpe_p), jnp.stack(s5_p), jnp.stack(gla_p), jnp.stack(conv_p),
            jnp.stack(ckv_s), jnp.stack(kpe_s), jnp.stack(s5_s), jnp.stack(gla_s), jnp.stack(conv_s))
```

```cpp
#include <hip/hip_runtime.h>
#include <stdint.h>
#include <stdio.h>
#include <math.h>

#define DEV __device__ __forceinline__
typedef unsigned short bf16_t;
typedef short bf16x8 __attribute__((ext_vector_type(8)));
typedef float f32x4 __attribute__((ext_vector_type(4)));
typedef float f32x16 __attribute__((ext_vector_type(16)));
typedef unsigned u32x4 __attribute__((ext_vector_type(4)));
typedef unsigned u32x2 __attribute__((ext_vector_type(2)));

constexpr int DM = 1024, NB = 8, SEQ = 2048, M = NB * SEQ, DEPTH = 4, SB = 32, PAST = 16384, PAGE = 128, NPAGES = 128, NPOOL = 5120;
constexpr int DIN = 1456, DINP = 1536;
constexpr int S5G = 16, S5P = 64;
constexpr int MH = 8, QL = 256, KVL = 128, ROPE = 32;
constexpr int GH = 4, GDK = 32, GDV = 64;
constexpr int DFF = 2816, DFF2 = 5632;
constexpr float EPS = 1e-6f;
constexpr float QSCALE = 0.10206207261596575f * 1.4426950408889634f;
constexpr int NSPLIT = 8, KPS = PAST / NSPLIT;

constexpr size_t O_YP = 0, O_YS = O_YP + (size_t)M * DM, O_CKVP = O_YS + (size_t)SB * DM, O_KRP = O_CKVP + (size_t)DEPTH * M * KVL,
    O_S5P = O_KRP + (size_t)DEPTH * M * ROPE, O_GLAP = O_S5P + (size_t)DEPTH * NB * S5G * S5P * 2, O_CONVP = O_GLAP + (size_t)DEPTH * NB * GH * GDK * GDV,
    O_CKVS = O_CONVP + (size_t)DEPTH * NB * 2 * DFF, O_KRS = O_CKVS + (size_t)DEPTH * SB * KVL, O_S5S = O_KRS + (size_t)DEPTH * SB * ROPE,
    O_GLAS = O_S5S + (size_t)DEPTH * SB * S5G * S5P * 2, O_CONVS = O_GLAS + (size_t)DEPTH * SB * GH * GDK * GDV, O_END = O_CONVS + (size_t)DEPTH * SB * 2 * DFF;

constexpr size_t al(size_t x) { return (x + 255) & ~(size_t)255; }
constexpr size_t WS_CTL = 0, CTL_BYTES = 1 << 20;
constexpr size_t WL_IN = 0, WL_QB = WL_IN + (size_t)DINP * DM * 2, WL_KV = WL_QB + (size_t)768 * 256 * 2, WL_GLU = WL_KV + (size_t)1024 * 256 * 2,
    WL_OUT = WL_GLU + (size_t)256 * 256 * 2, WL_FFI = WL_OUT + (size_t)DM * DM * 2, WL_FFO = WL_FFI + (size_t)DFF2 * DM * 2, WL_SIZE = WL_FFO + (size_t)DM * DFF * 2;
constexpr size_t WS_W = WS_CTL + CTL_BYTES;
constexpr size_t S5_ABAR = 0, S5_BBAR = 512, S5_SIZE = 512 + 8192;
constexpr size_t WS_S5 = al(WS_W + DEPTH * WL_SIZE);
constexpr size_t WS_COS = al(WS_S5 + (size_t)DEPTH * S5G * S5_SIZE), WS_SIN = WS_COS + (size_t)(SEQ + 1) * 16 * 4;
constexpr size_t WS_XB = al(WS_SIN + (size_t)(SEQ + 1) * 16 * 4);
constexpr size_t WS_RSX = al(WS_XB + (size_t)M * DM * 2);
constexpr size_t WS_U5 = al(WS_RSX + (size_t)M * 16);
constexpr size_t WS_CQB = al(WS_U5 + (size_t)M * 256 * 2);
constexpr size_t WS_RSCQ = al(WS_CQB + (size_t)M * 256 * 2);
constexpr size_t WS_T2B = al(WS_RSCQ + (size_t)M * 16);
constexpr size_t WS_RSKV = al(WS_T2B + (size_t)M * 256 * 2);
constexpr size_t WS_QKF = al(WS_RSKV + (size_t)M * 16);
constexpr size_t WS_GLG = al(WS_QKF + (size_t)M * 256 * 4);
constexpr size_t WS_GVB = al(WS_GLG + (size_t)M * 128 * 4);
constexpr size_t WS_GRB = al(WS_GVB + (size_t)M * 256 * 2);
constexpr size_t WS_QN = al(WS_GRB + (size_t)M * 256 * 2);
constexpr size_t WS_QP = al(WS_QN + (size_t)M * 512 * 2);
constexpr size_t WS_KN = al(WS_QP + (size_t)M * 256 * 2);
constexpr size_t WS_KP = al(WS_KN + (size_t)M * 512 * 2);
constexpr size_t WS_VB = al(WS_KP + (size_t)M * 32 * 2);
constexpr size_t WS_Y5 = al(WS_VB + (size_t)M * 512 * 2);
constexpr size_t WS_MIX = al(WS_Y5 + (size_t)M * 256 * 2);
constexpr size_t WS_H = al(WS_MIX + (size_t)M * DM * 2);
constexpr size_t WS_XSB = al(WS_H + (size_t)M * DFF * 2);
constexpr size_t WS_RSXS = al(WS_XSB + (size_t)SB * DM * 2);
constexpr size_t WS_PS = al(WS_RSXS + (size_t)SB * 16);
constexpr size_t WS_QLAT = al(WS_PS + (size_t)SB * DINP * 4);
constexpr size_t WS_KVNEW = al(WS_QLAT + (size_t)SB * MH * 160 * 4);
constexpr size_t WS_MIXS = al(WS_KVNEW + (size_t)SB * 160 * 4);
constexpr size_t WS_OP = al(WS_MIXS + (size_t)SB * DM * 2);
constexpr size_t WS_ML = al(WS_OP + (size_t)SB * NSPLIT * MH * 128 * 4);
constexpr size_t WS_HVS = al(WS_ML + (size_t)SB * NSPLIT * MH * 2 * 4);
constexpr size_t WS_HS = al(WS_HVS + (size_t)SB * DFF2 * 4);
constexpr size_t WS_PF = al(WS_HS + (size_t)SB * DFF * 2);
constexpr size_t WS_QF = al(WS_PF + (size_t)M * DINP * 4);
constexpr size_t WS_HB = al(WS_QF + (size_t)M * 768 * 4);
constexpr size_t WS_HV = al(WS_HB + (size_t)M * 1024 * 8);
constexpr size_t WS_END = al(WS_HV + (size_t)M * DFF2 * 4);

DEV bf16_t f2bf(float f) { unsigned u = __float_as_uint(f); u += 0x7fffu + ((u >> 16) & 1u); return (bf16_t)(u >> 16); }
DEV float bf2f(bf16_t h) { return __uint_as_float((unsigned)h << 16); }
DEV unsigned pk2(float lo, float hi) { return (unsigned)f2bf(lo) | ((unsigned)f2bf(hi) << 16); }
DEV float wave_sum(float v) {
#pragma unroll
    for (int o = 1; o < 64; o <<= 1) v += __shfl_xor(v, o);
    return v;
}
DEV float wave_max(float v) {
#pragma unroll
    for (int o = 1; o < 64; o <<= 1) v = fmaxf(v, __shfl_xor(v, o));
    return v;
}
DEV float sigmoidf_(float x) { return 1.f / (1.f + __expf(-x)); }
DEV float gelu_tanh(float x) { const float u = 0.7978845608028654f * (x + 0.044715f * x * x * x); return x * sigmoidf_(2.f * u); }
DEV float log_sigmoid(float x) { return fminf(x, 0.f) - log1pf(__expf(-fabsf(x))); }
DEV int crow(int r, int hi) { return (r & 3) + 8 * (r >> 2) + 4 * hi; }
DEV float rs4(const float* p, float inv_n) { const f32x4 v = *(const f32x4*)p; return rsqrtf(((v.x + v.y) + (v.z + v.w)) * inv_n + EPS); }

DEV int colmap_win(int n) {
    const int t = n >> 8, c = n & 255;
    switch (t) {
        case 0: return c;
        case 1: return 256 + c;
        case 2: return c < 128 ? 512 + c : (c < 160 ? 640 + (c - 128) : (c < 176 ? 1184 + (c - 160) : -1));
        case 3: return c < 128 ? 672 + c : 800 + (c - 128);
        case 4: return 928 + c;
        default: return 1200 + c;
    }
}
DEV int rope_logical(int j) { return ((j >> 2) & 1) * 16 + 4 * (j >> 3) + (j & 3); }
DEV int rope_phys(int lg) { const int nn = lg >> 4, i = lg & 15; return 8 * (i >> 2) + 4 * nn + (i & 3); }
DEV int colmap_qb(int n) {
    if (n < 512) return (n >> 6) * 96 + (n & 63);
    const int c = n - 512, h = c >> 5, j = c & 31; return h * 96 + 64 + rope_logical(j);
}
DEV int colmap_ffi(int n) { const int j = n >> 8, r = n & 255; return r < 128 ? 128 * j + r : DFF + 128 * j + (r - 128); }

struct KArgs { unsigned char* ws; float* out; const float* p[8]; int i[4]; };
static_assert(sizeof(KArgs) == 96, "KArgs has no padding");
struct CvtDesc { const float* src; const float* src2; const float* gain; bf16_t* dst; int N, K, ld, pad; };
static_assert(sizeof(CvtDesc) == 48, "no padding");
enum { CV_WIN = 0, CV_WQB, CV_WKV, CV_T, CV_WFFI };
template <int KIND> __global__ void __launch_bounds__(256) k_cvt(CvtDesc d) {
    const int ld = d.ld;
    const int id = blockIdx.x * 256 + threadIdx.x; if (id >= d.N * (d.K / 8)) return;
    const int n = id % d.N, k0 = (id / d.N) * 8;
    float v[8];
#pragma unroll
    for (int i = 0; i < 8; ++i) { const int k = k0 + i; float x = 0.f;
        if (KIND == CV_WIN) { const int c = colmap_win(n); if (c >= 0) x = d.gain[k] * d.src[(size_t)k * DIN + c]; }
        else if (KIND == CV_WQB) { x = d.gain[k] * d.src[(size_t)k * 768 + colmap_qb(n)]; }
        else if (KIND == CV_WKV) { if (k < 128) { const int nn = n & 511; const float* s = n < 512 ? d.src : d.src2; x = d.gain[k] * s[((size_t)k * 8 + (nn >> 6)) * 64 + (nn & 63)]; } }
        else if (KIND == CV_T) { x = d.src[(size_t)k * ld + n]; }
        else { x = d.gain[k] * d.src[(size_t)k * DFF2 + colmap_ffi(n)]; }
        v[i] = x; }
    u32x4 o; o.x = pk2(v[0], v[1]); o.y = pk2(v[2], v[3]); o.z = pk2(v[4], v[5]); o.w = pk2(v[6], v[7]);
    *(u32x4*)(d.dst + (size_t)n * d.K + k0) = o;
}
__global__ void __launch_bounds__(64) k_s5_pre(KArgs ka) {
    const float *a_re = ka.p[0], *a_im = ka.p[1], *log_dt = ka.p[2], *b_re = ka.p[3], *b_im = ka.p[4]; unsigned char* ws = ka.ws;
    const int lg = blockIdx.x, p = threadIdx.x;
    const double dt = exp((double)log_dt[lg]);
    const double lr = a_re[lg * 64 + p], li = a_im[lg * 64 + p];
    const double er = exp(lr * dt), ar = er * cos(li * dt), ai = er * sin(li * dt);
    const double nr = ar - 1.0, ni = ai, den = lr * lr + li * li;
    const double cr = (nr * lr + ni * li) / den, ci = (ni * lr - nr * li) / den;
    float2* abar = (float2*)(ws + WS_S5 + (size_t)lg * S5_SIZE + S5_ABAR);
    float2* bbar = (float2*)(ws + WS_S5 + (size_t)lg * S5_SIZE + S5_BBAR);
    abar[p] = make_float2((float)ar, (float)ai);
    for (int c = 0; c < 16; ++c) { const double br = b_re[((size_t)lg * 64 + p) * 16 + c], bi = b_im[((size_t)lg * 64 + p) * 16 + c];
        bbar[p * 16 + c] = make_float2((float)(cr * br - ci * bi), (float)(cr * bi + ci * br)); }
}
__global__ void __launch_bounds__(256) k_rope_tab(KArgs ka) {
    unsigned char* ws = ka.ws;
    const int id = blockIdx.x * 256 + threadIdx.x; if (id >= (SEQ + 1) * 16) return;
    const int pr = id >> 4, i = id & 15; const double pos = pr < SEQ ? (double)pr : (double)PAST;
    const float inv = (float)pow(10000.0, -(double)i / 16.0);
    const double ang = pos * (double)inv;
    ((float*)(ws + WS_COS))[id] = (float)cos(ang); ((float*)(ws + WS_SIN))[id] = (float)sin(ang);
}
struct XPrepArgs { const float* x; bf16_t* xb; float* rs; int rows, pad; };
static_assert(sizeof(XPrepArgs) == 32, "no padding");
__global__ void __launch_bounds__(256) k_x_prep(XPrepArgs xa) {
    const float* x = xa.x; bf16_t* xb = xa.xb; float* rs = xa.rs; const int rows = xa.rows;
    const int row = (blockIdx.x * 256 + threadIdx.x) >> 6, lane = threadIdx.x & 63; if (row >= rows) return;
    const f32x4* xr = (const f32x4*)(x + (size_t)row * DM) + lane;
    float part[4];
#pragma unroll
    for (int j = 0; j < 4; ++j) { const f32x4 v = xr[64 * j]; part[j] = wave_sum((v.x * v.x + v.y * v.y) + (v.z * v.z + v.w * v.w));
        u32x2 o; o.x = pk2(v.x, v.y); o.y = pk2(v.z, v.w); *(u32x2*)(xb + (size_t)row * DM + 256 * j + 4 * lane) = o; }
    if (lane == 0) *(f32x4*)(rs + 4 * row) = (f32x4){part[0], part[1], part[2], part[3]};
}

template <class Epi> struct GemmArgs { const bf16_t* A; const bf16_t* Bt; int lda, ldb, Mr, N, K, pad; Epi epi; };
template <int TM, int TN, class Epi> __global__ void __launch_bounds__(256) k_gemm(GemmArgs<Epi> ga) {
    const bf16_t* A = ga.A; const bf16_t* Bt = ga.Bt; const int lda = ga.lda, ldb = ga.ldb, Mr = ga.Mr, N = ga.N, K = ga.K; const Epi& epi = ga.epi;
    const int wave = (blockIdx.x * 256 + threadIdx.x) >> 6, lane = threadIdx.x & 63;
    const int MT = Mr / (32 * TM), NT = N / (32 * TN); if (wave >= MT * NT) return;
    const int mt = wave % MT, nt = wave / MT, r32 = lane & 31, hi = lane >> 5;
    const bf16_t* ap = A + (size_t)(mt * 32 * TM + r32) * lda + 8 * hi;
    const bf16_t* bp = Bt + (size_t)(nt * 32 * TN + r32) * ldb + 8 * hi;
    f32x16 acc[TM][TN];
#pragma unroll
    for (int i = 0; i < TM; ++i)
#pragma unroll
        for (int j = 0; j < TN; ++j)
#pragma unroll
            for (int r = 0; r < 16; ++r) acc[i][j][r] = 0.f;
    for (int k = 0; k < K; k += 16) {
        bf16x8 a[TM], b[TN];
#pragma unroll
        for (int i = 0; i < TM; ++i) a[i] = *(const bf16x8*)(ap + (size_t)i * 32 * lda + k);
#pragma unroll
        for (int j = 0; j < TN; ++j) b[j] = *(const bf16x8*)(bp + (size_t)j * 32 * ldb + k);
#pragma unroll
        for (int i = 0; i < TM; ++i)
#pragma unroll
            for (int j = 0; j < TN; ++j) acc[i][j] = __builtin_amdgcn_mfma_f32_32x32x16_bf16(a[i], b[j], acc[i][j], 0, 0, 0);
    }
#pragma unroll
    for (int i = 0; i < TM; ++i)
#pragma unroll
        for (int j = 0; j < TN; ++j)
#pragma unroll
            for (int r = 0; r < 16; ++r) epi(mt * 32 * TM + i * 32 + crow(r, hi), nt * 32 * TN + j * 32 + r32, acc[i][j][r]);
}
struct EpiScaleF32 { float* out; const float* rs; int ld; float inv_n;
    DEV void operator()(int row, int col, float v) const { out[(size_t)row * ld + col] = v * rs4(rs + 4 * row, inv_n); } };
struct EpiKV { bf16_t* kn; bf16_t* vb; const float* rs;
    DEV void operator()(int row, int col, float v) const { const float r = rs4(rs + 4 * row, 1.f / 128.f); if (col < 512) kn[(size_t)row * 512 + col] = f2bf(v * r); else vb[(size_t)row * 512 + col - 512] = f2bf(v * r); } };
struct EpiGlu { const bf16_t* y; const float* bias; bf16_t* mix; int ldm, pad;
    DEV void operator()(int row, int col, float v) const { const float yy = bf2f(y[(size_t)row * 256 + col]); mix[(size_t)row * ldm + col] = f2bf(yy * sigmoidf_(v + bias[col])); } };
struct EpiResid { const float* xin; float* xout;
    DEV void operator()(int row, int col, float v) const { xout[(size_t)row * DM + col] = xin[(size_t)row * DM + col] + v; } };

__global__ void __launch_bounds__(256) k_post_win(KArgs ka) {
    const int l = ka.i[0]; unsigned char* ws = ka.ws; float* out = ka.out; const float *g_kv = ka.p[0], *w_gate = ka.p[1], *b_gate = ka.p[2];
    __shared__ float red[8];
    const int row = blockIdx.x, t = threadIdx.x, lane = t & 63, wv = t >> 6;
    const float* pf = (const float*)(ws + WS_PF) + (size_t)row * DINP;
    const int pos = row & (SEQ - 1);
    ((bf16_t*)(ws + WS_U5))[((size_t)(t >> 4) * M + row) * 16 + (t & 15)] = f2bf(pf[t]);
    const float cq = pf[256 + t]; ((bf16_t*)(ws + WS_CQB))[(size_t)row * 256 + t] = f2bf(cq);
    float s1 = wave_sum(cq * cq);
    const float t2 = pf[512 + t]; ((bf16_t*)(ws + WS_T2B))[(size_t)row * 256 + t] = f2bf(t2);
    float s2 = wave_sum(t < 128 ? t2 * t2 : 0.f);
    if (lane == 0) { red[wv] = s1; red[4 + wv] = s2; }
    __syncthreads();
    const float scq = (red[0] + red[1]) + (red[2] + red[3]), skv = (red[4] + red[5]) + (red[6] + red[7]);
    if (t == 0) { *(f32x4*)((float*)(ws + WS_RSCQ) + 4 * row) = (f32x4){scq, 0.f, 0.f, 0.f}; *(f32x4*)((float*)(ws + WS_RSKV) + 4 * row) = (f32x4){skv, 0.f, 0.f, 0.f}; }
    const float rk = rsqrtf(skv * (1.f / 128.f) + EPS);
    if (t < 128) out[O_CKVP + ((size_t)l * M + row) * KVL + t] = t2 * rk * g_kv[t];
    else if (t < 160) { const int j = t - 128, i = j & 15; const float x1 = pf[640 + i], x2 = pf[656 + i];
        const float c = ((const float*)(ws + WS_COS))[pos * 16 + i], s = ((const float*)(ws + WS_SIN))[pos * 16 + i];
        const float v = j < 16 ? x1 * c - x2 * s : x1 * s + x2 * c;
        out[O_KRP + ((size_t)l * M + row) * ROPE + j] = v; ((bf16_t*)(ws + WS_KP))[(size_t)row * 32 + rope_phys(j)] = f2bf(v); }
    if (t < 128) { float z = b_gate[t];
#pragma unroll
        for (int r = 0; r < 16; ++r) z += pf[672 + r] * w_gate[r * 128 + t];
        ((float*)(ws + WS_GLG))[(size_t)row * 128 + t] = log_sigmoid(z) * (1.f / 16.f); }
    ((float*)(ws + WS_QKF))[(size_t)row * 256 + t] = pf[768 + t];
    ((bf16_t*)(ws + WS_GVB))[(size_t)row * 256 + t] = f2bf(pf[1024 + t]);
    ((bf16_t*)(ws + WS_GRB))[(size_t)row * 256 + t] = f2bf(pf[1280 + t]);
}
__global__ void __launch_bounds__(256) k_post_q(KArgs ka) {
    unsigned char* ws = ka.ws;
    const size_t id = (size_t)blockIdx.x * 256 + threadIdx.x; if (id >= (size_t)M * 768) return;
    const int row = (int)(id / 768), n = (int)(id % 768), pos = row & (SEQ - 1);
    const float* qf = (const float*)(ws + WS_QF) + (size_t)row * 768;
    if (n < 512) { ((bf16_t*)(ws + WS_QN))[(size_t)row * 512 + n] = f2bf(qf[n] * QSCALE); return; }
    const int c = n - 512, h = c >> 5, j = c & 31, nn = (j >> 2) & 1, i = 4 * (j >> 3) + (j & 3);
    const float x1 = qf[512 + h * 32 + 8 * (j >> 3) + (j & 3)], x2 = qf[512 + h * 32 + 8 * (j >> 3) + 4 + (j & 3)];
    const float cs = ((const float*)(ws + WS_COS))[pos * 16 + i], sn = ((const float*)(ws + WS_SIN))[pos * 16 + i];
    const float v = nn == 0 ? x1 * cs - x2 * sn : x1 * sn + x2 * cs;
    ((bf16_t*)(ws + WS_QP))[(size_t)row * 256 + c] = f2bf(v * QSCALE);
}
__global__ void __launch_bounds__(64) k_s5_scan(KArgs ka) {
    const int l = ka.i[0]; unsigned char* ws = ka.ws; float* out = ka.out;
    const int b = blockIdx.x >> 4, g = blockIdx.x & 15, p = threadIdx.x, lg = l * 16 + g;
    const float2 a = ((const float2*)(ws + WS_S5 + (size_t)lg * S5_SIZE + S5_ABAR))[p];
    float2 bb[16];
#pragma unroll
    for (int c = 0; c < 16; ++c) bb[c] = ((const float2*)(ws + WS_S5 + (size_t)lg * S5_SIZE + S5_BBAR))[p * 16 + c];
    const bf16_t* u = (const bf16_t*)(ws + WS_U5) + ((size_t)g * M + (size_t)b * SEQ) * 16;
    float2* hb = (float2*)(ws + WS_HB);
    float hr = 0.f, hi = 0.f;
    for (int t = 0; t < SEQ; ++t) {
        float br = 0.f, bi = 0.f;
#pragma unroll
        for (int c = 0; c < 16; ++c) { const float uv = bf2f(u[t * 16 + c]); br += bb[c].x * uv; bi += bb[c].y * uv; }
        const float nr = a.x * hr - a.y * hi + br, ni = a.x * hi + a.y * hr + bi; hr = nr; hi = ni;
        hb[((size_t)(b * SEQ + t) * 16 + g) * 64 + p] = make_float2(hr, hi);
    }
    out[O_S5P + ((((size_t)l * NB + b) * S5G + g) * S5P + p) * 2 + 0] = hr;
    out[O_S5P + ((((size_t)l * NB + b) * S5G + g) * S5P + p) * 2 + 1] = hi;
}
__global__ void __launch_bounds__(256) k_s5_y(KArgs ka) {
    const int l = ka.i[0]; unsigned char* ws = ka.ws; const float *c_re = ka.p[0], *c_im = ka.p[1], *dskip = ka.p[2];
    const int row = blockIdx.x, t = threadIdx.x, g = t >> 4, c = t & 15;
    const float2* h = (const float2*)(ws + WS_HB) + ((size_t)row * 16 + g) * 64;
    const float* cr = c_re + (((size_t)l * 16 + g) * 16 + c) * 64; const float* ci = c_im + (((size_t)l * 16 + g) * 16 + c) * 64;
    float y = 0.f;
    for (int p = 0; p < 64; ++p) { const float2 hv = h[p]; y += cr[p] * hv.x - ci[p] * hv.y; }
    const float u = bf2f(((const bf16_t*)(ws + WS_U5))[((size_t)g * M + row) * 16 + c]);
    y += dskip[l * 256 + t] * u;
    ((bf16_t*)(ws + WS_Y5))[(size_t)row * 256 + t] = f2bf(gelu_tanh(y));
}
__global__ void __launch_bounds__(64) k_attn_naive(KArgs ka) {
    unsigned char* ws = ka.ws;
    const int blk = blockIdx.x, qb = blk & 31, h = (blk >> 5) & 7, b = blk >> 8, lane = threadIdx.x;
    const int q = qb * 64 + lane; const size_t row = (size_t)b * SEQ + q;
    const bf16_t* QN = (const bf16_t*)(ws + WS_QN); const bf16_t* QP = (const bf16_t*)(ws + WS_QP);
    const bf16_t* KN = (const bf16_t*)(ws + WS_KN); const bf16_t* KP = (const bf16_t*)(ws + WS_KP); const bf16_t* VB = (const bf16_t*)(ws + WS_VB);
    float qn[64], qp[32], o[64];
#pragma unroll
    for (int d = 0; d < 64; ++d) { qn[d] = bf2f(QN[row * 512 + h * 64 + d]); o[d] = 0.f; }
#pragma unroll
    for (int d = 0; d < 32; ++d) qp[d] = bf2f(QP[row * 256 + h * 32 + d]);
    float m = -INFINITY, lsum = 0.f;
    const int kend = qb * 64 + 63;
    for (int k = 0; k <= kend; ++k) {
        const size_t kr = (size_t)b * SEQ + k;
        float s = 0.f;
#pragma unroll
        for (int d = 0; d < 64; ++d) s += qn[d] * bf2f(KN[kr * 512 + h * 64 + d]);
#pragma unroll
        for (int d = 0; d < 32; ++d) s += qp[d] * bf2f(KP[kr * 32 + d]);
        if (k <= q) {
            const float mn = fmaxf(m, s), al_ = exp2f(m - mn), p = exp2f(s - mn);
            lsum = lsum * al_ + p; m = mn;
#pragma unroll
            for (int d = 0; d < 64; ++d) o[d] = o[d] * al_ + p * bf2f(VB[kr * 512 + h * 64 + d]);
        }
    }
    const float inv = 1.f / lsum;
    bf16_t* mix = (bf16_t*)(ws + WS_MIX) + row * DM + 256 + h * 64;
#pragma unroll
    for (int d = 0; d < 64; ++d) mix[d] = f2bf(o[d] * inv);
}
__global__ void __launch_bounds__(64) k_gla_naive(KArgs ka) {
    const int l = ka.i[0]; unsigned char* ws = ka.ws; float* out = ka.out; const float* gn = ka.p[0];
    const int b = blockIdx.x >> 2, h = blockIdx.x & 3, v = threadIdx.x;
    const float* QKF = (const float*)(ws + WS_QKF); const float* GLG = (const float*)(ws + WS_GLG);
    const bf16_t* GVB = (const bf16_t*)(ws + WS_GVB); const bf16_t* GRB = (const bf16_t*)(ws + WS_GRB);
    float S[32];
#pragma unroll
    for (int d = 0; d < 32; ++d) S[d] = 0.f;
    const float gg = gn[l * 256 + h * 64 + v];
    for (int t = 0; t < SEQ; ++t) {
        const size_t row = (size_t)b * SEQ + t;
        const float vv = bf2f(GVB[row * 256 + h * 64 + v]);
        float o = 0.f;
#pragma unroll
        for (int d = 0; d < 32; ++d) { const float dec = __expf(GLG[row * 128 + h * 32 + d]);
            S[d] = dec * S[d] + QKF[row * 256 + 128 + h * 32 + d] * vv; o += QKF[row * 256 + h * 32 + d] * 0.17677669529663687f * S[d]; }
        const float r = rsqrtf(wave_sum(o * o) * (1.f / 64.f) + EPS);
        const float gr = bf2f(GRB[row * 256 + h * 64 + v]);
        ((bf16_t*)(ws + WS_MIX))[row * DM + 768 + h * 64 + v] = f2bf(o * r * gg * gr * sigmoidf_(gr));
    }
#pragma unroll
    for (int d = 0; d < 32; ++d) out[O_GLAP + ((((size_t)l * NB + b) * GH + h) * GDK + d) * GDV + v] = S[d];
}
__global__ void __launch_bounds__(256) k_post_ffi(KArgs ka) {
    const int l = ka.i[0]; unsigned char* ws = ka.ws; float* out = ka.out; const float *cw = ka.p[0], *cb = ka.p[1];
    const size_t id = (size_t)blockIdx.x * 256 + threadIdx.x; if (id >= (size_t)M * DFF) return;
    const int row = (int)(id / DFF), c = (int)(id % DFF), t = row & (SEQ - 1);
    const int pv = 256 * (c >> 7) + (c & 127), pg = pv + 128;
    const float* hv = (const float*)(ws + WS_HV);
    const float g0 = hv[(size_t)row * DFF2 + pg], g1 = t >= 1 ? hv[(size_t)(row - 1) * DFF2 + pg] : 0.f, g2 = t >= 2 ? hv[(size_t)(row - 2) * DFF2 + pg] : 0.f;
    const float conv = cb[l * DFF + c] + cw[(l * 3 + 0) * DFF + c] * g2 + cw[(l * 3 + 1) * DFF + c] * g1 + cw[(l * 3 + 2) * DFF + c] * g0;
    ((bf16_t*)(ws + WS_H))[(size_t)row * DFF + c] = f2bf(gelu_tanh(conv) * hv[(size_t)row * DFF2 + pv]);
    if (t >= SEQ - 2) out[O_CONVP + (((size_t)l * NB + (row >> 11)) * 2 + (t - (SEQ - 2))) * DFF + c] = g0;
}

struct SampleW { const float *s5_c_re, *s5_c_im, *s5_d, *s5_w_glu, *s5_b_glu, *q_norm_g, *w_qb, *kv_norm_g, *w_uk, *w_uv, *w_gate, *b_gate, *gla_norm_g, *state_s5, *state_gla; };
struct SPrepArgs { unsigned char* ws; float* out; SampleW w; int l, pad; };
static_assert(sizeof(SPrepArgs) == 16 + 15 * 8 + 8, "no padding");
__global__ void __launch_bounds__(256) k_sample_prep(SPrepArgs sa) {
    const int l = sa.l; unsigned char* ws = sa.ws; float* out = sa.out; const SampleW& w = sa.w;
    __shared__ float u[256], ys[256], cqn[256], qv[768], red[8], gdec[128];
    __shared__ float2 hs[1024];
    const int b = blockIdx.x, t = threadIdx.x, lane = t & 63, wv = t >> 6;
    const float* ps = (const float*)(ws + WS_PS) + (size_t)b * DINP;
    bf16_t* mixs = (bf16_t*)(ws + WS_MIXS) + (size_t)b * DM;
    u[t] = ps[t];
    const float cq = ps[256 + t], t2 = ps[512 + t];
    float s1 = wave_sum(cq * cq), s2 = wave_sum(t < 128 ? t2 * t2 : 0.f);
    if (lane == 0) { red[wv] = s1; red[4 + wv] = s2; }
    __syncthreads();
    const float rq = rsqrtf(((red[0] + red[1]) + (red[2] + red[3])) * (1.f / 256.f) + EPS), rk = rsqrtf(((red[4] + red[5]) + (red[6] + red[7])) * (1.f / 128.f) + EPS);
    cqn[t] = cq * rq * w.q_norm_g[l * 256 + t];
#pragma unroll
    for (int i = 0; i < 4; ++i) { const int s = t + 256 * i, g = s >> 6, p = s & 63, lg = l * 16 + g;
        const float2 a = ((const float2*)(ws + WS_S5 + (size_t)lg * S5_SIZE + S5_ABAR))[p];
        const float2* bb = (const float2*)(ws + WS_S5 + (size_t)lg * S5_SIZE + S5_BBAR) + p * 16;
        const float* st = w.state_s5 + ((((size_t)l * SB + b) * S5G + g) * S5P + p) * 2;
        const float h0r = st[0], h0i = st[1];
        float hr = a.x * h0r - a.y * h0i, hi = a.x * h0i + a.y * h0r;
        for (int c = 0; c < 16; ++c) { const float uv = u[g * 16 + c]; hr += bb[c].x * uv; hi += bb[c].y * uv; }
        hs[s] = make_float2(hr, hi);
        float* o = out + O_S5S + ((((size_t)l * SB + b) * S5G + g) * S5P + p) * 2; o[0] = hr; o[1] = hi; }
    __syncthreads();
    { const int g = t >> 4, c = t & 15; const float* cr = w.s5_c_re + (((size_t)l * 16 + g) * 16 + c) * 64; const float* ci = w.s5_c_im + (((size_t)l * 16 + g) * 16 + c) * 64;
        float y = 0.f; for (int p = 0; p < 64; ++p) { const float2 hv = hs[g * 64 + p]; y += cr[p] * hv.x - ci[p] * hv.y; }
        y += w.s5_d[l * 256 + t] * u[t]; ys[t] = gelu_tanh(y); }
    __syncthreads();
    { float z = w.s5_b_glu[l * 256 + t]; const float* wg = w.s5_w_glu + (size_t)l * 65536; for (int k = 0; k < 256; ++k) z += ys[k] * wg[k * 256 + t];
        mixs[t] = f2bf(ys[t] * sigmoidf_(z)); }
    { const float* wq = w.w_qb + (size_t)l * 256 * 768;
#pragma unroll
        for (int i = 0; i < 3; ++i) { const int n = t + 256 * i; float a = 0.f; for (int k = 0; k < 256; ++k) a += cqn[k] * wq[(size_t)k * 768 + n]; qv[n] = a; } }
    __syncthreads();
    float* qlat = (float*)(ws + WS_QLAT) + (size_t)b * MH * 160;
#pragma unroll
    for (int i = 0; i < 4; ++i) { const int idx = t + 256 * i, h = idx >> 7, lp = idx & 127; const float* uk = w.w_uk + (((size_t)l * 128 + lp) * 8 + h) * 64;
        float a = 0.f; for (int n = 0; n < 64; ++n) a += qv[h * 96 + n] * uk[n];
        qlat[h * 160 + lp] = a * QSCALE; }
    const float* cosS = (const float*)(ws + WS_COS) + SEQ * 16; const float* sinS = (const float*)(ws + WS_SIN) + SEQ * 16;
    { const int h = t >> 5, j = t & 31, i = j & 15; const float x1 = qv[h * 96 + 64 + i], x2 = qv[h * 96 + 80 + i];
        qlat[h * 160 + 128 + j] = (j < 16 ? x1 * cosS[i] - x2 * sinS[i] : x1 * sinS[i] + x2 * cosS[i]) * QSCALE; }
    float* kvnew = (float*)(ws + WS_KVNEW) + (size_t)b * 160;
    if (t < 128) { const float v = t2 * rk * w.kv_norm_g[l * 128 + t]; kvnew[t] = v; out[O_CKVS + ((size_t)l * SB + b) * KVL + t] = v; }
    else if (t < 160) { const int j = t - 128, i = j & 15; const float x1 = ps[640 + i], x2 = ps[656 + i];
        const float v = j < 16 ? x1 * cosS[i] - x2 * sinS[i] : x1 * sinS[i] + x2 * cosS[i]; kvnew[t] = v; out[O_KRS + ((size_t)l * SB + b) * ROPE + j] = v; }
    if (t < 128) { float z = w.b_gate[l * 128 + t]; for (int r = 0; r < 16; ++r) z += ps[672 + r] * w.w_gate[((size_t)l * 16 + r) * 128 + t]; gdec[t] = __expf(log_sigmoid(z) * (1.f / 16.f)); }
    __syncthreads();
    { const int h = t >> 6, v = t & 63; const float vv = ps[1024 + t]; float o = 0.f;
        const float* s0 = w.state_gla + (((size_t)l * SB + b) * GH + h) * GDK * GDV; float* so = out + O_GLAS + (((size_t)l * SB + b) * GH + h) * GDK * GDV;
        for (int d = 0; d < 32; ++d) { const float s = gdec[h * 32 + d] * s0[d * 64 + v] + ps[896 + h * 32 + d] * vv; so[d * 64 + v] = s; o += ps[768 + h * 32 + d] * 0.17677669529663687f * s; }
        const float r = rsqrtf(wave_sum(o * o) * (1.f / 64.f) + EPS); const float gr = ps[1280 + t];
        mixs[768 + t] = f2bf(o * r * w.gla_norm_g[l * 256 + t] * gr * sigmoidf_(gr)); }
}
__global__ void __launch_bounds__(512) k_sample_attn(KArgs ka) {
    const int l = ka.i[0]; unsigned char* ws = ka.ws; const float *cache_ckv = ka.p[0], *cache_kr = ka.p[1]; const int* page_table = (const int*)ka.p[2];
    extern __shared__ __attribute__((aligned(16))) unsigned char lds[];
    float* KS = (float*)lds;
    float* KR = KS + 128 * 132;
    float* QS = KR + 128 * 36;
    float* PSM = QS + 8 * 160;
    const int b = blockIdx.x / NSPLIT, sp = blockIdx.x % NSPLIT, t = threadIdx.x, lane = t & 63, h = t >> 6;
    for (int i = t; i < 8 * 160; i += 512) QS[i] = ((const float*)(ws + WS_QLAT))[(size_t)b * 1280 + i];
    float m = -INFINITY, lsum = 0.f, o0 = 0.f, o1 = 0.f;
    for (int pg = 0; pg < KPS / PAGE; ++pg) {
        const int phys = page_table[b * NPAGES + sp * (KPS / PAGE) + pg];
        const f32x4* src = (const f32x4*)(cache_ckv + ((size_t)l * NPOOL + phys) * PAGE * KVL);
        __syncthreads();
        for (int i = t; i < 128 * 32; i += 512) { const int key = i >> 5, c4 = i & 31; *(f32x4*)(KS + key * 132 + 4 * c4) = src[i]; }
        const f32x4* src2 = (const f32x4*)(cache_kr + ((size_t)l * NPOOL + phys) * PAGE * ROPE);
        for (int i = t; i < 128 * 8; i += 512) { const int key = i >> 3, c4 = i & 7; *(f32x4*)(KR + key * 36 + 4 * c4) = src2[i]; }
        __syncthreads();
        float s[2];
#pragma unroll
        for (int kk = 0; kk < 2; ++kk) { const int key = lane + 64 * kk; float a = 0.f;
            for (int d = 0; d < 128; d += 4) { const f32x4 kv = *(const f32x4*)(KS + key * 132 + d), qq = *(const f32x4*)(QS + h * 160 + d); a += (kv.x * qq.x + kv.y * qq.y) + (kv.z * qq.z + kv.w * qq.w); }
            for (int d = 0; d < 32; d += 4) { const f32x4 kv = *(const f32x4*)(KR + key * 36 + d), qq = *(const f32x4*)(QS + h * 160 + 128 + d); a += (kv.x * qq.x + kv.y * qq.y) + (kv.z * qq.z + kv.w * qq.w); }
            s[kk] = a; }
        const float mn = fmaxf(m, wave_max(fmaxf(s[0], s[1]))), al_ = exp2f(m - mn);
        const float p0 = exp2f(s[0] - mn), p1 = exp2f(s[1] - mn);
        lsum = lsum * al_ + wave_sum(p0 + p1); m = mn; o0 *= al_; o1 *= al_;
        PSM[h * 128 + lane] = p0; PSM[h * 128 + 64 + lane] = p1;
        __builtin_amdgcn_s_waitcnt(0);
        __builtin_amdgcn_wave_barrier();
        for (int key = 0; key < 128; ++key) { const float p = PSM[h * 128 + key]; o0 += p * KS[key * 132 + lane]; o1 += p * KS[key * 132 + 64 + lane]; }
    }
    float* op = (float*)(ws + WS_OP) + (((size_t)b * NSPLIT + sp) * MH + h) * 128;
    op[lane] = o0; op[64 + lane] = o1;
    if (lane == 0) { float* ml = (float*)(ws + WS_ML) + (((size_t)b * NSPLIT + sp) * MH + h) * 2; ml[0] = m; ml[1] = lsum; }
}
__global__ void __launch_bounds__(512) k_sample_combine(KArgs ka) {
    const int l = ka.i[0]; unsigned char* ws = ka.ws; const float* w_uv = ka.p[0];
    __shared__ float ol[8][128];
    const int b = blockIdx.x, t = threadIdx.x, lane = t & 63, h = t >> 6;
    const float* ql = (const float*)(ws + WS_QLAT) + ((size_t)b * MH + h) * 160; const float* kn = (const float*)(ws + WS_KVNEW) + (size_t)b * 160;
    float sn = ql[lane] * kn[lane] + ql[64 + lane] * kn[64 + lane] + (lane < 32 ? ql[128 + lane] * kn[128 + lane] : 0.f);
    sn = wave_sum(sn);
    const float* ml = (const float*)(ws + WS_ML) + ((size_t)b * NSPLIT * MH + h) * 2; const float* op = (const float*)(ws + WS_OP) + ((size_t)b * NSPLIT * MH + h) * 128;
    float mx = sn;
    for (int s = 0; s < NSPLIT; ++s) mx = fmaxf(mx, ml[s * MH * 2]);
    float wn = exp2f(sn - mx), L = wn, o0 = wn * kn[lane], o1 = wn * kn[64 + lane];
    for (int s = 0; s < NSPLIT; ++s) { const float ws_ = exp2f(ml[s * MH * 2] - mx); L += ws_ * ml[s * MH * 2 + 1]; o0 += ws_ * op[s * MH * 128 + lane]; o1 += ws_ * op[s * MH * 128 + 64 + lane]; }
    const float inv = 1.f / L; ol[h][lane] = o0 * inv; ol[h][64 + lane] = o1 * inv;
    __syncthreads();
    float a = 0.f; const float* uv = w_uv + (size_t)l * 128 * 512 + h * 64 + lane;
    for (int lp = 0; lp < 128; ++lp) a += ol[h][lp] * uv[(size_t)lp * 512];
    ((bf16_t*)(ws + WS_MIXS))[(size_t)b * DM + 256 + h * 64 + lane] = f2bf(a);
}
__global__ void __launch_bounds__(256) k_sample_post_ffi(KArgs ka) {
    const int l = ka.i[0]; unsigned char* ws = ka.ws; float* out = ka.out; const float *cw = ka.p[0], *cb = ka.p[1], *state_conv = ka.p[2];
    const int id = blockIdx.x * 256 + threadIdx.x; if (id >= SB * DFF) return;
    const int b = id / DFF, c = id % DFF, pv = 256 * (c >> 7) + (c & 127), pg = pv + 128;
    const float* hv = (const float*)(ws + WS_HVS) + (size_t)b * DFF2;
    const float g0 = hv[pg], b0 = state_conv[(((size_t)l * SB + b) * 2 + 0) * DFF + c], b1 = state_conv[(((size_t)l * SB + b) * 2 + 1) * DFF + c];
    const float conv = cb[l * DFF + c] + cw[(l * 3 + 0) * DFF + c] * b0 + cw[(l * 3 + 1) * DFF + c] * b1 + cw[(l * 3 + 2) * DFF + c] * g0;
    ((bf16_t*)(ws + WS_HS))[(size_t)b * DFF + c] = f2bf(gelu_tanh(conv) * hv[pv]);
    out[O_CONVS + (((size_t)l * SB + b) * 2 + 0) * DFF + c] = b1; out[O_CONVS + (((size_t)l * SB + b) * 2 + 1) * DFF + c] = g0;
}
__global__ void __launch_bounds__(256) k_final_norm(KArgs ka) {
    float* x = ka.out; const float* g = ka.p[0]; const int rows = ka.i[0];
    const int row = (blockIdx.x * 256 + threadIdx.x) >> 6, lane = threadIdx.x & 63; if (row >= rows) return;
    f32x4* xr = (f32x4*)(x + (size_t)row * DM) + lane; f32x4 v[4]; float s = 0.f;
#pragma unroll
    for (int j = 0; j < 4; ++j) { v[j] = xr[64 * j]; s += (v[j].x * v[j].x + v[j].y * v[j].y) + (v[j].z * v[j].z + v[j].w * v[j].w); }
    const float r = rsqrtf(wave_sum(s) * (1.f / DM) + EPS);
#pragma unroll
    for (int j = 0; j < 4; ++j) { const f32x4 gg = ((const f32x4*)g)[lane + 64 * j]; xr[64 * j] = v[j] * r * gg; }
}

#include <string.h>
static KArgs mk(unsigned char* ws, float* out, int i0, const void* p0 = nullptr, const void* p1 = nullptr, const void* p2 = nullptr, const void* p3 = nullptr, const void* p4 = nullptr) {
    KArgs a; memset(&a, 0, sizeof a); a.ws = ws; a.out = out; a.i[0] = i0;
    a.p[0] = (const float*)p0; a.p[1] = (const float*)p1; a.p[2] = (const float*)p2; a.p[3] = (const float*)p3; a.p[4] = (const float*)p4; return a;
}
template <int TM, int TN, class Epi> static void gemm(hipStream_t st, const bf16_t* A, int lda, const bf16_t* Bt, int ldb, int Mr, int N, int K, const Epi& e) {
    const int waves = (Mr / (32 * TM)) * (N / (32 * TN));
    GemmArgs<Epi> ga; memset(&ga, 0, sizeof ga); ga.A = A; ga.Bt = Bt; ga.lda = lda; ga.ldb = ldb; ga.Mr = Mr; ga.N = N; ga.K = K; memcpy(&ga.epi, &e, sizeof e);
    hipLaunchKernelGGL((k_gemm<TM, TN, Epi>), dim3((waves + 3) / 4), dim3(256), 0, st, ga);
}
template <int KIND> static void cvt(hipStream_t st, const float* src, const float* src2, const float* gain, bf16_t* dst, int N, int K, int ld) {
    CvtDesc d; memset(&d, 0, sizeof d); d.src = src; d.src2 = src2; d.gain = gain; d.dst = dst; d.N = N; d.K = K; d.ld = ld; const int n = N * (K / 8);
    hipLaunchKernelGGL((k_cvt<KIND>), dim3((n + 255) / 256), dim3(256), 0, st, d);
}
static void xprep(hipStream_t st, const float* x, bf16_t* xb, float* rs, int rows) {
    XPrepArgs a; memset(&a, 0, sizeof a); a.x = x; a.xb = xb; a.rs = rs; a.rows = rows;
    hipLaunchKernelGGL(k_x_prep, dim3((rows + 3) / 4), dim3(256), 0, st, a);
}
static EpiScaleF32 epi_scale(float* out, int ld, const float* rs, float inv_n) { EpiScaleF32 e; memset(&e, 0, sizeof e); e.out = out; e.rs = rs; e.ld = ld; e.inv_n = inv_n; return e; }
extern "C" void kernel_launch(void* const* d_in, const int* in_sizes, int n_in, void* d_out, int out_size, void* d_ws, size_t ws_size, hipStream_t stream) {
    if (n_in != 35 || (size_t)out_size != O_END || ws_size < WS_END) { fprintf(stderr, "kernel_launch: unexpected sizes n_in %d out %d ws %zu (need %zu)\n", n_in, out_size, ws_size, (size_t)WS_END); return; }
    const float* const* in = (const float* const*)d_in;
    unsigned char* ws = (unsigned char*)d_ws; float* out = (float*)d_out;
    const float *x_prompt = in[0], *x_sample = in[1], *cache_ckv = in[2], *cache_kr = in[3]; const int* page_table = (const int*)d_in[4];
    static bool attr = false;
    constexpr int ATT_LDS = (128 * 132 + 128 * 36 + 8 * 160 + 8 * 128) * 4;
    if (!attr) { (void)hipFuncSetAttribute((const void*)k_sample_attn, hipFuncAttributeMaxDynamicSharedMemorySize, ATT_LDS); attr = true; }
    for (int l = 0; l < DEPTH; ++l) {
        unsigned char* wl = ws + WS_W + (size_t)l * WL_SIZE;
        cvt<CV_WIN>(stream, in[9] + (size_t)l * DM * DIN, nullptr, in[8] + l * DM, (bf16_t*)(wl + WL_IN), DINP, DM, 0);
        cvt<CV_WQB>(stream, in[21] + (size_t)l * 256 * 768, nullptr, in[20] + l * 256, (bf16_t*)(wl + WL_QB), 768, 256, 0);
        cvt<CV_WKV>(stream, in[23] + (size_t)l * 128 * 512, in[24] + (size_t)l * 128 * 512, in[22] + l * 128, (bf16_t*)(wl + WL_KV), 1024, 256, 0);
        cvt<CV_T>(stream, in[18] + (size_t)l * 65536, nullptr, nullptr, (bf16_t*)(wl + WL_GLU), 256, 256, 256);
        cvt<CV_T>(stream, in[28] + (size_t)l * DM * DM, nullptr, nullptr, (bf16_t*)(wl + WL_OUT), DM, DM, DM);
        cvt<CV_WFFI>(stream, in[30] + (size_t)l * DM * DFF2, nullptr, in[29] + l * DM, (bf16_t*)(wl + WL_FFI), DFF2, DM, 0);
        cvt<CV_T>(stream, in[33] + (size_t)l * DFF * DM, nullptr, nullptr, (bf16_t*)(wl + WL_FFO), DM, DFF, DM);
    }
    hipLaunchKernelGGL(k_s5_pre, dim3(DEPTH * 16), dim3(64), 0, stream, mk(ws, out, 0, in[10], in[11], in[12], in[13], in[14]));
    hipLaunchKernelGGL(k_rope_tab, dim3(((SEQ + 1) * 16 + 255) / 256), dim3(256), 0, stream, mk(ws, out, 0));
    bf16_t* XB = (bf16_t*)(ws + WS_XB); float* RSX = (float*)(ws + WS_RSX); bf16_t* XSB = (bf16_t*)(ws + WS_XSB); float* RSXS = (float*)(ws + WS_RSXS);
    float* xp = out + O_YP; float* xs = out + O_YS;
    xprep(stream, x_prompt, XB, RSX, M);
    xprep(stream, x_sample, XSB, RSXS, SB);
    for (int l = 0; l < DEPTH; ++l) {
        unsigned char* wl = ws + WS_W + (size_t)l * WL_SIZE;
        const float* xin_p = l == 0 ? x_prompt : xp; const float* xin_s = l == 0 ? x_sample : xs;
        gemm<2, 2>(stream, XB, DM, (bf16_t*)(wl + WL_IN), DM, M, DINP, DM, epi_scale((float*)(ws + WS_PF), DINP, RSX, 1.f / DM));
        hipLaunchKernelGGL(k_post_win, dim3(M), dim3(256), 0, stream, mk(ws, out, l, in[22] + l * 128, in[25] + (size_t)l * 16 * 128, in[26] + l * 128));
        gemm<2, 2>(stream, (bf16_t*)(ws + WS_CQB), 256, (bf16_t*)(wl + WL_QB), 256, M, 768, 256, epi_scale((float*)(ws + WS_QF), 768, (float*)(ws + WS_RSCQ), 1.f / 256.f));
        hipLaunchKernelGGL(k_post_q, dim3((unsigned)(((size_t)M * 768 + 255) / 256)), dim3(256), 0, stream, mk(ws, out, l));
        gemm<2, 2>(stream, (bf16_t*)(ws + WS_T2B), 256, (bf16_t*)(wl + WL_KV), 256, M, 1024, 256, EpiKV{(bf16_t*)(ws + WS_KN), (bf16_t*)(ws + WS_VB), (float*)(ws + WS_RSKV)});
        hipLaunchKernelGGL(k_s5_scan, dim3(NB * 16), dim3(64), 0, stream, mk(ws, out, l));
        hipLaunchKernelGGL(k_s5_y, dim3(M), dim3(256), 0, stream, mk(ws, out, l, in[15], in[16], in[17]));
        { EpiGlu e; memset(&e, 0, sizeof e); e.y = (bf16_t*)(ws + WS_Y5); e.bias = in[19] + l * 256; e.mix = (bf16_t*)(ws + WS_MIX); e.ldm = DM;
          gemm<2, 2>(stream, (bf16_t*)(ws + WS_Y5), 256, (bf16_t*)(wl + WL_GLU), 256, M, 256, 256, e); }
        hipLaunchKernelGGL(k_attn_naive, dim3(NB * MH * 32), dim3(64), 0, stream, mk(ws, out, l));
        hipLaunchKernelGGL(k_gla_naive, dim3(NB * GH), dim3(64), 0, stream, mk(ws, out, l, in[27]));
        gemm<2, 2>(stream, (bf16_t*)(ws + WS_MIX), DM, (bf16_t*)(wl + WL_OUT), DM, M, DM, DM, EpiResid{xin_p, xp});
        xprep(stream, xp, XB, RSX, M);
        gemm<2, 2>(stream, XB, DM, (bf16_t*)(wl + WL_FFI), DM, M, DFF2, DM, epi_scale((float*)(ws + WS_HV), DFF2, RSX, 1.f / DM));
        hipLaunchKernelGGL(k_post_ffi, dim3((unsigned)(((size_t)M * DFF + 255) / 256)), dim3(256), 0, stream, mk(ws, out, l, in[31], in[32]));
        gemm<2, 2>(stream, (bf16_t*)(ws + WS_H), DFF, (bf16_t*)(wl + WL_FFO), DFF, M, DM, DFF, EpiResid{xp, xp});
        xprep(stream, xp, XB, RSX, M);
        gemm<1, 1>(stream, XSB, DM, (bf16_t*)(wl + WL_IN), DM, SB, DINP, DM, epi_scale((float*)(ws + WS_PS), DINP, RSXS, 1.f / DM));
        { SPrepArgs sa; memset(&sa, 0, sizeof sa); sa.ws = ws; sa.out = out; sa.l = l;
          const SampleW sw{in[15], in[16], in[17], in[18], in[19], in[20], in[21], in[22], in[23], in[24], in[25], in[26], in[27], in[5], in[6]}; memcpy(&sa.w, &sw, sizeof sw);
          hipLaunchKernelGGL(k_sample_prep, dim3(SB), dim3(256), 0, stream, sa); }
        hipLaunchKernelGGL(k_sample_attn, dim3(SB * NSPLIT), dim3(512), ATT_LDS, stream, mk(ws, out, l, cache_ckv, cache_kr, page_table));
        hipLaunchKernelGGL(k_sample_combine, dim3(SB), dim3(512), 0, stream, mk(ws, out, l, in[24]));
        gemm<1, 1>(stream, (bf16_t*)(ws + WS_MIXS), DM, (bf16_t*)(wl + WL_OUT), DM, SB, DM, DM, EpiResid{xin_s, xs});
        xprep(stream, xs, XSB, RSXS, SB);
        gemm<1, 1>(stream, XSB, DM, (bf16_t*)(wl + WL_FFI), DM, SB, DFF2, DM, epi_scale((float*)(ws + WS_HVS), DFF2, RSXS, 1.f / DM));
        hipLaunchKernelGGL(k_sample_post_ffi, dim3((SB * DFF + 255) / 256), dim3(256), 0, stream, mk(ws, out, l, in[31], in[32], in[7]));
        gemm<1, 1>(stream, (bf16_t*)(ws + WS_HS), DFF, (bf16_t*)(wl + WL_FFO), DFF, SB, DM, DFF, EpiResid{xs, xs});
        xprep(stream, xs, XSB, RSXS, SB);
    }
    { KArgs a = mk(ws, xp, M, in[34]); hipLaunchKernelGGL(k_final_norm, dim3(M / 4), dim3(256), 0, stream, a); }
    { KArgs a = mk(ws, xs, SB, in[34]); hipLaunchKernelGGL(k_final_norm, dim3(SB / 4), dim3(256), 0, stream, a); }
}
```

```cpp
#include <hip/hip_runtime.h>
#include <stdint.h>
#include <stddef.h>
#include <stdio.h>
#include <math.h>

#define DEV __device__ __forceinline__
typedef unsigned short bf16_t;
typedef short bf16x8 __attribute__((ext_vector_type(8)));
typedef float f32x4 __attribute__((ext_vector_type(4)));
typedef float f32x16 __attribute__((ext_vector_type(16)));
typedef unsigned u32x4 __attribute__((ext_vector_type(4)));
typedef unsigned u32x2 __attribute__((ext_vector_type(2)));

constexpr int DM = 1024, NB = 8, SEQ = 2048, M = NB * SEQ, DEPTH = 4, SB = 32, PAST = 16384, PAGE = 128, NPAGES = 128, NPOOL = 5120;
constexpr int DIN = 1456, DINP = 1536;
constexpr int S5G = 16, S5P = 64;
constexpr int MH = 8, QL = 256, KVL = 128, ROPE = 32;
constexpr int GH = 4, GDK = 32, GDV = 64;
constexpr int DFF = 2816, DFF2 = 5632;
constexpr float EPS = 1e-6f;
constexpr float QSCALE = 0.10206207261596575f * 1.4426950408889634f;
constexpr int NSPLIT = 8, KPS = PAST / NSPLIT;

constexpr size_t O_YP = 0, O_YS = O_YP + (size_t)M * DM, O_CKVP = O_YS + (size_t)SB * DM, O_KRP = O_CKVP + (size_t)DEPTH * M * KVL,
    O_S5P = O_KRP + (size_t)DEPTH * M * ROPE, O_GLAP = O_S5P + (size_t)DEPTH * NB * S5G * S5P * 2, O_CONVP = O_GLAP + (size_t)DEPTH * NB * GH * GDK * GDV,
    O_CKVS = O_CONVP + (size_t)DEPTH * NB * 2 * DFF, O_KRS = O_CKVS + (size_t)DEPTH * SB * KVL, O_S5S = O_KRS + (size_t)DEPTH * SB * ROPE,
    O_GLAS = O_S5S + (size_t)DEPTH * SB * S5G * S5P * 2, O_CONVS = O_GLAS + (size_t)DEPTH * SB * GH * GDK * GDV, O_END = O_CONVS + (size_t)DEPTH * SB * 2 * DFF;

constexpr size_t al(size_t x) { return (x + 255) & ~(size_t)255; }
constexpr size_t WS_CTL = 0, CTL_BYTES = 1 << 20;
constexpr size_t WL_IN = 0, WL_QB = WL_IN + (size_t)DINP * DM * 2, WL_KV = WL_QB + (size_t)768 * 256 * 2, WL_GLU = WL_KV + (size_t)1024 * 256 * 2,
    WL_OUT = WL_GLU + (size_t)256 * 256 * 2, WL_FFI = WL_OUT + (size_t)DM * DM * 2, WL_FFO = WL_FFI + (size_t)DFF2 * DM * 2, WL_SIZE = WL_FFO + (size_t)DM * DFF * 2;
constexpr size_t WS_W = WS_CTL + CTL_BYTES;
constexpr size_t S5_ABAR = 0, S5_BBAR = 512, S5_AL = 8704, S5_TQ = 9216, S5_P = S5_TQ + (size_t)640 * 512 * 2, S5_SIZE = S5_P + (size_t)512 * 128 * 2;
constexpr size_t WS_S5 = al(WS_W + DEPTH * WL_SIZE);
constexpr size_t WS_COS = al(WS_S5 + (size_t)DEPTH * S5G * S5_SIZE), WS_SIN = WS_COS + (size_t)(SEQ + 1) * 16 * 4;
constexpr size_t WS_APOW = al(WS_SIN + (size_t)(SEQ + 1) * 16 * 4);
constexpr size_t WS_XB = al(WS_APOW + (size_t)DEPTH * 16 * 33 * 64 * 8);
constexpr size_t WS_RSX = al(WS_XB + (size_t)M * DM * 2);
constexpr size_t WS_U5 = al(WS_RSX + (size_t)M * 64);
constexpr size_t WS_CQB = al(WS_U5 + (size_t)M * 256 * 2);
constexpr size_t WS_RSCQ = al(WS_CQB + (size_t)M * 256 * 2);
constexpr size_t WS_T2B = al(WS_RSCQ + (size_t)M * 16);
constexpr size_t WS_RSKV = al(WS_T2B + (size_t)M * 256 * 2);
constexpr size_t WS_QKF = al(WS_RSKV + (size_t)M * 16);
constexpr size_t WS_GLG = al(WS_QKF + (size_t)M * 256 * 4);
constexpr size_t WS_GVB = al(WS_GLG + (size_t)M * 128 * 4);
constexpr size_t WS_GRB = al(WS_GVB + (size_t)M * 256 * 2);
constexpr size_t WS_QN = al(WS_GRB + (size_t)M * 256 * 2);
constexpr size_t WS_QP = al(WS_QN + (size_t)M * 512 * 2);
constexpr size_t WS_KN = al(WS_QP + (size_t)M * 256 * 2);
constexpr size_t WS_KP = al(WS_KN + (size_t)M * 512 * 2);
constexpr size_t WS_VB = al(WS_KP + (size_t)M * 32 * 2);
constexpr size_t WS_Y5 = al(WS_VB + (size_t)M * 512 * 2);
constexpr size_t WS_MIX = al(WS_Y5 + (size_t)M * 256 * 2);
constexpr size_t WS_H = al(WS_MIX + (size_t)M * DM * 2);
constexpr size_t WS_XSB = al(WS_H + (size_t)M * DFF * 2);
constexpr size_t WS_RSXS = al(WS_XSB + (size_t)SB * DM * 2);
constexpr size_t WS_PS = al(WS_RSXS + (size_t)SB * 16);
constexpr size_t WS_QLAT = al(WS_PS + (size_t)SB * DINP * 4);
constexpr size_t WS_KVNEW = al(WS_QLAT + (size_t)SB * MH * 160 * 4);
constexpr size_t WS_MIXS = al(WS_KVNEW + (size_t)SB * 160 * 4);
constexpr size_t WS_OP = al(WS_MIXS + (size_t)SB * DM * 2);
constexpr size_t WS_ML = al(WS_OP + (size_t)DEPTH * SB * NSPLIT * MH * 128 * 4);
constexpr size_t WS_HVS = al(WS_ML + (size_t)DEPTH * SB * NSPLIT * MH * 2 * 4);
constexpr size_t WS_HS = al(WS_HVS + (size_t)SB * DFF2 * 4);
constexpr size_t WS_T2F = al(WS_HS + (size_t)SB * DFF * 2);
constexpr size_t WS_HB = al(WS_T2F + (size_t)M * 256 * 4);
constexpr size_t WS_HV = al(WS_HB + (size_t)M * 1024 * 8);
constexpr size_t WS_FV = WS_HV, WS_FG = WS_HV + (2u << 20), WS_LG = WS_HV + (4u << 20);
constexpr size_t WS_END = al(WS_HV + (size_t)M * DFF2 * 4);

DEV bf16_t f2bf(float f) { unsigned u = __float_as_uint(f); u += 0x7fffu + ((u >> 16) & 1u); return (bf16_t)(u >> 16); }
DEV float bf2f(bf16_t h) { return __uint_as_float((unsigned)h << 16); }
DEV unsigned pk2(float lo, float hi) { return (unsigned)f2bf(lo) | ((unsigned)f2bf(hi) << 16); }
DEV int lane_id() { int l; asm volatile("v_mbcnt_lo_u32_b32 %0, -1, 0\n\tv_mbcnt_hi_u32_b32 %0, -1, %0" : "=v"(l)); return l; }
DEV float shfl_xor_(float v, int m) { return __builtin_bit_cast(float, __builtin_amdgcn_ds_bpermute((lane_id() ^ m) << 2, __builtin_bit_cast(int, v))); }
DEV float shfl_(float v, int src) { return __builtin_bit_cast(float, __builtin_amdgcn_ds_bpermute(src << 2, __builtin_bit_cast(int, v))); }
DEV float wave_sum(float v) {
#pragma unroll
    for (int o = 1; o < 64; o <<= 1) v += shfl_xor_(v, o);
    return v;
}
DEV float wave_max(float v) {
#pragma unroll
    for (int o = 1; o < 64; o <<= 1) v = fmaxf(v, shfl_xor_(v, o));
    return v;
}
DEV float fexp2(float x) { return __builtin_amdgcn_exp2f(x); }
DEV float fexp(float x) { return __builtin_amdgcn_exp2f(1.4426950408889634f * x); }
DEV float sigmoidf_(float x) { return __builtin_amdgcn_rcpf(1.f + fexp(-x)); }
DEV float gelu_tanh(float x) { const float u = 0.7978845608028654f * (x + 0.044715f * x * x * x); return x * sigmoidf_(2.f * u); }
DEV float log_sigmoid(float x) { return fminf(x, 0.f) - 0.6931471805599453f * __builtin_amdgcn_logf(1.f + fexp(-fabsf(x))); }
DEV void lds_barrier() { asm volatile("s_waitcnt lgkmcnt(0)" ::: "memory"); __builtin_amdgcn_s_barrier(); asm volatile("" ::: "memory"); }
DEV int crow(int r, int hi) { return (r & 3) + 8 * (r >> 2) + 4 * hi; }
DEV float rs4(const float* p, float inv_n) { const f32x4 v = *(const f32x4*)p; return rsqrtf(((v.x + v.y) + (v.z + v.w)) * inv_n + EPS); }

DEV int colmap_win(int n) {
    const int t = n >> 8, c = n & 255;
    switch (t) {
        case 0: return c;
        case 1: return 256 + c;
        case 2: return c < 128 ? 512 + c : (c < 160 ? 640 + (c - 128) : (c < 176 ? 1184 + (c - 160) : -1));
        case 3: return c < 128 ? 672 + c : 800 + (c - 128);
        case 4: return 928 + c;
        default: return 1200 + c;
    }
}
DEV int rope_logical(int j) { return ((j >> 2) & 1) * 16 + 4 * (j >> 3) + (j & 3); }
DEV int rope_phys(int lg) { const int nn = lg >> 4, i = lg & 15; return 8 * (i >> 2) + 4 * nn + (i & 3); }
DEV int colmap_qb(int n) {
    if (n < 512) return (n >> 6) * 96 + (n & 63);
    const int c = n - 512, h = c >> 5, j = c & 31; return h * 96 + 64 + rope_logical(j);
}
DEV int colmap_ffi(int n) { const int j = n >> 8, r = n & 255; return r < 128 ? 128 * j + r : DFF + 128 * j + (r - 128); }


namespace pg8 {
#define PG8_LAS __attribute__((address_space(3)))
typedef unsigned short bf16_t;
typedef short bf16x8 __attribute__((ext_vector_type(8)));
typedef float f32x4 __attribute__((ext_vector_type(4)));
typedef unsigned u32x4 __attribute__((ext_vector_type(4)));
constexpr int BM = 256, BK = 64, HALF = 128, HTB = HALF * BK * 2  , STAGE_BYTES = 8 * HTB, NXCD = 8, WGM = 8;

__host__ __device__ __forceinline__ int lds_byte(int r, int c) { const int st = (r >> 4) * 2 + (c >> 5), rr = r & 15, cc = c & 31, ob = rr * 64 + cc * 2; return st * 1024 + (ob ^ (((ob >> 9) & 1) << 5)); }
__host__ __device__ __forceinline__ void stage_rc(int b, int& R, int& C) { const int st = b / 1024, sb = b % 1024, swz = sb ^ (((sb >> 9) & 1) << 5); R = (st >> 1) * 16 + swz / 64; C = (st & 1) * 32 + (swz % 64) / 2; }
__host__ __device__ __forceinline__ int perm32(int rho) { const int n = rho >> 4, i = rho & 15; return 8 * (i >> 2) + 4 * n + (i & 3); }

struct Unit { int pm, pn; };
struct Gemm { const bf16_t* A; const bf16_t* Bt; int M, N, K; };

struct StaticOrder {
    int nM, nN, nwg, G, c;
    __host__ __device__ void init(int M, int N, int G_, int c_) { nM = M / BM; nN = N / BM; nwg = nM * nN; G = G_; c = c_; }
    __host__ __device__ bool next(int i, Unit& u) const {
        const long L = (long)i * G + c; if (L >= nwg) return false;
        int wgid = (int)L; { const int q = nwg / NXCD, r = nwg % NXCD, xcd = wgid % NXCD, off = wgid / NXCD; wgid = (xcd < r ? xcd * (q + 1) : r * (q + 1) + (xcd - r) * q) + off; }
        const int nig = WGM * nN, gid = wgid / nig, fm = gid * WGM, gsz = (nM - fm) < WGM ? (nM - fm) : WGM;
        u.pm = fm + ((wgid % nig) % gsz); u.pn = (wgid % nig) / gsz; return true;
    }
    __device__ __forceinline__ void a_ready(const Unit&) const {}
    __device__ __forceinline__ void done(const Unit&) const {}
};

__device__ __forceinline__ int static_pm(int M, int N, int G, int c, int i) {
    const int nM = M / BM, nN = N / BM, nwg = nM * nN; const long L = (long)i * G + c; if (L >= nwg) return -1;
    int wgid = (int)L; { const int q = nwg / NXCD, r = nwg % NXCD, xcd = wgid % NXCD, off = wgid / NXCD; wgid = (xcd < r ? xcd * (q + 1) : r * (q + 1) + (xcd - r) * q) + off; }
    const int nig = WGM * nN, gid = wgid / nig, fm = gid * WGM, gsz = (nM - fm) < WGM ? (nM - fm) : WGM;
    return fm + ((wgid % nig) % gsz);
}
__device__ __forceinline__ void st16_wt(void* p, u32x4 v) { asm volatile("global_store_dwordx4 %0, %1, off sc1\n\ts_nop 1" :: "v"(p), "v"(v) : "memory"); }
__device__ __forceinline__ void st16_wt(void* p, f32x4 v) { asm volatile("global_store_dwordx4 %0, %1, off sc1\n\ts_nop 1" :: "v"(p), "v"(v) : "memory"); }
__device__ __forceinline__ void st4_wt(float* p, float v) { asm volatile("global_store_dword %0, %1, off sc1\n\ts_nop 1" :: "v"(p), "v"(v) : "memory"); }
__device__ __forceinline__ void pub_wave(unsigned* cnt) { asm volatile("s_waitcnt vmcnt(0)" ::: "memory"); if (lane_id() == 0) __hip_atomic_fetch_add(cnt, 1u, __ATOMIC_RELAXED, __HIP_MEMORY_SCOPE_AGENT); }
__device__ __forceinline__ void poll_ge(const unsigned* cnt, unsigned need) {
    unsigned sp = 0;
    while ((unsigned)__builtin_amdgcn_readfirstlane((int)__hip_atomic_load((unsigned*)cnt, __ATOMIC_RELAXED, __HIP_MEMORY_SCOPE_AGENT)) < need) { __builtin_amdgcn_s_sleep(2); if (++sp > (1u << 22)) break; }
}
__device__ __forceinline__ void poll_ge_lanes(const unsigned* cnt, unsigned need) {
    unsigned sp = 0;
    for (;;) { const unsigned v = __hip_atomic_load((unsigned*)cnt, __ATOMIC_RELAXED, __HIP_MEMORY_SCOPE_AGENT);
        if (__builtin_amdgcn_ballot_w64(v < need) == 0ull) break;
        __builtin_amdgcn_s_sleep(2); if (++sp > (1u << 22)) break; }
}
__device__ __forceinline__ void acq_agent() { __builtin_amdgcn_fence(__ATOMIC_ACQUIRE, "agent"); asm volatile("s_waitcnt vmcnt(0)" ::: "memory"); }
struct Order5 : StaticOrder { int redeal, x, r; unsigned* grp;
    __device__ __forceinline__ bool next(int i, Unit& u) const { if (!redeal) return StaticOrder::next(i, u);
        const int E = r + 32 * i; if (E >= 176) return false; const int g = E >= 88 ? 1 : 0, e = E - 88 * g; u.pm = 8 * x + 4 * g + (e & 3); u.pn = e >> 2; return true; }
    __device__ __forceinline__ void a_ready(const Unit&) const {}
    __device__ __forceinline__ void done(const Unit& u) const { if (redeal) pub_wave(grp + (u.pm >> 2) * 64); }
};
struct Order6 : StaticOrder { int redeal, pm0, pn0; unsigned* cnt;
    __device__ __forceinline__ bool next(int i, Unit& u) const { if (!redeal) return StaticOrder::next(i, u); if (i != 0) return false; u.pm = pm0; u.pn = pn0; return true; }
    __device__ __forceinline__ void a_ready(const Unit&) const {}
    __device__ __forceinline__ void done(const Unit& u) const { if (redeal && cnt) pub_wave(cnt + u.pm * 64); }
};
struct Order1 : StaticOrder { int redeal, x, r, wv; const unsigned* rdy; unsigned need;
    __device__ __forceinline__ bool next(int i, Unit& u) const { if (!redeal) return StaticOrder::next(i, u);
        int g, j;
        if (r >= 24) { if (i == 0) { g = 0; j = r - 8; } else if (i == 1) { g = 1; j = r - 24; } else return false; }
        else if (r >= 16) { if (i > 1) return false; g = 0; j = r - 16 + 8 * i; }
        else { if (i > 0) return false; g = 1; j = 8 + r; }
        u.pm = 8 * x + 4 * g + (j & 3); u.pn = j >> 2; return true; }
    __device__ __forceinline__ void a_ready(const Unit& u) const {
        if (redeal) { if (wv == 0 && need) { poll_ge(rdy + u.pm * 64, need); acq_agent(); }
            asm volatile("" ::: "memory"); __builtin_amdgcn_s_barrier(); asm volatile("" ::: "memory"); } }
    __device__ __forceinline__ void done(const Unit&) const {}
};

__device__ __forceinline__ unsigned cvt_pk_bf16(float lo, float hi) { unsigned r; asm volatile("v_cvt_pk_bf16_f32 %0, %1, %2" : "=v"(r) : "v"(lo), "v"(hi)); return r; }
typedef float f32x2 __attribute__((ext_vector_type(2)));

template <class Epi, class Sched, bool ALIGN_EPI = false, bool SP2 = false>
__device__ __forceinline__ void gemm_phase(PG8_LAS unsigned char* lds, const Gemm g, const Sched& S, const Epi& E, const int wave_id  ) {
    int tid_l = wave_id * 64 + lane_id(); asm volatile("" : "+v"(tid_l));
    const int tid = tid_l, wid = __builtin_amdgcn_readfirstlane(tid >> 6), lane = tid & 63, wr = wid >> 2, wc = wid & 3, fr = lane & 15, fq = lane >> 4;
    const int K = g.K, nt = K / BK;
    unsigned voffA[2], voffB[2];
#pragma unroll
    for (int i = 0; i < 2; ++i) { int R, C; stage_rc(tid * 16 + i * 8192, R, C); const int Rb = Epi::PERM ? ((R & ~31) + perm32(R & 31)) : R;
        voffA[i] = (unsigned)(R * K + C) * 2u; voffB[i] = (unsigned)(Rb * K + C) * 2u; }
    const size_t kstep = (size_t)(BK * 2);
    const size_t hstep = (size_t)HALF * K * 2;
    const size_t tstep = 2 * hstep;
    const unsigned ldsw = (unsigned)wid * 1024u;
    const int aoff = lds_byte(wr * 64 + fr, fq * 8), boff = lds_byte(wc * 32 + fr, fq * 8);
#define PG8_SA(b, h) (((b) * 2 + (h)) * HTB)
#define PG8_SB(b, h) ((4 + (b) * 2 + (h)) * HTB)
#define PG8_STAGE(bufoff, gbase, voff) do { _Pragma("unroll") for (int _i = 0; _i < 2; ++_i) \
        __builtin_amdgcn_global_load_lds((const unsigned*)((const char*)(gbase) + (voff)[_i]), (PG8_LAS unsigned*)(lds + (bufoff) + ldsw + _i * 8192), 16, 0, 0); } while (0)
#define PG8_LDA(dst, b, h) do { _Pragma("unroll") for (int m = 0; m < 4; ++m) _Pragma("unroll") for (int k = 0; k < 2; ++k) dst[m][k] = *(const PG8_LAS bf16x8*)(lds + PG8_SA(b, h) + aoff + m * 2048 + k * 1024); } while (0)
#define PG8_LDB(dst, b, h) do { _Pragma("unroll") for (int n = 0; n < 2; ++n) _Pragma("unroll") for (int k = 0; k < 2; ++k) dst[n][k] = *(const PG8_LAS bf16x8*)(lds + PG8_SB(b, h) + boff + n * 2048 + k * 1024); } while (0)
#define PG8_MMA(ai, bj, At, Bt) do { __builtin_amdgcn_s_setprio(1); _Pragma("unroll") for (int m = 0; m < 4; ++m) _Pragma("unroll") for (int n = 0; n < 2; ++n) _Pragma("unroll") for (int k = 0; k < 2; ++k) \
        acc[ai][bj][m][n] = __builtin_amdgcn_mfma_f32_16x16x32_bf16(Bt[n][k], At[m][k], acc[ai][bj][m][n], 0, 0, 0); __builtin_amdgcn_s_setprio(0); } while (0)
#define PG8_WAIT_V(n) asm volatile("s_waitcnt vmcnt(" #n ")" ::: "memory")
#define PG8_WAIT_L(n) asm volatile("s_waitcnt lgkmcnt(" #n ")" ::: "memory")
#define PG8_BAR __builtin_amdgcn_s_barrier()
#define PG8_SCHED __builtin_amdgcn_sched_barrier(0)
    Unit cur, nxt; int ui = 0;
    if (!S.next(0, cur)) return;
    f32x4 acc[2][2][4][2];
#pragma unroll
    for (int a = 0; a < 2; ++a)
#pragma unroll
        for (int b = 0; b < 2; ++b)
#pragma unroll
            for (int m = 0; m < 4; ++m)
#pragma unroll
                for (int n = 0; n < 2; ++n) acc[a][b][m][n] = (f32x4){0.f, 0.f, 0.f, 0.f};
    bf16x8 At[4][2], B0[2][2], B1[2][2];
    const char* cA = (const char*)g.A + (size_t)cur.pm * tstep; const char* cB = (const char*)g.Bt + (size_t)cur.pn * tstep;
    S.a_ready(cur);
    if constexpr (SP2) {
        PG8_STAGE(PG8_SB(0, 0), cB, voffB); PG8_STAGE(PG8_SB(0, 1), cB + hstep, voffB); PG8_STAGE(PG8_SA(0, 0), cA, voffA); PG8_STAGE(PG8_SA(0, 1), cA + hstep, voffA);
        if (wr == 1) PG8_BAR;
        PG8_WAIT_V(2); PG8_BAR;
        PG8_STAGE(PG8_SB(1, 0), cB + kstep, voffB); PG8_STAGE(PG8_SA(1, 0), cA + kstep, voffA); PG8_STAGE(PG8_SB(1, 1), cB + hstep + kstep, voffB);
        PG8_WAIT_V(6); PG8_BAR;
    } else {
        PG8_STAGE(PG8_SB(0, 0), cB, voffB); PG8_STAGE(PG8_SA(0, 0), cA, voffA); PG8_STAGE(PG8_SB(0, 1), cB + hstep, voffB); PG8_STAGE(PG8_SA(0, 1), cA + hstep, voffA);
        if (wr == 1) PG8_BAR;
        PG8_WAIT_V(4); PG8_BAR;
        PG8_STAGE(PG8_SB(1, 0), cB + kstep, voffB); PG8_STAGE(PG8_SA(1, 0), cA + kstep, voffA); PG8_STAGE(PG8_SB(1, 1), cB + hstep + kstep, voffB);
        PG8_WAIT_V(6); PG8_BAR;
    }
    for (;;) {
        const bool has_next = S.next(ui + 1, nxt);
        const char* nA = has_next ? (const char*)g.A + (size_t)nxt.pm * tstep : cA; const char* nB = has_next ? (const char*)g.Bt + (size_t)nxt.pn * tstep : cB;
        for (int t = 0; t < nt; t += 2) {
            const bool last = (t == nt - 2);
            const char* a1 = cA + (size_t)(t + 1) * kstep;
            const char* a2 = last ? nA : cA + (size_t)(t + 2) * kstep; const char* b2 = last ? nB : cB + (size_t)(t + 2) * kstep;
            const char* a3 = a2 + kstep; const char* b3 = b2 + kstep;
            if (last && has_next) S.a_ready(nxt);
            if constexpr (SP2) {
            PG8_LDB(B0, 0, 0); PG8_LDB(B1, 0, 1); PG8_SCHED; PG8_LDA(At, 0, 0); PG8_STAGE(PG8_SA(1, 1), a1 + hstep, voffA);
            PG8_WAIT_V(8); PG8_WAIT_L(0); PG8_BAR; PG8_MMA(0, 0, At, B0); PG8_MMA(0, 1, At, B1); PG8_BAR; PG8_SCHED;
            PG8_LDA(At, 0, 1); PG8_STAGE(PG8_SB(0, 0), b2, voffB); PG8_STAGE(PG8_SB(0, 1), b2 + hstep, voffB); PG8_STAGE(PG8_SA(0, 0), a2, voffA);
            PG8_WAIT_V(8); PG8_WAIT_L(0); PG8_BAR; PG8_MMA(1, 0, At, B0); PG8_MMA(1, 1, At, B1); PG8_BAR; PG8_SCHED;
            PG8_LDB(B0, 1, 0); PG8_LDB(B1, 1, 1); PG8_SCHED; PG8_LDA(At, 1, 0); PG8_STAGE(PG8_SA(0, 1), a2 + hstep, voffA);
            PG8_WAIT_V(8); PG8_WAIT_L(0); PG8_BAR; PG8_MMA(0, 0, At, B0); PG8_MMA(0, 1, At, B1); PG8_BAR; PG8_SCHED;
            PG8_LDA(At, 1, 1); PG8_STAGE(PG8_SB(1, 0), b3, voffB); PG8_STAGE(PG8_SB(1, 1), b3 + hstep, voffB); PG8_STAGE(PG8_SA(1, 0), a3, voffA);
            PG8_WAIT_V(8); PG8_WAIT_L(0); PG8_BAR; PG8_MMA(1, 0, At, B0); PG8_MMA(1, 1, At, B1); PG8_BAR; PG8_SCHED;
            } else {
            PG8_LDB(B0, 0, 0); PG8_SCHED; PG8_LDA(At, 0, 0); PG8_STAGE(PG8_SA(1, 1), a1 + hstep, voffA);
            PG8_WAIT_L(8); PG8_BAR; PG8_WAIT_L(0); PG8_MMA(0, 0, At, B0); PG8_BAR; PG8_SCHED;
            PG8_LDB(B1, 0, 1); PG8_STAGE(PG8_SB(0, 0), b2, voffB);
            PG8_BAR; PG8_WAIT_L(0); PG8_MMA(0, 1, At, B1); PG8_BAR;
            PG8_LDA(At, 0, 1); PG8_STAGE(PG8_SA(0, 0), a2, voffA);
            PG8_BAR; PG8_WAIT_L(0); PG8_MMA(1, 0, At, B0); PG8_BAR; PG8_SCHED;
            PG8_STAGE(PG8_SB(0, 1), b2 + hstep, voffB);
            PG8_WAIT_V(6); PG8_BAR; PG8_MMA(1, 1, At, B1); PG8_BAR;
            PG8_LDB(B0, 1, 0); PG8_SCHED; PG8_LDA(At, 1, 0); PG8_STAGE(PG8_SA(0, 1), a2 + hstep, voffA);
            PG8_WAIT_L(8); PG8_BAR; PG8_WAIT_L(0); PG8_MMA(0, 0, At, B0); PG8_BAR; PG8_SCHED;
            PG8_LDB(B1, 1, 1); PG8_STAGE(PG8_SB(1, 0), b3, voffB);
            PG8_BAR; PG8_WAIT_L(0); PG8_MMA(0, 1, At, B1); PG8_BAR;
            PG8_LDA(At, 1, 1); PG8_STAGE(PG8_SA(1, 0), a3, voffA);
            PG8_BAR; PG8_WAIT_L(0); PG8_MMA(1, 0, At, B0); PG8_BAR; PG8_SCHED;
            PG8_STAGE(PG8_SB(1, 1), b3 + hstep, voffB);
            PG8_WAIT_V(6); PG8_BAR; PG8_MMA(1, 1, At, B1); PG8_BAR;
            }
        }
        if constexpr (ALIGN_EPI) { if (wr == 0) PG8_BAR; }
        if constexpr (!Epi::AFTER_DRAIN) { E(acc, cur, wr, wc, fr, fq); S.done(cur); }
        if (!has_next) break;
#pragma unroll
        for (int a = 0; a < 2; ++a)
#pragma unroll
            for (int b = 0; b < 2; ++b)
#pragma unroll
                for (int m = 0; m < 4; ++m)
#pragma unroll
                    for (int n = 0; n < 2; ++n) acc[a][b][m][n] = (f32x4){0.f, 0.f, 0.f, 0.f};
        cur = nxt; cA = nA; cB = nB; ++ui;
        if constexpr (ALIGN_EPI) { if (wr == 1) PG8_BAR; }
    }
    PG8_WAIT_V(0);
    if constexpr (!ALIGN_EPI) { if (wr == 0) PG8_BAR; }
    PG8_BAR;
    if constexpr (Epi::AFTER_DRAIN) { E.fused(acc, cur, wr, wc, fr, fq, lds, wid, lane); S.done(cur); }
#undef PG8_SA
#undef PG8_SB
#undef PG8_STAGE
#undef PG8_LDA
#undef PG8_LDB
#undef PG8_MMA
#undef PG8_WAIT_V
#undef PG8_WAIT_L
#undef PG8_BAR
#undef PG8_SCHED
}
}

namespace pg8 { struct OneUnit { int pm, pn;
    __device__ __forceinline__ bool next(int i, Unit& u) const { if (i != 0) return false; u.pm = pm; u.pn = pn; return true; }
    __device__ __forceinline__ void a_ready(const Unit&) const {}
    __device__ __forceinline__ void done(const Unit&) const {} }; }
namespace pg8 { struct OneUnitPub { int pm, pn; unsigned* cnt;
    __device__ __forceinline__ bool next(int i, Unit& u) const { if (i != 0) return false; u.pm = pm; u.pn = pn; return true; }
    __device__ __forceinline__ void a_ready(const Unit&) const {}
    __device__ __forceinline__ void done(const Unit&) const { pub_wave(cnt); } }; }
namespace pg8 {
__device__ __forceinline__ u32x4 pack8(const f32x4& a, const f32x4& b) { u32x4 w; w.x = cvt_pk_bf16(a[0], a[1]); w.y = cvt_pk_bf16(a[2], a[3]); w.z = cvt_pk_bf16(b[0], b[1]); w.w = cvt_pk_bf16(b[2], b[3]); return w; }
__device__ __forceinline__ float hsum4(const f32x4& v) { return (v[0] + v[1]) + (v[2] + v[3]); }
__device__ __forceinline__ float hsq4(const f32x4& v) { return (v[0] * v[0] + v[1] * v[1]) + (v[2] * v[2] + v[3] * v[3]); }
__device__ __forceinline__ float rstd16(const float* rs, int row, float inv_n) { const f32x4* p = (const f32x4*)(rs + 16 * (size_t)row); const f32x4 a = p[0], b = p[1], c = p[2], d = p[3];
    return rsqrtf(((hsum4(a) + hsum4(b)) + (hsum4(c) + hsum4(d))) * inv_n + EPS); }
__device__ __forceinline__ float rstd4(const float* rs, int row, float inv_n) { const f32x4 a = *(const f32x4*)(rs + 4 * (size_t)row); return rsqrtf(hsum4(a) * inv_n + EPS); }
__device__ __forceinline__ float red_fq(float s) { s += shfl_xor_(s, 16); s += shfl_xor_(s, 32); return s; }
__device__ __forceinline__ float fsigmoid(float x) { return __builtin_amdgcn_rcpf(1.f + __builtin_amdgcn_exp2f(-1.4426950408889634f * x)); }
__device__ __forceinline__ f32x4 unpk_lo(unsigned a, unsigned b) { return (f32x4){__uint_as_float(a << 16), __uint_as_float(a & 0xffff0000u), __uint_as_float(b << 16), __uint_as_float(b & 0xffff0000u)}; }
#define EPI_LAUNDER { const int ln_ = lane_id(); fr = ln_ & 15; fq = ln_ >> 4; }
#define EPI_ROWS_BEGIN _Pragma("unroll") for (int ai = 0; ai < 2; ++ai) _Pragma("unroll") for (int m = 0; m < 4; ++m) { const int row = u.pm * BM + ai * HALF + wr * 64 + m * 16 + fr;
#define EPI_ROWS_END asm volatile("" ::: "memory"); }

struct EpiWin { static constexpr bool PERM = true, AFTER_DRAIN = false;
    const float* rsx; bf16_t* u5; bf16_t* cqb; float* rscq; float* t2f; bf16_t* t2b; float* rskv; float* qkf; bf16_t* gvb; bf16_t* grb; PG8_LAS float* rst;
    __device__ __forceinline__ void operator()(const f32x4 (&acc)[2][2][4][2], const Unit& u, int wr, int wc, int fr, int fq) const {
        EPI_LAUNDER const int cb = wc * 32 + 8 * fq, tid = (wr * 4 + wc) * 64 + fq * 16 + fr;
        if (tid < 256) rst[tid] = rstd16(rsx, u.pm * BM + tid, 1.f / 1024.f);
        asm volatile("s_waitcnt lgkmcnt(0)" ::: "memory"); __builtin_amdgcn_s_barrier(); asm volatile("" ::: "memory");
        EPI_ROWS_BEGIN
            const float r = rst[ai * HALF + wr * 64 + m * 16 + fr];
            f32x4 v[2][2];
#pragma unroll
            for (int bj = 0; bj < 2; ++bj) { v[bj][0] = acc[ai][bj][m][0] * r; v[bj][1] = acc[ai][bj][m][1] * r; }
            if (u.pn == 0) {
#pragma unroll
                for (int bj = 0; bj < 2; ++bj) { const int c = bj * HALF + cb; *(u32x4*)(u5 + ((size_t)(c >> 4) * ::M + row) * 16 + (c & 15)) = pack8(v[bj][0], v[bj][1]); }
            } else if (u.pn == 1) { float s = 0.f;
#pragma unroll
                for (int bj = 0; bj < 2; ++bj) { *(u32x4*)(cqb + (size_t)row * 256 + bj * HALF + cb) = pack8(v[bj][0], v[bj][1]); s += hsq4(v[bj][0]) + hsq4(v[bj][1]); }
                s = red_fq(s); if (fq == 0) rscq[(size_t)row * 4 + wc] = s;
            } else if (u.pn == 2) {
#pragma unroll
                for (int bj = 0; bj < 2; ++bj) { float* p = t2f + (size_t)row * 256 + bj * HALF + cb; *(f32x4*)p = v[bj][0]; *(f32x4*)(p + 4) = v[bj][1];
                    *(u32x4*)(t2b + (size_t)row * 256 + bj * HALF + cb) = pack8(v[bj][0], v[bj][1]); }
                const float s = red_fq(hsq4(v[0][0]) + hsq4(v[0][1])); if (fq == 0) rskv[(size_t)row * 4 + wc] = s;
            } else if (u.pn == 3) {
#pragma unroll
                for (int bj = 0; bj < 2; ++bj) { float* p = qkf + (size_t)row * 256 + bj * HALF + cb; *(f32x4*)p = v[bj][0]; *(f32x4*)(p + 4) = v[bj][1]; }
            } else { bf16_t* dst = u.pn == 4 ? gvb : grb;
#pragma unroll
                for (int bj = 0; bj < 2; ++bj) *(u32x4*)(dst + (size_t)row * 256 + bj * HALF + cb) = pack8(v[bj][0], v[bj][1]);
            }
        EPI_ROWS_END
    }
};
struct EpiQ { static constexpr bool PERM = true, AFTER_DRAIN = false;
    const float* rscq; const float* cosT; const float* sinT; bf16_t* qn; bf16_t* qp;
    __device__ __forceinline__ void operator()(const f32x4 (&acc)[2][2][4][2], const Unit& u, int wr, int wc, int fr, int fq) const {
        EPI_LAUNDER const int cb = wc * 32 + 8 * fq;
        EPI_ROWS_BEGIN
            const float r = rstd4(rscq, row, 1.f / 256.f) * QSCALE;
            if (u.pn < 2) {
#pragma unroll
                for (int bj = 0; bj < 2; ++bj) *(u32x4*)(qn + (size_t)row * 512 + u.pn * 256 + bj * HALF + cb) = pack8(acc[ai][bj][m][0] * r, acc[ai][bj][m][1] * r);
            } else { const int pos = row & (SEQ - 1); const f32x4 cs = *(const f32x4*)(cosT + pos * 16 + 4 * fq), sn = *(const f32x4*)(sinT + pos * 16 + 4 * fq);
#pragma unroll
                for (int bj = 0; bj < 2; ++bj) { const f32x4 x1 = acc[ai][bj][m][0] * r, x2 = acc[ai][bj][m][1] * r;
                    *(u32x4*)(qp + (size_t)row * 256 + bj * HALF + cb) = pack8(x1 * cs - x2 * sn, x1 * sn + x2 * cs); }
            }
        EPI_ROWS_END
    }
};
struct EpiKV { static constexpr bool PERM = true, AFTER_DRAIN = false;
    const float* rskv; bf16_t* kn; bf16_t* vb;
    __device__ __forceinline__ void operator()(const f32x4 (&acc)[2][2][4][2], const Unit& u, int wr, int wc, int fr, int fq) const {
        EPI_LAUNDER const int cb = wc * 32 + 8 * fq; bf16_t* dst = (u.pn < 2 ? kn : vb) + (u.pn & 1) * 256;
        EPI_ROWS_BEGIN
            const float r = rstd4(rskv, row, 1.f / 128.f);
#pragma unroll
            for (int bj = 0; bj < 2; ++bj) *(u32x4*)(dst + (size_t)row * 512 + bj * HALF + cb) = pack8(acc[ai][bj][m][0] * r, acc[ai][bj][m][1] * r);
        EPI_ROWS_END
    }
};
struct EpiGlu { static constexpr bool PERM = true, AFTER_DRAIN = false;
    const bf16_t* y5; const float* bias; bf16_t* mix;
    __device__ __forceinline__ void operator()(const f32x4 (&acc)[2][2][4][2], const Unit& u, int wr, int wc, int fr, int fq) const {
        EPI_LAUNDER const int cb = wc * 32 + 8 * fq;
        EPI_ROWS_BEGIN
#pragma unroll
            for (int bj = 0; bj < 2; ++bj) { const int c = bj * HALF + cb; const u32x4 yw = *(const u32x4*)(y5 + (size_t)row * 256 + c);
                const f32x4 y0 = unpk_lo(yw.x, yw.y), y1 = unpk_lo(yw.z, yw.w), b0 = *(const f32x4*)(bias + c), b1 = *(const f32x4*)(bias + c + 4);
                f32x4 o0, o1;
#pragma unroll
                for (int e = 0; e < 4; ++e) { o0[e] = y0[e] * fsigmoid(acc[ai][bj][m][0][e] + b0[e]); o1[e] = y1[e] * fsigmoid(acc[ai][bj][m][1][e] + b1[e]); }
                st16_wt(mix + (size_t)row * DM + c, pack8(o0, o1)); }
        EPI_ROWS_END
    }
};
template <bool WT> struct EpiResidT { static constexpr bool PERM = true, AFTER_DRAIN = false;
    const float* xin_f32; bf16_t* xb; float* rsx;
    __device__ __forceinline__ void operator()(const f32x4 (&acc)[2][2][4][2], const Unit& u, int wr, int wc, int fr, int fq) const {
        EPI_LAUNDER const int cb = wc * 32 + 8 * fq;
        EPI_ROWS_BEGIN
            float s = 0.f;
#pragma unroll
            for (int bj = 0; bj < 2; ++bj) { const size_t o = (size_t)row * DM + u.pn * 256 + bj * HALF + cb;
                f32x4 a0, a1;
                if (xin_f32) { a0 = *(const f32x4*)(xin_f32 + o); a1 = *(const f32x4*)(xin_f32 + o + 4); }
                else { const u32x4 w = *(const u32x4*)(xb + o); a0 = unpk_lo(w.x, w.y); a1 = unpk_lo(w.z, w.w); }
                a0 = a0 + acc[ai][bj][m][0]; a1 = a1 + acc[ai][bj][m][1];
                if (WT) st16_wt(xb + o, pack8(a0, a1)); else *(u32x4*)(xb + o) = pack8(a0, a1); s += hsq4(a0) + hsq4(a1); }
            s = red_fq(s); if (fq == 0) { if (WT) st4_wt(rsx + (size_t)row * 16 + u.pn * 4 + wc, s); else rsx[(size_t)row * 16 + u.pn * 4 + wc] = s; }
        EPI_ROWS_END
    }
};
using EpiResid = EpiResidT<false>;
template <int CTRL> __device__ __forceinline__ float dpp_mov(float x) { return __builtin_bit_cast(float, __builtin_amdgcn_update_dpp(0, __builtin_bit_cast(int, x), CTRL, 0xf, 0xf, false)); }
__device__ __forceinline__ float fgelu(float x) { const float t = x * x; const float u = x * (1.5957691216057308f + 0.07135481627159432f * t);
    return x * __builtin_amdgcn_rcpf(1.f + __builtin_amdgcn_exp2f(-1.4426950408889634f * u)); }
struct EpiFfi { static constexpr bool PERM = true, AFTER_DRAIN = false;
    const float* rsx; const float* cw; const float* cbias; bf16_t* h; float* fv; float* fg; float* lg; float* convout; PG8_LAS float* xch;
    __device__ __forceinline__ void operator()(const f32x4 (&acc)[2][2][4][2], const Unit& u, int wr, int wc, int fr, int fq) const {
        EPI_LAUNDER const int cb = wc * 32 + 8 * fq, c0 = u.pn * HALF + cb, tid = (wr * 4 + wc) * 64 + fq * 16 + fr;
        PG8_LAS float* RST = xch + 1024;
        if (tid < 256) RST[tid] = rstd16(rsx, u.pm * BM + tid, 1.f / 1024.f);
#pragma unroll
        for (int ai = 0; ai < 2; ++ai) if (fr >= 14) { PG8_LAS float* p = xch + ((2 * ai + wr) * 2 + (fr - 14)) * 128 + cb; *(PG8_LAS f32x4*)p = acc[ai][1][3][0]; *(PG8_LAS f32x4*)(p + 4) = acc[ai][1][3][1]; }
        f32x4 w0[2], w1[2], w2[2], bb[2];
#pragma unroll
        for (int n = 0; n < 2; ++n) { w0[n] = *(const f32x4*)(cw + c0 + 4 * n); w1[n] = *(const f32x4*)(cw + DFF + c0 + 4 * n); w2[n] = *(const f32x4*)(cw + 2 * DFF + c0 + 4 * n); bb[n] = *(const f32x4*)(cbias + c0 + 4 * n); }
        asm volatile("s_waitcnt lgkmcnt(0)" ::: "memory"); __builtin_amdgcn_s_barrier(); asm volatile("" ::: "memory");
#pragma unroll
        for (int ai = 0; ai < 2; ++ai) { const int bnd = 2 * ai + wr;
            f32x4 hp0[2], hp1[2], gp[2];
            { const int pb_ = bnd > 0 ? bnd - 1 : 0; const float r0 = bnd > 0 ? RST[64 * bnd - 2] : 0.f, r1 = bnd > 0 ? RST[64 * bnd - 1] : 0.f;
#pragma unroll
              for (int n = 0; n < 2; ++n) { hp0[n] = *(const PG8_LAS f32x4*)(xch + (pb_ * 2 + 0) * 128 + cb + 4 * n) * r0; hp1[n] = *(const PG8_LAS f32x4*)(xch + (pb_ * 2 + 1) * 128 + cb + 4 * n) * r1; gp[n] = hp0[n]; } }
#pragma unroll
            for (int m = 0; m < 4; ++m) { const int rit = ai * HALF + wr * 64 + m * 16 + fr, row = u.pm * BM + rit; const float r = RST[rit];
                f32x4 g[2], vv[2], hv[2];
#pragma unroll
                for (int n = 0; n < 2; ++n) { g[n] = acc[ai][1][m][n] * r; vv[n] = acc[ai][0][m][n] * r;
#pragma unroll
                    for (int e = 0; e < 4; ++e) { const float a1 = dpp_mov<0x121>(g[n][e]), a2 = dpp_mov<0x122>(g[n][e]);
                        const float b1 = m == 0 ? hp1[n][e] : dpp_mov<0x121>(gp[n][e]), b2 = m == 0 ? (fr == 1 ? hp1[n][e] : hp0[n][e]) : dpp_mov<0x122>(gp[n][e]);
                        const float p1 = fr >= 1 ? a1 : b1, p2 = fr >= 2 ? a2 : b2;
                        const float cv = bb[n][e] + w0[n][e] * p2 + w1[n][e] * p1 + w2[n][e] * g[n][e];
                        hv[n][e] = fgelu(cv) * vv[n][e]; } }
                if (m == 0 && bnd == 0 && fr < 2) { float* p = fv + ((size_t)u.pm * 2 + fr) * DFF + c0; st16_wt(p, vv[0]); st16_wt(p + 4, vv[1]); float* q = fg + ((size_t)u.pm * 2 + fr) * DFF + c0; st16_wt(q, g[0]); st16_wt(q + 4, g[1]); }
                else st16_wt(h + (size_t)row * DFF + c0, pack8(hv[0], hv[1]));
                if (m == 3 && bnd == 3 && fr >= 14) { float* p = lg + ((size_t)u.pm * 2 + (fr - 14)) * DFF + c0; st16_wt(p, g[0]); st16_wt(p + 4, g[1]);
                    if ((u.pm & 7) == 7) { float* q = convout + ((size_t)(u.pm >> 3) * 2 + (fr - 14)) * DFF + c0; *(f32x4*)q = g[0]; *(f32x4*)(q + 4) = g[1]; } }
                gp[0] = g[0]; gp[1] = g[1];
                asm volatile("" ::: "memory"); }
        }
    }
};
}

#include <hip/hip_bf16.h>
#include <cmath>
namespace attn_body {
using bf16=__hip_bfloat16;
using bf16x8=__attribute__((ext_vector_type(8)))short;
using s16x4=__attribute__((ext_vector_type(4)))short;
using f32x16=__attribute__((ext_vector_type(16)))float;
using u32x4=__attribute__((ext_vector_type(4)))unsigned;
constexpr int BATCH=8,NHEAD=8,SEQ=2048,D=64,DR=32;
constexpr int QNP=512,QPP=256,KNP=512,KPP=32,VP=512,OP=1024,OCOL=256;
constexpr int NW=8,QBLK=32,QB=QBLK*NW,KVBLK=64,NQB=SEQ/QB;
constexpr int ATTN_UNIT_ROWS=QB;
__device__ __forceinline__ int crow(int r,int hi){return (r&3)+8*(r>>2)+4*hi;}
#define SBAR() __builtin_amdgcn_sched_barrier(0)
__device__ __forceinline__ void cmask(f32x16&p0,f32x16&p1,int jb,int qrel,int hi){
  const float NEG=-INFINITY; int kb=64*jb+4*hi;
  #pragma unroll
  for(int r=0;r<16;++r){int kv=kb+(r&3)+8*(r>>2); if(kv>qrel)p0[r]=NEG; if(kv+32>qrel)p1[r]=NEG;}
}

constexpr int NSLOT=3, SLOTB=8192, KSLOTB=12288;
constexpr int LDS_K=0, LDS_V=NSLOT*KSLOTB, LDS_WS=LDS_V+NSLOT*SLOTB, LDS_OST=LDS_WS+NW*64*4, LDS_BYTES=LDS_OST+NW*4096;
constexpr float C2=0.10206207261596575f*1.4426950408889634f;
__device__ __forceinline__ void glds16(const void*gsrc,unsigned lds_dst){unsigned keep;
  asm volatile("s_mov_b32 %0, m0\n\ts_mov_b32 m0, %2\n\ts_nop 0\n\tglobal_load_lds_dwordx4 %1, off\n\ts_mov_b32 m0, %0":"=&s"(keep):"v"(gsrc),"s"(lds_dst):"memory");}
__device__ __forceinline__ float max3f(float a,float b,float c){float r;asm("v_max3_f32 %0, %1, %2, %3":"=v"(r):"v"(a),"v"(b),"v"(c));return r;}
__device__ __forceinline__ float max2f(float a,float b){float r;asm("v_max_f32_e32 %0, %1, %2":"=v"(r):"v"(a),"v"(b));return r;}
__device__ __forceinline__ float fadd_s(float a,float b){float r;asm("v_add_f32_e32 %0, %1, %2":"=v"(r):"v"(a),"v"(b));return r;}
__device__ __forceinline__ float fsub_s(float a,float b){float r;asm("v_sub_f32_e32 %0, %1, %2":"=v"(r):"v"(a),"v"(b));return r;}
typedef float f32x2_t __attribute__((ext_vector_type(2))); typedef __bf16 bf16x2_t __attribute__((ext_vector_type(2)));
__device__ __forceinline__ unsigned cvtpk_s(float lo,float hi){f32x2_t v={lo,hi};bf16x2_t b=__builtin_convertvector(v,bf16x2_t);return __builtin_bit_cast(unsigned,b);}
#define WAIT_BAR(N) asm volatile("s_waitcnt vmcnt(" #N ") lgkmcnt(0)\n\ts_barrier":::"memory")

__device__ __forceinline__ void qkt(f32x16&p0,f32x16&p1,const char*Kslot,const bf16x8*qr,const f32x16&negm,int r32,int hi){
  const char*kb=Kslot+hi*1024+r32*16;
  #pragma unroll
  for(int d0=0;d0<6;++d0){
    const bf16x8 b0=*reinterpret_cast<const bf16x8*>(kb+d0*2048);
    const bf16x8 b1=*reinterpret_cast<const bf16x8*>(kb+d0*2048+512);
    if(d0==0){p0=__builtin_amdgcn_mfma_f32_32x32x16_bf16(b0,qr[0],negm,0,0,0);p1=__builtin_amdgcn_mfma_f32_32x32x16_bf16(b1,qr[0],negm,0,0,0);}
    else{p0=__builtin_amdgcn_mfma_f32_32x32x16_bf16(b0,qr[d0],p0,0,0,0);p1=__builtin_amdgcn_mfma_f32_32x32x16_bf16(b1,qr[d0],p1,0,0,0);}}
}
typedef __attribute__((address_space(3))) const char* lds_cptr;
typedef short v4i16_t __attribute__((ext_vector_type(4)));
__device__ __forceinline__ void kload8(bf16x8*kf,lds_cptr kp){
  kf[0]=*(const __attribute__((address_space(3))) bf16x8*)(kp);      kf[1]=*(const __attribute__((address_space(3))) bf16x8*)(kp+512);
  kf[2]=*(const __attribute__((address_space(3))) bf16x8*)(kp+2048); kf[3]=*(const __attribute__((address_space(3))) bf16x8*)(kp+2560);
  kf[4]=*(const __attribute__((address_space(3))) bf16x8*)(kp+4096); kf[5]=*(const __attribute__((address_space(3))) bf16x8*)(kp+4608);
  kf[6]=*(const __attribute__((address_space(3))) bf16x8*)(kp+6144); kf[7]=*(const __attribute__((address_space(3))) bf16x8*)(kp+6656);
  kf[8]=*(const __attribute__((address_space(3))) bf16x8*)(kp+8192); kf[9]=*(const __attribute__((address_space(3))) bf16x8*)(kp+8704);
  kf[10]=*(const __attribute__((address_space(3))) bf16x8*)(kp+10240); kf[11]=*(const __attribute__((address_space(3))) bf16x8*)(kp+10752);
}
__device__ __forceinline__ void kload2(bf16x8*kf,lds_cptr kp,int j){ kf[2*j]=*(const __attribute__((address_space(3))) bf16x8*)(kp+j*2048); kf[2*j+1]=*(const __attribute__((address_space(3))) bf16x8*)(kp+j*2048+512); }
__device__ __forceinline__ s16x4 vtr(lds_cptr p){ return __builtin_bit_cast(s16x4,__builtin_amdgcn_ds_read_tr16_b64_v4i16((__attribute__((address_space(3))) v4i16_t*)p)); }
__device__ __forceinline__ float rowmax(const f32x16&p0,const f32x16&p1){
  float a=max3f(p0[0],p0[1],p1[0]),b=max3f(p0[2],p0[3],p1[1]);a=max3f(a,p1[2],p1[3]);
  #pragma unroll
  for(int r=4;r<16;r+=4){a=max3f(a,p0[r],p0[r+1]);b=max3f(b,p0[r+2],p0[r+3]);a=max3f(a,p1[r],p1[r+1]);b=max3f(b,p1[r+2],p1[r+3]);}
  const float m=max2f(a,b);
  auto rr=__builtin_amdgcn_permlane32_swap(__float_as_uint(m),__float_as_uint(m),false,false);
  return max2f(__uint_as_float(rr[0]),__uint_as_float(rr[1]));
}
__device__ __forceinline__ void pv(f32x16*o,int vb,bf16x8 pa0,bf16x8 pa1,bf16x8 pa2,bf16x8 pa3){
  #pragma unroll
  for(int d0=0;d0<2;++d0){s16x4 lo[4],hi[4];
    #pragma unroll
    for(int ks=0;ks<4;++ks){
      asm volatile("ds_read_b64_tr_b16 %0,%1 offset:%c2":"=&v"(lo[ks]):"v"(vb),"i"(d0*4096+ks*1024):"memory");
      asm volatile("ds_read_b64_tr_b16 %0,%1 offset:%c2":"=&v"(hi[ks]):"v"(vb),"i"(d0*4096+ks*1024+512):"memory");}
    asm volatile("s_waitcnt lgkmcnt(0)":::"memory");SBAR();
    #define PK(k) (bf16x8){lo[k][0],lo[k][1],lo[k][2],lo[k][3],hi[k][0],hi[k][1],hi[k][2],hi[k][3]}
    o[d0]=__builtin_amdgcn_mfma_f32_32x32x16_bf16(pa0,PK(0),o[d0],0,0,0);
    o[d0]=__builtin_amdgcn_mfma_f32_32x32x16_bf16(pa1,PK(1),o[d0],0,0,0);
    o[d0]=__builtin_amdgcn_mfma_f32_32x32x16_bf16(pa2,PK(2),o[d0],0,0,0);
    o[d0]=__builtin_amdgcn_mfma_f32_32x32x16_bf16(pa3,PK(3),o[d0],0,0,0);
    #undef PK
  }
}

#ifndef ATTN_STORE16
#define ATTN_STORE16(p,v) pg8::st16_wt((void*)(p),(v))
#endif
template<int THRL> __device__ __forceinline__ void attn_unit(const int wave_id,int b,int h,int qb,const bf16*QN,const bf16*QP,const bf16*__restrict__ KN,const bf16*__restrict__ KP,const bf16*__restrict__ V,bf16*O,char*shm){
  int tid_=wave_id*64+lane_id(); asm volatile("":"+v"(tid_)); const int tid=tid_,lane=tid&63,r32=lane&31,hi=lane>>5; const int wid=__builtin_amdgcn_readfirstlane(tid>>6);
  const long rowbase=(long)b*SEQ; const int q0=qb*QB;
  const bf16*Qwn=QN+(rowbase+q0+wid*QBLK)*QNP+h*D,*Qwp=QP+(rowbase+q0+wid*QBLK)*QPP+h*DR;
  const bf16*Kh=KN+rowbase*KNP+h*D,*Kr=KP+rowbase*KPP,*Vh=V+rowbase*VP+h*D;
  const unsigned lds0=(unsigned)(uintptr_t)shm;
  float*wsf=(float*)(shm+LDS_WS)+wid*64;
  const bf16*ksrc=Kh+(long)lane*KNP+wid*8;
  const bf16*ksrc2=Kr+(long)lane*KPP+(wid&3)*8;
  const bf16*vsrc=Vh+(long)(16*(wid&3)+(lane>>2))*VP+(wid>>2)*32+(lane&3)*8;
  const unsigned kdst=lds0+LDS_K+wid*1024, kdst2=lds0+LDS_K+(8+(wid&3))*1024, vdst=lds0+LDS_V+wid*1024;
  #define KS_(slot) ((slot)+((slot)>>1))
  #define DMA_K(t,slot) do{ glds16(ksrc+(long)(t)*KVBLK*KNP,(unsigned)__builtin_amdgcn_readfirstlane(kdst+KS_(slot))); glds16(ksrc2+(long)(t)*KVBLK*KPP,(unsigned)__builtin_amdgcn_readfirstlane(kdst2+KS_(slot))); }while(0)
  #define DMA_V(t,slot) glds16(vsrc+(long)(t)*KVBLK*VP,(unsigned)__builtin_amdgcn_readfirstlane(vdst+(slot)))
  const int vb0=(int)(lds0+LDS_V)+((lane>>4)&1)*32+(lane&3)*8+(4*hi+((lane&15)>>2))*64;
  const char*Kbase=shm+LDS_K; bf16x8 kf[12];
  const lds_cptr shm3=(lds_cptr)shm; const lds_cptr kp0=shm3+LDS_K+hi*1024+r32*16; const lds_cptr vp0=shm3+LDS_V+((lane>>4)&1)*32+(lane&3)*8+(4*hi+((lane&15)>>2))*64;
  const int NT=(q0+QB)/KVBLK;
  DMA_K(0,0);DMA_V(0,0);DMA_K(1,SLOTB);
  bf16x8 qr[6];
  #pragma unroll
  for(int d0=0;d0<4;++d0)qr[d0]=*reinterpret_cast<const bf16x8*>(&Qwn[(long)r32*QNP+d0*16+hi*8]);
  #pragma unroll
  for(int d0=0;d0<2;++d0)qr[4+d0]=*reinterpret_cast<const bf16x8*>(&Qwp[(long)r32*QPP+d0*16+hi*8]);
  float mhat=0.f,l_reg=0.f;f32x16 o[2];o[0]=f32x16{};o[1]=f32x16{};const f32x16 zero16=f32x16{};
  const int qrel=wid*QBLK+r32;
  #define CMASK(P0,P1,t) do{int jb_=(t)-(NT-4); if(jb_>=0)cmask(P0,P1,jb_,qrel,hi);}while(0)
  bool resc=false;
  #define START(P0,P1) do{ const float rm=rowmax(P0,P1); resc=false; \
    { const float dl=rm; mhat=fadd_s(mhat,dl); \
      _Pragma("unroll") for(int r=0;r<16;++r){P0[r]=fsub_s(P0[r],dl);P1[r]=fsub_s(P1[r],dl);} } \
    _Pragma("unroll") for(int r=0;r<16;++r)P0[r]=__builtin_amdgcn_exp2f(P0[r]); }while(0)
  #define RESC() do{ if(resc){ asm volatile("s_waitcnt lgkmcnt(0)":::"memory"); \
      _Pragma("unroll") for(int d_=0;d_<2;++d_) _Pragma("unroll") for(int r=0;r<16;++r)o[d_][r]*=wsf[crow(r,hi)]; } }while(0)
  f32x16 pA0,pA1,pB0,pB1;
  int sl_prev=0,sl_cur=0,sl_next=SLOTB;
  #define ROT() do{sl_prev=sl_cur;sl_cur=sl_next;sl_next=(sl_next==(NSLOT-1)*SLOTB)?0:sl_next+SLOTB;}while(0)
  DMA_K(2,2*SLOTB);
  WAIT_BAR(5);
  qkt(pA0,pA1,Kbase,qr,zero16,r32,hi);asm volatile("s_nop 15\n\ts_nop 7":"+v"(pA0),"+v"(pA1));CMASK(pA0,pA1,0);
  START(pA0,pA1);
  _Pragma("unroll") for(int r=0;r<16;++r)pA1[r]=__builtin_amdgcn_exp2f(pA1[r]);
  WAIT_BAR(0);
  DMA_K(3,0);DMA_V(1,SLOTB);
  ROT();
  kload8(kf,kp0+KS_(sl_cur));
  WAIT_BAR(3);
  s16x4 vlo[8],vhi[8]; u32x4 pw0,pw1,pw2,pw3;
  #define PKW(P,B) cvtpk_s(P[B],P[B+1])
  #define PAF(k) __builtin_bit_cast(bf16x8,pw##k)
  #define VFR(i) (bf16x8){vlo[i][0],vlo[i][1],vlo[i][2],vlo[i][3],vhi[i][0],vhi[i][1],vhi[i][2],vhi[i][3]}
  #define PIN(x) asm volatile("":"+v"(x))
  #define MX3(a,b,c) __builtin_fmaxf(__builtin_fmaxf((a),(b)),(c))
  #define GAPA(MF,A0,A1,A2,A3,W0,W1,PW) do{ MF; sacc+=A0; sacc+=A1; sacc+=A2; sacc+=A3; PIN(sacc); W0; W1; PIN(PW); SBAR(); }while(0)
  #define EX(v) __builtin_amdgcn_exp2f(v)
  #define GAPB(MF,X,B) do{ MF; X[B]=EX(X[B]); X[B+1]=EX(X[B+1]); X[B+2]=EX(X[B+2]); X[B+3]=EX(X[B+3]); PIN(X); SBAR(); }while(0)
  #define VRD(i) do{ vlo[i]=vtr(vp_+(((i)>>2)*4096+((i)&3)*1024)); vhi[i]=vtr(vp_+(((i)>>2)*4096+((i)&3)*1024+512)); }while(0)
  #define KRD(G,j) do{ if(G){ kload2(kf,kp0+KS_(sl_next),j); SBAR(); } }while(0)
  #define STEP(C0,C1,P0,P1,t,GK,GV,GL) do{ SBAR(); \
    const lds_cptr vp_=vp0+sl_prev; \
    VRD(0); SBAR(); float sacc=(P0[0]+P0[1]); \
    GAPA(C0=__builtin_amdgcn_mfma_f32_32x32x16_bf16(kf[0],qr[0],zero16,0,0,0), P0[2],P0[3],P0[4],P0[5],     pw0[0]=PKW(P0,0), pw0[1]=PKW(P0,2), pw0); \
    VRD(4); SBAR(); GAPA(C1=__builtin_amdgcn_mfma_f32_32x32x16_bf16(kf[1],qr[0],zero16,0,0,0), P0[6],P0[7],P0[8],P0[9],     pw0[2]=PKW(P0,4), pw0[3]=PKW(P0,6), pw0); \
    VRD(1); SBAR(); GAPA(C0=__builtin_amdgcn_mfma_f32_32x32x16_bf16(kf[2],qr[1],C0,0,0,0),   P0[10],P0[11],P0[12],P0[13], pw1[0]=PKW(P0,8), pw1[1]=PKW(P0,10), pw1); \
    VRD(5); SBAR(); GAPA(C1=__builtin_amdgcn_mfma_f32_32x32x16_bf16(kf[3],qr[1],C1,0,0,0),   P0[14],P0[15],P1[0],P1[1],   pw1[2]=PKW(P0,12),pw1[3]=PKW(P0,14), pw1); \
    VRD(2); SBAR(); GAPA(C0=__builtin_amdgcn_mfma_f32_32x32x16_bf16(kf[4],qr[2],C0,0,0,0),   P1[2],P1[3],P1[4],P1[5],     pw2[0]=PKW(P1,0), pw2[1]=PKW(P1,2), pw2); \
    VRD(6); SBAR(); GAPA(C1=__builtin_amdgcn_mfma_f32_32x32x16_bf16(kf[5],qr[2],C1,0,0,0),   P1[6],P1[7],P1[8],P1[9],     pw2[2]=PKW(P1,4), pw2[3]=PKW(P1,6), pw2); \
    VRD(3); SBAR(); GAPA(C0=__builtin_amdgcn_mfma_f32_32x32x16_bf16(kf[6],qr[3],C0,0,0,0),   P1[10],P1[11],P1[12],P1[13], pw3[0]=PKW(P1,8), pw3[1]=PKW(P1,10), pw3); \
    VRD(7); SBAR(); GAPA(C1=__builtin_amdgcn_mfma_f32_32x32x16_bf16(kf[7],qr[3],C1,0,0,0),   P1[14],P1[15],0.f,0.f,       pw3[2]=PKW(P1,12),pw3[3]=PKW(P1,14), pw3); \
    C0=__builtin_amdgcn_mfma_f32_32x32x16_bf16(kf[8],qr[4],C0,0,0,0); C1=__builtin_amdgcn_mfma_f32_32x32x16_bf16(kf[9],qr[4],C1,0,0,0); \
    C0=__builtin_amdgcn_mfma_f32_32x32x16_bf16(kf[10],qr[5],C0,0,0,0); C1=__builtin_amdgcn_mfma_f32_32x32x16_bf16(kf[11],qr[5],C1,0,0,0); SBAR(); \
    _Pragma("unroll") for(int r=0;r<16;++r){C0[r]-=mhat;C1[r]-=mhat;} \
    l_reg+=sacc; \
    if(GK){DMA_K((t)+3,sl_cur);} if(GV){DMA_V((t)+1,sl_next);} \
    CMASK(C0,C1,t); \
    { float a=MX3(C0[0],C0[1],C1[0]),b=MX3(C0[2],C0[3],C1[1]); a=MX3(a,C1[2],C1[3]); \
      _Pragma("unroll") for(int r=4;r<16;r+=4){a=MX3(a,C0[r],C0[r+1]);b=MX3(b,C0[r+2],C0[r+3]);a=MX3(a,C1[r],C1[r+1]);b=MX3(b,C1[r+2],C1[r+3]);} \
      float rm=__builtin_fmaxf(a,b); { auto rr=__builtin_amdgcn_permlane32_swap(__float_as_uint(rm),__float_as_uint(rm),false,false); rm=__builtin_fmaxf(__uint_as_float(rr[0]),__uint_as_float(rr[1])); } \
      resc=false; \
      if(__builtin_expect(__any(rm>(float)THRL),0)){ const float dl=__builtin_fmaxf(rm,0.f); mhat+=dl; \
        _Pragma("unroll") for(int r=0;r<16;++r){C0[r]-=dl;C1[r]-=dl;} \
        const float f=__builtin_amdgcn_exp2f(-dl); l_reg*=f; if(hi==0)wsf[r32]=f; resc=true; } } \
    SBAR(); \
    GAPB(o[0]=__builtin_amdgcn_mfma_f32_32x32x16_bf16(PAF(0),VFR(0),o[0],0,0,0), C0,0); \
    GAPB(o[1]=__builtin_amdgcn_mfma_f32_32x32x16_bf16(PAF(0),VFR(4),o[1],0,0,0), C0,4); \
    KRD(GL,0); GAPB(o[0]=__builtin_amdgcn_mfma_f32_32x32x16_bf16(PAF(1),VFR(1),o[0],0,0,0), C0,8); \
    KRD(GL,1); GAPB(o[1]=__builtin_amdgcn_mfma_f32_32x32x16_bf16(PAF(1),VFR(5),o[1],0,0,0), C0,12); \
    KRD(GL,2); GAPB(o[0]=__builtin_amdgcn_mfma_f32_32x32x16_bf16(PAF(2),VFR(2),o[0],0,0,0), C1,0); \
    KRD(GL,3); GAPB(o[1]=__builtin_amdgcn_mfma_f32_32x32x16_bf16(PAF(2),VFR(6),o[1],0,0,0), C1,4); \
    KRD(GL,4); GAPB(o[0]=__builtin_amdgcn_mfma_f32_32x32x16_bf16(PAF(3),VFR(3),o[0],0,0,0), C1,8); \
    KRD(GL,5); GAPB(o[1]=__builtin_amdgcn_mfma_f32_32x32x16_bf16(PAF(3),VFR(7),o[1],0,0,0), C1,12); \
    }while(0)
  int t=1;
  #undef CMASK
  #define CMASK(P0,P1,t) do{}while(0)
  for(;t+5<NT;t+=2){
    STEP(pB0,pB1,pA0,pA1,t,true,true,true);     WAIT_BAR(3); RESC(); ROT();
    STEP(pA0,pA1,pB0,pB1,t+1,true,true,true);   WAIT_BAR(3); RESC(); ROT();
  }
  #undef CMASK
  #define CMASK(P0,P1,t) do{int jb_=(t)-(NT-4); if(jb_>=0)cmask(P0,P1,jb_,qrel,hi);}while(0)
  #define ENDW(tt) do{ if((tt)+3<NT){WAIT_BAR(3);} else if((tt)+2<NT){WAIT_BAR(1);} else {WAIT_BAR(0);} }while(0)
  for(;t+1<NT;t+=2){
    STEP(pB0,pB1,pA0,pA1,t,(t+3<NT),(t+1<NT),(t+1<NT));       ENDW(t);   RESC(); ROT();
    STEP(pA0,pA1,pB0,pB1,t+1,(t+4<NT),(t+2<NT),(t+2<NT));     ENDW(t+1); RESC(); ROT();
  }
  STEP(pB0,pB1,pA0,pA1,NT-1,false,false,false); RESC();
  { float sacc=pB0[0]+pB0[1]; _Pragma("unroll") for(int r=2;r<16;++r)sacc+=pB0[r]; _Pragma("unroll") for(int r=0;r<16;++r)sacc+=pB1[r]; l_reg+=sacc;
    pw0=(u32x4){PKW(pB0,0),PKW(pB0,2),PKW(pB0,4),PKW(pB0,6)};pw1=(u32x4){PKW(pB0,8),PKW(pB0,10),PKW(pB0,12),PKW(pB0,14)};pw2=(u32x4){PKW(pB1,0),PKW(pB1,2),PKW(pB1,4),PKW(pB1,6)};pw3=(u32x4){PKW(pB1,8),PKW(pB1,10),PKW(pB1,12),PKW(pB1,14)};
    SBAR(); pv(o,vb0+sl_cur,PAF(0),PAF(1),PAF(2),PAF(3)); }
  #undef PKW
  #undef PAF
  #undef VFR
  #undef PIN
  #undef MX3
  #undef GAPA
  #undef GAPB
  #undef EX
  #undef VRD
  #undef KRD
  #undef STEP
  #undef ENDW
  {auto rr=__builtin_amdgcn_permlane32_swap(__float_as_uint(l_reg),__float_as_uint(l_reg),false,false);l_reg=__uint_as_float(rr[0])+__uint_as_float(rr[1]);}
  if(hi==0)wsf[32+r32]=l_reg;asm volatile("s_waitcnt lgkmcnt(0)":::"memory");
  float rli[16];
  #pragma unroll
  for(int r=0;r<16;++r)rli[r]=__builtin_amdgcn_rcpf(wsf[32+crow(r,hi)]);
  bf16*Ow=O+(rowbase+q0+wid*QBLK)*OP+OCOL+h*D;
  { bf16*stg=(bf16*)(shm+LDS_OST)+wid*2048;
    #pragma unroll
    for(int r=0;r<16;++r){const int orow=crow(r,hi);
      #pragma unroll
      for(int d0=0;d0<2;++d0)stg[orow*64+d0*32+r32]=__float2bfloat16(o[d0][r]*rli[r]);}
    asm volatile("s_waitcnt lgkmcnt(0)":::"memory");
    #pragma unroll
    for(int i=0;i<4;++i){const int row=i*8+(lane>>3),ch=lane&7; const u32x4 v=*(const u32x4*)(stg+row*64+ch*8); ATTN_STORE16(Ow+(long)row*OP+ch*8,v);} }
  asm volatile("s_waitcnt lgkmcnt(0)\n\ts_barrier":::"memory");
  #undef DMA_K
  #undef DMA_V
  #undef KS_
  #undef CMASK
  #undef START
  #undef RESC
  #undef ROT
}
constexpr int ATTN_LDS_BYTES=LDS_BYTES;
struct AttnTensors { const bf16* QN; const bf16* QP; const bf16* KN; const bf16* KP; const bf16* V; bf16* O; };
struct AttnUnit { int bh; int qb; };
struct StaticOrder {
  int vcu, G;
  __device__ __forceinline__ explicit StaticOrder(int grid,int block):vcu((grid%8==0)?(block%8)*(grid/8)+block/8:block),G(grid){}
  __device__ __forceinline__ bool next(int i,AttnUnit&u)const{ const int idx=vcu+(i>>1)*G; if(idx>=BATCH*NHEAD*(NQB/2))return false; const int s=idx&3; u.bh=idx>>2; u.qb=(i&1)?7-s:s; return true; }
  __device__ __forceinline__ void a_ready(const AttnUnit&)const{}
  __device__ __forceinline__ void done(const AttnUnit&)const{}
};
template<class Sched,int THRL=8> __device__ __forceinline__ void attn_phase(char*lds,const AttnTensors&T,const Sched&S,const int wave_id){
  AttnUnit u;
  for(int i=0;S.next(i,u);++i){ S.a_ready(u); attn_unit<THRL>(wave_id,u.bh/NHEAD,u.bh%NHEAD,u.qb,T.QN,T.QP,T.KN,T.KP,T.V,T.O,lds); S.done(u); }
}
#undef SBAR
#undef WAIT_BAR
}

#define LAS __attribute__((address_space(3)))
#define CAS __attribute__((address_space(4)))
#define KPTR(T, ap64, i) ((T*)(__attribute__((address_space(1))) T*)(ap64)[i])
constexpr int RING_OFF = 0, RING_BYTES = 131072, LDSCTL_OFF = RING_BYTES, MISC_OFF = LDSCTL_OFF + 320, XCH_OFF = LDSCTL_OFF + 1024  , LDS_BYTES = 147456;
constexpr int N_PHASES = 3 + 7 * DEPTH;
constexpr int CW_P4 = 213760  , CW_WIN = 230144  , CW_S4 = 230400  ;
constexpr int CW_MX = 193024  , CW_GL = 209408  , CW_DR = 211456  ;
constexpr int CW_G5 = 172032  , CW_P6 = 176128  , CW_S5 = 192512, CW_S6 = 192768  ;
constexpr int CW_BAR = 4096, CW_CNT = 160000, CW_Q3 = 170000, CW_Q2 = 171000;
#define XB_TMO      128
#define XB_XCNT(j)  (256  + 64 * (j))
#define XB_XSUB(j)  (1280 + 64 * (j))
#define XB_XGEN(j)  (2304 + 64 * (j))
#define XB_TOP      3328
#define XB_TOPGEN   3392
#define XCD_BAR_WORDS 3456
#define XB_SPIN_CAP (1u << 18)

__device__ __forceinline__ unsigned xb_ld(unsigned* p)              { return __hip_atomic_load(p, __ATOMIC_RELAXED, __HIP_MEMORY_SCOPE_AGENT); }
__device__ __forceinline__ unsigned xb_add(unsigned* p, unsigned v) { return __hip_atomic_fetch_add(p, v, __ATOMIC_RELAXED, __HIP_MEMORY_SCOPE_AGENT); }
__device__ __forceinline__ unsigned xb_xcc_id() { return (unsigned)__builtin_amdgcn_s_getreg((3 << 11) | 20) & 0xFu; }
#define XB_SPIN(cond, bar) do { unsigned _sp = 0; while (cond) { __builtin_amdgcn_s_sleep(1); \
    if ((++_sp & 255u) == 0u) { if (xb_ld(&(bar)[XB_TMO])) break; if (_sp > XB_SPIN_CAP) { atomicAdd(&(bar)[XB_TMO], 1u); break; } } } } while (0)

struct XcdBarrier {
    unsigned* bar; unsigned x;
    volatile LAS unsigned* st;
};

__device__ __forceinline__ XcdBarrier xcd_barrier_post(unsigned* bar, volatile LAS unsigned* st, const bool t0  ) {
    XcdBarrier b; b.bar = bar; b.x = xb_xcc_id(); b.st = st;
    if (t0) (void)xb_add(&bar[XB_XCNT(b.x)], 1u);
    return b;
}
__device__ __forceinline__ void xcd_barrier_complete(unsigned* bar, unsigned x, unsigned& nloc, unsigned& nx) {
    const unsigned G = gridDim.x * gridDim.y * gridDim.z;
    unsigned sum, cnt, mine, sp = 0u;
    for (;;) {
        sum = 0u; cnt = 0u; mine = 0u;
#pragma unroll
        for (unsigned j = 0; j < 16; ++j) { const unsigned c = xb_ld(&bar[XB_XCNT(j)]); sum += c; cnt += (c > 0u) ? 1u : 0u; mine = (j == x) ? c : mine; }
        if (sum == G) break;
        __builtin_amdgcn_s_sleep(1);
        if ((++sp & 255u) == 0u) { if (xb_ld(&bar[XB_TMO])) break; if (sp > XB_SPIN_CAP) { atomicAdd(&bar[XB_TMO], 1u); break; } }
    }
    nloc = mine > 0u ? mine : 1u; nx = cnt > 0u ? cnt : 1u;
}

template <bool ARRIVE_ONLY = false>
__device__ __forceinline__ void xcd_barrier(const XcdBarrier& b, const bool t0) {
    asm volatile("s_waitcnt vmcnt(0)" ::: "memory");
    __syncthreads();
    if (t0) {
        unsigned* bar = b.bar; unsigned bx_ = b.x; asm volatile("" : "+s"(bx_));
        __builtin_amdgcn_s_waitcnt(0);
        unsigned nloc = b.st[0], nx = b.st[1];
        if (nloc == 0u) { xcd_barrier_complete(bar, bx_, nloc, nx); b.st[0] = nloc; b.st[1] = nx; }
        const unsigned old = xb_add(&bar[XB_XSUB(bx_)], 1u);
        const unsigned gen = old / nloc;
        if (old + 1u == (gen + 1u) * nloc) {
            __builtin_amdgcn_fence(__ATOMIC_RELEASE, "agent");
            asm volatile("s_waitcnt vmcnt(0)" ::: "memory");
            const unsigned og = xb_add(&bar[XB_TOP], 1u);
            const unsigned tg = og / nx;
            if (og + 1u == (tg + 1u) * nx) xb_add(&bar[XB_TOPGEN], 1u);
            else XB_SPIN(xb_ld(&bar[XB_TOPGEN]) == tg, bar);
            __builtin_amdgcn_fence(__ATOMIC_ACQUIRE, "agent");
            xb_add(&bar[XB_XGEN(bx_)], 1u);
            asm volatile("s_waitcnt vmcnt(0)" ::: "memory");
            if constexpr (ARRIVE_ONLY) b.st[2] = 0xFFFFFFFFu;
        } else if constexpr (ARRIVE_ONLY) { b.st[2] = gen;
        } else {
            XB_SPIN(xb_ld(&bar[XB_XGEN(bx_)]) == gen, bar);
            __builtin_amdgcn_fence(__ATOMIC_ACQUIRE, "agent");
            asm volatile("s_waitcnt vmcnt(0)" ::: "memory");
        }
    }
    __syncthreads();
}
__device__ __forceinline__ void xcd_barrier_wait(const XcdBarrier& b, const bool t0) {
    if (t0) { unsigned* bar = b.bar; unsigned bx_ = b.x; asm volatile("" : "+s"(bx_)); const unsigned gen = b.st[2];
        if (gen != 0xFFFFFFFFu) { XB_SPIN(xb_ld(&bar[XB_XGEN(bx_)]) == gen, bar); __builtin_amdgcn_fence(__ATOMIC_ACQUIRE, "agent"); asm volatile("s_waitcnt vmcnt(0)" ::: "memory"); } }
    __syncthreads();
}

struct MKArgs { const float* in[35]; float* out; unsigned char* ws; int ph_lo, ph_hi, li, pad; };
static_assert(sizeof(MKArgs) == 37 * 8 + 16 && offsetof(MKArgs, out) == 35 * 8 && offsetof(MKArgs, ws) == 36 * 8, "MKArgs has no padding; KPTR indices");
static_assert((CW_BAR + 32 * XCD_BAR_WORDS) <= CW_CNT && (CW_CNT + DEPTH * SB * 64) <= CW_Q3 && (CW_Q3 + DEPTH * 128) * 4 <= (int)CTL_BYTES, "control words");

enum { CV_WIN = 0, CV_WQB, CV_WKV, CV_T, CV_WFFI };
DEV f32x4 cvt_src4(int kind, const float* src, const float* src2, const float* gain, int ld, int k, int n) {
    f32x4 v = (f32x4){0.f, 0.f, 0.f, 0.f}; float g = 1.f;
    if (kind == CV_WIN) { const int c = colmap_win(n); if (c >= 0) { v = *(const f32x4*)(src + (size_t)k * DIN + c); g = gain[k]; } }
    else if (kind == CV_WQB) { v = *(const f32x4*)(src + (size_t)k * 768 + colmap_qb(n)); g = gain[k]; }
    else if (kind == CV_WKV) { if (k < 128) { const int nn = n & 511; v = *(const f32x4*)((n < 512 ? src : src2) + ((size_t)k * 8 + (nn >> 6)) * 64 + (nn & 63)); g = gain[k]; } }
    else if (kind == CV_T) v = *(const f32x4*)(src + (size_t)k * ld + n);
    else { v = *(const f32x4*)(src + (size_t)k * DFF2 + colmap_ffi(n)); g = gain[k]; }
    return v * g;
}
struct CvtMat { const float* src; const float* src2; const float* gain; bf16_t* dst; int kind, N, K, ld, tm; };
#define CVT_TILES_PER_LAYER 2880
#ifndef CVT_Q0
#define CVT_Q0 0
#endif
#ifndef CVT_CH
#define CVT_CH 4
#endif
#ifndef CVT_CUT_A
#define CVT_CUT_A 1088
#endif
#ifndef CVT_CUT_B
#define CVT_CUT_B 1760
#endif
template <class AP> DEV CvtMat cvt_mat_of(int L, int t, unsigned char* ws, AP ap) {
    unsigned char* wl = ws + WS_W + (size_t)L * WL_SIZE; CvtMat m;
    if (t < 384) { m = CvtMat{KPTR(const float, ap, 9) + (size_t)L * DM * DIN, nullptr, KPTR(const float, ap, 8) + L * DM, (bf16_t*)(wl + WL_IN), CV_WIN, DINP, DM, 0, t}; }
    else if (t < 432) { m = CvtMat{KPTR(const float, ap, 21) + (size_t)L * 256 * 768, nullptr, KPTR(const float, ap, 20) + L * 256, (bf16_t*)(wl + WL_QB), CV_WQB, 768, 256, 0, t - 384}; }
    else if (t < 496) { m = CvtMat{KPTR(const float, ap, 23) + (size_t)L * 128 * 512, KPTR(const float, ap, 24) + (size_t)L * 128 * 512, KPTR(const float, ap, 22) + L * 128, (bf16_t*)(wl + WL_KV), CV_WKV, 1024, 256, 0, t - 432}; }
    else if (t < 512) { m = CvtMat{KPTR(const float, ap, 18) + (size_t)L * 65536, nullptr, nullptr, (bf16_t*)(wl + WL_GLU), CV_T, 256, 256, 256, t - 496}; }
    else if (t < 768) { m = CvtMat{KPTR(const float, ap, 28) + (size_t)L * DM * DM, nullptr, nullptr, (bf16_t*)(wl + WL_OUT), CV_T, DM, DM, DM, t - 512}; }
    else if (t < 2176) { m = CvtMat{KPTR(const float, ap, 30) + (size_t)L * DM * DFF2, nullptr, KPTR(const float, ap, 29) + L * DM, (bf16_t*)(wl + WL_FFI), CV_WFFI, DFF2, DM, 0, t - 768}; }
    else { m = CvtMat{KPTR(const float, ap, 33) + (size_t)L * DFF * DM, nullptr, nullptr, (bf16_t*)(wl + WL_FFO), CV_T, DM, DFF, DM, t - 2176}; }
    return m;
}
template <class AP> DEV void cvt_layer_wg(int L, int wgi, int nwg, int tid, LAS unsigned char* sm, unsigned char* ws, AP ap, int t_begin = 0, int t_end = CVT_TILES_PER_LAYER) {
    LAS bf16_t* T = (LAS bf16_t*)sm;
    const int kk = tid >> 3, nq = tid & 7;
    f32x4 c0 = (f32x4){0.f, 0.f, 0.f, 0.f}, c1 = c0;
    int t = t_begin + wgi;
    if (t < t_end) { const CvtMat m = cvt_mat_of(L, t, ws, ap); const int nb = m.N / 64, k0 = 64 * (m.tm / nb), n0 = 64 * (m.tm % nb);
        c0 = cvt_src4(m.kind, m.src, m.src2, m.gain, m.ld, k0 + kk, n0 + 8 * nq); c1 = cvt_src4(m.kind, m.src, m.src2, m.gain, m.ld, k0 + kk, n0 + 8 * nq + 4); }
    for (; t < t_end; t += nwg) {
        const CvtMat m = cvt_mat_of(L, t, ws, ap); const int nb = m.N / 64, k0 = 64 * (m.tm / nb), n0 = 64 * (m.tm % nb);
        lds_barrier();
#pragma unroll
        for (int e = 0; e < 4; ++e) { T[(8 * nq + e) * 72 + kk] = f2bf(c0[e]); T[(8 * nq + 4 + e) * 72 + kk] = f2bf(c1[e]); }
        if (t + nwg < t_end) { const CvtMat m2 = cvt_mat_of(L, t + nwg, ws, ap); const int nb2 = m2.N / 64, k2 = 64 * (m2.tm / nb2), n2 = 64 * (m2.tm % nb2);
            c0 = cvt_src4(m2.kind, m2.src, m2.src2, m2.gain, m2.ld, k2 + kk, n2 + 8 * nq); c1 = cvt_src4(m2.kind, m2.src, m2.src2, m2.gain, m2.ld, k2 + kk, n2 + 8 * nq + 4); }
        lds_barrier();
        { const int nl = tid >> 3, kc = tid & 7; *(u32x4*)(m.dst + (size_t)(n0 + nl) * m.K + k0 + 8 * kc) = *(const LAS u32x4*)(T + nl * 72 + 8 * kc); }
    }
    lds_barrier();
}
DEV void s5_pre_item(const float* a_re, const float* a_im, const float* log_dt, const float* b_re, const float* b_im, unsigned char* ws, int lg, int p) {
    const float dt = expf(log_dt[lg]);
    const double lr = a_re[lg * 64 + p], li = a_im[lg * 64 + p];
    const double er = exp(lr * dt), ar = er * cos(li * dt), ai = er * sin(li * dt);
    const double nr = ar - 1.0, ni = ai, den = lr * lr + li * li;
    const double cr = (nr * lr + ni * li) / den, ci = (ni * lr - nr * li) / den;
    float2* abar = (float2*)(ws + WS_S5 + (size_t)lg * S5_SIZE + S5_ABAR);
    float2* bbar = (float2*)(ws + WS_S5 + (size_t)lg * S5_SIZE + S5_BBAR);
    abar[p] = make_float2((float)ar, (float)ai);
    for (int c = 0; c < 16; ++c) { const double br = b_re[((size_t)lg * 64 + p) * 16 + c], bi = b_im[((size_t)lg * 64 + p) * 16 + c];
        bbar[p * 16 + c] = make_float2((float)(cr * br - ci * bi), (float)(cr * bi + ci * br)); }
}
DEV void rope_item(unsigned char* ws, int id) {
    const int pr = id >> 4, i = id & 15; const double pos = pr < SEQ ? (double)pr : (double)PAST;
    const float inv = (float)pow(10000.0, -(double)i / 16.0);
    const double ang = pos * (double)inv;
    ((float*)(ws + WS_COS))[id] = (float)cos(ang); ((float*)(ws + WS_SIN))[id] = (float)sin(ang);
}
DEV void xprep_row(const float* x, bf16_t* xb, float* rs, int row, int lane) {
    const f32x4* xr = (const f32x4*)(x + (size_t)row * DM) + lane;
    float part[4];
#pragma unroll
    for (int j = 0; j < 4; ++j) { const f32x4 v = xr[64 * j]; part[j] = wave_sum((v.x * v.x + v.y * v.y) + (v.z * v.z + v.w * v.w));
        u32x2 o; o.x = pk2(v.x, v.y); o.y = pk2(v.z, v.w); *(u32x2*)(xb + (size_t)row * DM + 256 * j + 4 * lane) = o; }
    if (lane < 16) rs[(size_t)row * 16 + lane] = (lane & 3) ? 0.f : (lane == 0 ? part[0] : lane == 4 ? part[1] : lane == 8 ? part[2] : part[3]);
}

DEV float2 cpow_(float lr, float li, float dt, int tau) {
    const float mag = expf((float)tau * lr * dt), ang = li * dt * (float)tau;
    float sn, cs; sincosf(ang, &sn, &cs); return make_float2(mag * cs, mag * sn);
}
DEV void s5_mat_T(const float* a_re, const float* a_im, const float* log_dt, const float* c_re, const float* c_im, unsigned char* ws, int id) {
    const int cg = id & 1, c = (id >> 1) & 15, dj = ((id >> 5) % 63) - 31, lg = id / (32 * 63);
    float kk[8];
#pragma unroll
    for (int i = 0; i < 8; ++i) kk[i] = 0.f;
    if (dj >= 0) { const float2* bb = (const float2*)(ws + WS_S5 + (size_t)lg * S5_SIZE + S5_BBAR); const float2* apw = (const float2*)(ws + WS_APOW) + ((size_t)lg * 33 + dj) * 64;
        for (int p = 0; p < 64; ++p) { const float2 ap = apw[p];
            const float cr = c_re[((size_t)lg * 16 + c) * 64 + p], ci = c_im[((size_t)lg * 16 + c) * 64 + p];
            const float br = cr * ap.x - ci * ap.y, bi = cr * ap.y + ci * ap.x;
#pragma unroll
            for (int i = 0; i < 8; ++i) { const float2 b = bb[p * 16 + cg * 8 + i]; kk[i] += br * b.x - bi * b.y; } } }
    u32x4 o; o.x = pk2(kk[0], kk[1]); o.y = pk2(kk[2], kk[3]); o.z = pk2(kk[4], kk[5]); o.w = pk2(kk[6], kk[7]);
    bf16_t* T = (bf16_t*)(ws + WS_S5 + (size_t)lg * S5_SIZE + S5_TQ);
    const int j0 = dj >= 0 ? dj : 0, j1 = dj >= 0 ? 31 : 31 + dj;
    for (int j = j0; j <= j1; ++j) *(u32x4*)(T + (size_t)(j * 16 + c) * 512 + (j - dj) * 16 + cg * 8) = o;
}
DEV void s5_mat_Q(const float* a_re, const float* a_im, const float* log_dt, unsigned char* ws, int id) {
    const int jp = id & 31, sidx = (id >> 5) & 127, lg = id >> 12, p = sidx & 63;
    const float2 ap = ((const float2*)(ws + WS_APOW))[((size_t)lg * 33 + (31 - jp)) * 64 + p];
    const float2* bb = (const float2*)(ws + WS_S5 + (size_t)lg * S5_SIZE + S5_BBAR) + p * 16;
    float v[16];
#pragma unroll
    for (int c = 0; c < 16; ++c) { const float2 b = bb[c]; v[c] = sidx < 64 ? ap.x * b.x - ap.y * b.y : ap.x * b.y + ap.y * b.x; }
    bf16_t* Q = (bf16_t*)(ws + WS_S5 + (size_t)lg * S5_SIZE + S5_TQ) + (size_t)(512 + sidx) * 512 + jp * 16;
    u32x4 o; o.x = pk2(v[0], v[1]); o.y = pk2(v[2], v[3]); o.z = pk2(v[4], v[5]); o.w = pk2(v[6], v[7]); *(u32x4*)Q = o;
    o.x = pk2(v[8], v[9]); o.y = pk2(v[10], v[11]); o.z = pk2(v[12], v[13]); o.w = pk2(v[14], v[15]); *(u32x4*)(Q + 8) = o;
}
DEV void s5_mat_P(const float* a_re, const float* a_im, const float* log_dt, const float* c_re, const float* c_im, unsigned char* ws, int id) {
    const int sg = id & 15, c = (id >> 4) & 15, j = (id >> 8) & 31, lg = id >> 13;
    float v[8];
#pragma unroll
    for (int i = 0; i < 8; ++i) { const int sidx = sg * 8 + i, p = sidx & 63; const float2 ap = ((const float2*)(ws + WS_APOW))[((size_t)lg * 33 + (j + 1)) * 64 + p];
        const float cr = c_re[((size_t)lg * 16 + c) * 64 + p], ci = c_im[((size_t)lg * 16 + c) * 64 + p];
        v[i] = sidx < 64 ? cr * ap.x - ci * ap.y : -(cr * ap.y + ci * ap.x); }
    u32x4 o; o.x = pk2(v[0], v[1]); o.y = pk2(v[2], v[3]); o.z = pk2(v[4], v[5]); o.w = pk2(v[6], v[7]);
    *(u32x4*)((bf16_t*)(ws + WS_S5 + (size_t)lg * S5_SIZE + S5_P) + (size_t)(j * 16 + c) * 128 + sg * 8) = o;
}
DEV void s5_task(int l, int b, int g, int wave, int lane, LAS unsigned char* sm, unsigned char* ws, float* out, const float* dskip) {
    const int lg = l * 16 + g, fr = lane & 15, fq = lane >> 4;
    const bf16_t* TQ = (const bf16_t*)(ws + WS_S5 + (size_t)lg * S5_SIZE + S5_TQ); const bf16_t* PM = (const bf16_t*)(ws + WS_S5 + (size_t)lg * S5_SIZE + S5_P);
    const bf16_t* U = (const bf16_t*)(ws + WS_U5) + ((size_t)g * M + (size_t)b * SEQ) * 16;
    LAS float* Hloc = (LAS float*)sm; LAS bf16_t* Hin = (LAS bf16_t*)(sm + 32768);
    f32x4 acc[5][4];
#pragma unroll
    for (int i = 0; i < 5; ++i)
#pragma unroll
        for (int nt = 0; nt < 4; ++nt) acc[i][nt] = (f32x4){0.f, 0.f, 0.f, 0.f};
    __syncthreads();
#pragma unroll 4
    for (int s = 0; s < 16; ++s) { const int k0 = 32 * s + 8 * fq;
        bf16x8 bfr[4];
#pragma unroll
        for (int nt = 0; nt < 4; ++nt) bfr[nt] = *(const bf16x8*)(U + (size_t)(nt * 16 + fr) * 512 + k0);
#pragma unroll
        for (int i = 0; i < 4; ++i) { const int rt = wave + 8 * i;
            if (2 * s <= rt) { const bf16x8 a = *(const bf16x8*)(TQ + (size_t)(rt * 16 + fr) * 512 + k0);
#pragma unroll
                for (int nt = 0; nt < 4; ++nt) acc[i][nt] = __builtin_amdgcn_mfma_f32_16x16x32_bf16(a, bfr[nt], acc[i][nt], 0, 0, 0); } }
        { const bf16x8 a = *(const bf16x8*)(TQ + (size_t)((32 + wave) * 16 + fr) * 512 + k0);
#pragma unroll
            for (int nt = 0; nt < 4; ++nt) acc[4][nt] = __builtin_amdgcn_mfma_f32_16x16x32_bf16(a, bfr[nt], acc[4][nt], 0, 0, 0); }
    }
#pragma unroll
    for (int nt = 0; nt < 4; ++nt) *(LAS f32x4*)(Hloc + (nt * 16 + fr) * 128 + 16 * wave + 4 * fq) = acc[4][nt];
    __syncthreads();
    if (wave == 0) { const float2 aL = ((const float2*)(ws + WS_S5 + (size_t)lg * S5_SIZE + S5_AL))[lane]; float hr = 0.f, hi = 0.f;
        for (int n = 0; n < 64; ++n) { Hin[n * 128 + lane] = f2bf(hr); Hin[n * 128 + 64 + lane] = f2bf(hi);
            const float lr = Hloc[n * 128 + lane], li = Hloc[n * 128 + 64 + lane];
            const float nr = aL.x * hr - aL.y * hi + lr, ni = aL.x * hi + aL.y * hr + li; hr = nr; hi = ni; }
        float* o = out + O_S5P + ((((size_t)l * NB + b) * S5G + g) * S5P + lane) * 2; o[0] = hr; o[1] = hi; }
    __syncthreads();
#pragma unroll
    for (int s = 0; s < 4; ++s) { const int k0 = 32 * s + 8 * fq;
        bf16x8 bfr[4];
#pragma unroll
        for (int nt = 0; nt < 4; ++nt) bfr[nt] = *(const LAS bf16x8*)(Hin + (nt * 16 + fr) * 128 + k0);
#pragma unroll
        for (int i = 0; i < 4; ++i) { const int rt = wave + 8 * i; const bf16x8 a = *(const bf16x8*)(PM + (size_t)(rt * 16 + fr) * 128 + k0);
#pragma unroll
            for (int nt = 0; nt < 4; ++nt) acc[i][nt] = __builtin_amdgcn_mfma_f32_16x16x32_bf16(a, bfr[nt], acc[i][nt], 0, 0, 0); } }
    const f32x4 dd = *(const f32x4*)(dskip + l * 256 + g * 16 + 4 * fq);
#pragma unroll
    for (int i = 0; i < 4; ++i) { const int rt = wave + 8 * i;
#pragma unroll
        for (int nt = 0; nt < 4; ++nt) { const int n = nt * 16 + fr; const size_t row = (size_t)b * SEQ + 32 * n + rt;
            const u32x2 uw = *(const u32x2*)((const bf16_t*)(ws + WS_U5) + ((size_t)g * M + row) * 16 + 4 * fq);
            const f32x4 uu = pg8::unpk_lo(uw.x, uw.y); f32x4 y = acc[i][nt] + dd * uu;
            u32x2 o; o.x = pk2(gelu_tanh(y[0]), gelu_tanh(y[1])); o.y = pk2(gelu_tanh(y[2]), gelu_tanh(y[3]));
            *(u32x2*)((bf16_t*)(ws + WS_Y5) + row * 256 + g * 16 + 4 * fq) = o; } }
}
DEV void misc_row(int l, int row, int lane, unsigned char* ws, float* out, const float* g_kv, const float* w_gate, const float* b_gate) {
    const float* t2 = (const float*)(ws + WS_T2F) + (size_t)row * 256;
    f32x4 v = (f32x4){0.f, 0.f, 0.f, 0.f}; if (lane < 44) v = *(const f32x4*)(t2 + 4 * lane);
    const float rk = pg8::rstd4((const float*)(ws + WS_RSKV), row, 1.f / 128.f);
    if (lane < 32) { const f32x4 g = *(const f32x4*)(g_kv + 4 * lane); *(f32x4*)(out + O_CKVP + ((size_t)l * M + row) * KVL + 4 * lane) = v * rk * g; }
    const int pos = row & (SEQ - 1);
    f32x4 pt;
#pragma unroll
    for (int e = 0; e < 4; ++e) pt[e] = shfl_xor_(v[e], 4);
    if (lane >= 32 && lane < 40) { const int q = lane - 32, qi = q & 3;
        const f32x4 cs = *(const f32x4*)((const float*)(ws + WS_COS) + pos * 16 + 4 * qi), sn = *(const f32x4*)((const float*)(ws + WS_SIN) + pos * 16 + 4 * qi);
        const f32x4 o = q < 4 ? v * cs - pt * sn : pt * sn + v * cs;
        *(f32x4*)(out + O_KRP + ((size_t)l * M + row) * ROPE + 4 * q) = o;
        u32x2 w; w.x = pk2(o[0], o[1]); w.y = pk2(o[2], o[3]); *(u32x2*)((bf16_t*)(ws + WS_KP) + (size_t)row * 32 + 8 * qi + 4 * (q >> 2)) = w; }
}
DEV void misc_rows4(int l, int row0, int lane, unsigned char* ws, float* out, const float* g_kv) {
    f32x4 v[4], cs[4], sn[4]; float rk[4];
    const int q = lane - 32, qi = q & 3; const bool rp = lane >= 32 && lane < 40;
#pragma unroll
    for (int r = 0; r < 4; ++r) { const int row = row0 + r; const float* t2 = (const float*)(ws + WS_T2F) + (size_t)row * 256;
        v[r] = (f32x4){0.f, 0.f, 0.f, 0.f}; if (lane < 44) v[r] = *(const f32x4*)(t2 + 4 * lane);
        rk[r] = pg8::rstd4((const float*)(ws + WS_RSKV), row, 1.f / 128.f);
        cs[r] = v[r]; sn[r] = v[r];
        if (rp) { const int pos = row & (SEQ - 1); cs[r] = *(const f32x4*)((const float*)(ws + WS_COS) + pos * 16 + 4 * qi); sn[r] = *(const f32x4*)((const float*)(ws + WS_SIN) + pos * 16 + 4 * qi); } }
    f32x4 g = (f32x4){0.f, 0.f, 0.f, 0.f}; if (lane < 32) g = *(const f32x4*)(g_kv + 4 * lane);
#pragma unroll
    for (int r = 0; r < 4; ++r) { const int row = row0 + r;
        if (lane < 32) *(f32x4*)(out + O_CKVP + ((size_t)l * M + row) * KVL + 4 * lane) = v[r] * rk[r] * g;
        f32x4 pt;
#pragma unroll
        for (int e = 0; e < 4; ++e) pt[e] = shfl_xor_(v[r][e], 4);
        if (rp) { const f32x4 o = q < 4 ? v[r] * cs[r] - pt * sn[r] : pt * sn[r] + v[r] * cs[r];
            *(f32x4*)(out + O_KRP + ((size_t)l * M + row) * ROPE + 4 * q) = o;
            u32x2 w; w.x = pk2(o[0], o[1]); w.y = pk2(o[2], o[3]); *(u32x2*)((bf16_t*)(ws + WS_KP) + (size_t)row * 32 + 8 * qi + 4 * (q >> 2)) = w; } }
}
template <int CTRL, int RMASK> DEV float dpp0(float x) { return __builtin_bit_cast(float, __builtin_amdgcn_update_dpp(0, __builtin_bit_cast(int, x), CTRL, RMASK, 0xf, false)); }
DEV float wave_scan_incl(float x, int row16  ) { x += dpp0<0x111, 0xf>(x); x += dpp0<0x112, 0xf>(x); x += dpp0<0x114, 0xf>(x); x += dpp0<0x118, 0xf>(x);
    const float t0 = shfl_(x, 15), t1 = shfl_(x, 31), t2 = shfl_(x, 47);
    return x + (row16 == 0 ? 0.f : row16 == 1 ? t0 : row16 == 2 ? t0 + t1 : (t0 + t1) + t2); }
DEV float shfl_up_add(float x, int lane, int off) { const float t = shfl_(x, lane >= off ? lane - off : lane); return lane >= off ? x + t : x; }
DEV void gla_task(int l, int b, int h, int wave, int lane, LAS unsigned char* sm, unsigned char* ws, float* out, const float* gn, const float* w_gate, const float* b_gate) {
    constexpr int QS = 40, KS2 = 72;
    constexpr int RQ = 32, RG = 16, RV = 64, RAWB = 64 * RQ * 4 * 2 + 64 * RG * 4 + 64 * RV * 2 * 2;
    LAS bf16_t* QE = (LAS bf16_t*)sm; LAS bf16_t* KE = QE + 64 * QS; LAS bf16_t* KDT = KE + 64 * QS; LAS bf16_t* VT = KDT + 32 * KS2; LAS bf16_t* ST = VT + 64 * KS2; LAS float* DEC = (LAS float*)(ST + 2 * 64 * QS); LAS float* WG = DEC + 32;
    LAS bf16_t* OUTS = (LAS bf16_t*)(WG + 512);
    LAS unsigned char* RAW = (LAS unsigned char*)(OUTS + 2 * 64 * RV);
    static_assert((64 * QS * 2 * 2 + 32 * KS2 * 2 + 64 * KS2 * 2 + 2 * 64 * QS * 2 + 128 + 2048 + 2 * 64 * RV * 2 + 2 * RAWB) <= RING_BYTES, "GLA LDS");
    const float* QKF = (const float*)(ws + WS_QKF); const float* T2F = (const float*)(ws + WS_T2F);
    const bf16_t* GVB = (const bf16_t*)(ws + WS_GVB); const bf16_t* GRB = (const bf16_t*)(ws + WS_GRB); bf16_t* MIX = (bf16_t*)(ws + WS_MIX);
    const int fr = lane & 15, fq = lane >> 4, t = wave * 64 + lane, lrow = t >> 3, lpc = t & 7;
    __syncthreads();
    for (int i = t; i < 64 * QS / 2; i += 512) ((LAS unsigned*)ST)[i] = 0u;
    const f32x4 bg4 = *(const f32x4*)(b_gate + h * 32 + 4 * wave);
    f32x4 wg[16];
#pragma unroll
    for (int r = 0; r < 16; ++r) wg[r] = *(const f32x4*)(w_gate + (size_t)r * 128 + h * 32 + 4 * wave);
    f32x4 S0 = (f32x4){0.f, 0.f, 0.f, 0.f}, S1 = S0;
    const int x4 = wave - 4, sdt = (x4 >> 1) & 1, svt = 2 * (x4 & 1);
    float gg4[4];
#pragma unroll
    for (int vt = 0; vt < 4; ++vt) gg4[vt] = gn[l * 256 + h * 64 + 16 * vt + fr];
    f32x4 lq, lk, lg; u32x4 lv, lr;
#define GLA_LOAD(n_) do { const size_t r_ = (size_t)b * SEQ + (size_t)(n_) * 64 + lrow; lq = *(const f32x4*)(QKF + r_ * 256 + h * 32 + 4 * lpc); lk = *(const f32x4*)(QKF + r_ * 256 + 128 + h * 32 + 4 * lpc); \
        lv = *(const u32x4*)(GVB + r_ * 256 + h * 64 + 8 * lpc); lr = *(const u32x4*)(GRB + r_ * 256 + h * 64 + 8 * lpc); if (t < 256) lg = *(const f32x4*)(T2F + ((size_t)b * SEQ + (size_t)(n_) * 64 + (t >> 2)) * 256 + 160 + 4 * (t & 3)); } while (0)
#define GLA_STASH(buf_) do { LAS unsigned char* rw_ = RAW + (buf_) * RAWB; const int sw_ = lpc ^ ((lrow >> 1) & 7); *(LAS f32x4*)((LAS float*)rw_ + lrow * RQ + 4 * sw_) = lq; *(LAS f32x4*)((LAS float*)rw_ + 64 * RQ + lrow * RQ + 4 * sw_) = lk; \
        if (t < 256) *(LAS f32x4*)((LAS float*)rw_ + 2 * 64 * RQ + (t >> 2) * RG + 4 * ((t & 3) ^ ((t >> 4) & 3))) = lg; \
        LAS bf16_t* rb_ = (LAS bf16_t*)(rw_ + 2 * 64 * RQ * 4 + 64 * RG * 4); *(LAS u32x4*)(rb_ + lrow * RV + 8 * sw_) = lv; *(LAS u32x4*)(rb_ + 64 * RV + lrow * RV + 8 * sw_) = lr; } while (0)
    GLA_LOAD(0); GLA_STASH(0); GLA_LOAD(1);
    __syncthreads();
    for (int n = 0; n < SEQ / 64; ++n) {
        const LAS float* rq = (const LAS float*)(RAW + (n & 1) * RAWB); const LAS float* rk = rq + 64 * RQ; const LAS float* rg = rk + 64 * RQ;
        const LAS bf16_t* rv = (const LAS bf16_t*)(rg + 64 * RG); const LAS bf16_t* rr = rv + 64 * RV;
        { f32x4 bb = bg4;
#pragma unroll
            for (int r = 0; r < 4; ++r) { const f32x4 g4 = *(const LAS f32x4*)(rg + lane * RG + 4 * (r ^ ((lane >> 2) & 3)));
#pragma unroll
                for (int e = 0; e < 4; ++e) bb = bb + wg[4 * r + e] * g4[e]; }
#pragma unroll
            for (int e = 0; e < 4; ++e) bb[e] = log_sigmoid(bb[e]) * (1.f / 16.f);
#pragma unroll
            for (int e = 0; e < 4; ++e) bb[e] = wave_scan_incl(bb[e], fq);
            const int swl = wave ^ ((lane >> 1) & 7);
            const f32x4 q4 = *(const LAS f32x4*)(rq + lane * RQ + 4 * swl), k4 = *(const LAS f32x4*)(rk + lane * RQ + 4 * swl);
            f32x4 bl, qe, ke, kd;
#pragma unroll
            for (int e = 0; e < 4; ++e) { bl[e] = shfl_(bb[e], 63); const float eb = fexp(bb[e]); qe[e] = q4[e] * 0.17677669529663687f * eb; ke[e] = k4[e] * __builtin_amdgcn_rcpf(eb); kd[e] = k4[e] * fexp(bl[e] - bb[e]); }
            u32x2 w; w.x = pk2(qe[0], qe[1]); w.y = pk2(qe[2], qe[3]); *(LAS u32x2*)(QE + lane * QS + 4 * wave) = w;
            w.x = pk2(ke[0], ke[1]); w.y = pk2(ke[2], ke[3]); *(LAS u32x2*)(KE + lane * QS + 4 * wave) = w;
#pragma unroll
            for (int e = 0; e < 4; ++e) KDT[(4 * wave + e) * KS2 + lane] = f2bf(kd[e]);
            if (lane == 0) {
#pragma unroll
                for (int e = 0; e < 4; ++e) DEC[4 * wave + e] = fexp(bl[e]); }
            const u32x4 v8 = *(const LAS u32x4*)(rv + lane * RV + 8 * swl);
            const unsigned vw[4] = {v8.x, v8.y, v8.z, v8.w};
#pragma unroll
            for (int e = 0; e < 4; ++e) { VT[(8 * wave + 2 * e) * KS2 + lane] = (bf16_t)(vw[e] & 0xffffu); VT[(8 * wave + 2 * e + 1) * KS2 + lane] = (bf16_t)(vw[e] >> 16); }
        }
        lds_barrier();
        if (n + 1 < SEQ / 64) GLA_STASH((n + 1) & 1);
        if (n + 2 < SEQ / 64) GLA_LOAD(n + 2);
        if (n > 0) { const u32x4 ov = *(const LAS u32x4*)(OUTS + ((n - 1) & 1) * 64 * RV + lrow * RV + 8 * lpc); *(u32x4*)(MIX + ((size_t)b * SEQ + (size_t)(n - 1) * 64 + lrow) * DM + 768 + h * 64 + 8 * lpc) = ov; }
        const LAS bf16_t* STc = ST + (n & 1) * 64 * QS; LAS bf16_t* STn = ST + ((n + 1) & 1) * 64 * QS;
        if (wave < 4) {
            const int it = wave;
            const bf16x8 qf = *(const LAS bf16x8*)(QE + (16 * it + fr) * QS + 8 * fq);
            f32x4 at[4];
#pragma unroll
            for (int jt = 0; jt < 4; ++jt) { at[jt] = (f32x4){0.f, 0.f, 0.f, 0.f};
                if (jt <= it) { const bf16x8 kf = *(const LAS bf16x8*)(KE + (16 * jt + fr) * QS + 8 * fq);
                    at[jt] = __builtin_amdgcn_mfma_f32_16x16x32_bf16(kf, qf, at[jt], 0, 0, 0);
                    if (jt == it) {
#pragma unroll
                        for (int e = 0; e < 4; ++e) if (4 * fq + e > fr) at[jt][e] = 0.f; } } }
            u32x4 af[2];
#pragma unroll
            for (int s2 = 0; s2 < 2; ++s2) { af[s2].x = pk2(at[2 * s2][0], at[2 * s2][1]); af[s2].y = pk2(at[2 * s2][2], at[2 * s2][3]); af[s2].z = pk2(at[2 * s2 + 1][0], at[2 * s2 + 1][1]); af[s2].w = pk2(at[2 * s2 + 1][2], at[2 * s2 + 1][3]); }
            f32x4 o[4]; float ss[4] = {0.f, 0.f, 0.f, 0.f};
#pragma unroll
            for (int vt = 0; vt < 4; ++vt) { o[vt] = (f32x4){0.f, 0.f, 0.f, 0.f};
                const bf16x8 sf = *(const LAS bf16x8*)(STc + (16 * vt + fr) * QS + 8 * fq);
                o[vt] = __builtin_amdgcn_mfma_f32_16x16x32_bf16(qf, sf, o[vt], 0, 0, 0);
#pragma unroll
                for (int s2 = 0; s2 < 2; ++s2) if (2 * s2 <= it) {
                    const u32x2 v0 = *(const LAS u32x2*)(VT + (16 * vt + fr) * KS2 + 32 * s2 + 4 * fq), v1 = *(const LAS u32x2*)(VT + (16 * vt + fr) * KS2 + 32 * s2 + 16 + 4 * fq);
                    const u32x4 vf = {v0.x, v0.y, v1.x, v1.y};
                    o[vt] = __builtin_amdgcn_mfma_f32_16x16x32_bf16(__builtin_bit_cast(bf16x8, af[s2]), __builtin_bit_cast(bf16x8, vf), o[vt], 0, 0, 0); }
#pragma unroll
                for (int e = 0; e < 4; ++e) ss[e] += o[vt][e] * o[vt][e]; }
#pragma unroll
            for (int e = 0; e < 4; ++e) { float tt = ss[e]; tt += shfl_xor_(tt, 1); tt += shfl_xor_(tt, 2); tt += shfl_xor_(tt, 4); tt += shfl_xor_(tt, 8); ss[e] = rsqrtf(tt * (1.f / 64.f) + EPS); }
            LAS bf16_t* oo = OUTS + (n & 1) * 64 * RV;
            bf16_t grw[4][4];
#pragma unroll
            for (int vt = 0; vt < 4; ++vt)
#pragma unroll
                for (int e = 0; e < 4; ++e) { const int i2 = 16 * it + 4 * fq + e, v = 16 * vt + fr; grw[vt][e] = rr[i2 * RV + 8 * ((v >> 3) ^ ((i2 >> 1) & 7)) + (v & 7)]; }
#pragma unroll
            for (int vt = 0; vt < 4; ++vt) { const int v = 16 * vt + fr; const float gg = gg4[vt];
#pragma unroll
                for (int e = 0; e < 4; ++e) { const int i2 = 16 * it + 4 * fq + e; const float gr = bf2f(grw[vt][e]);
                    oo[i2 * RV + v] = f2bf(o[vt][e] * ss[e] * gg * gr * sigmoidf_(gr)); } }
        } else {
            f32x4 u0 = (f32x4){0.f, 0.f, 0.f, 0.f}, u1 = u0;
#pragma unroll
            for (int s2 = 0; s2 < 2; ++s2) { const bf16x8 kf = *(const LAS bf16x8*)(KDT + (16 * sdt + fr) * KS2 + 32 * s2 + 8 * fq);
                const bf16x8 va = *(const LAS bf16x8*)(VT + (16 * svt + fr) * KS2 + 32 * s2 + 8 * fq), vb2 = *(const LAS bf16x8*)(VT + (16 * (svt + 1) + fr) * KS2 + 32 * s2 + 8 * fq);
                u0 = __builtin_amdgcn_mfma_f32_16x16x32_bf16(kf, va, u0, 0, 0, 0); u1 = __builtin_amdgcn_mfma_f32_16x16x32_bf16(kf, vb2, u1, 0, 0, 0); }
            const f32x4 dc = *(const LAS f32x4*)(DEC + 16 * sdt + 4 * fq);
            S0 = dc * S0 + u0; S1 = dc * S1 + u1;
            u32x2 w; w.x = pk2(S0[0], S0[1]); w.y = pk2(S0[2], S0[3]); *(LAS u32x2*)(STn + (16 * svt + fr) * QS + 16 * sdt + 4 * fq) = w;
            w.x = pk2(S1[0], S1[1]); w.y = pk2(S1[2], S1[3]); *(LAS u32x2*)(STn + (16 * (svt + 1) + fr) * QS + 16 * sdt + 4 * fq) = w;
        }
        lds_barrier();
    }
#undef GLA_LOAD
#undef GLA_STASH
    { const u32x4 ov = *(const LAS u32x4*)(OUTS + ((SEQ / 64 - 1) & 1) * 64 * RV + lrow * RV + 8 * lpc); *(u32x4*)(MIX + ((size_t)b * SEQ + (size_t)(SEQ / 64 - 1) * 64 + lrow) * DM + 768 + h * 64 + 8 * lpc) = ov; }
    if (wave >= 4) { float* so = out + O_GLAP + (((size_t)l * NB + b) * GH + h) * GDK * GDV;
#pragma unroll
        for (int e = 0; e < 4; ++e) { so[(16 * sdt + 4 * fq + e) * GDV + 16 * svt + fr] = S0[e]; so[(16 * sdt + 4 * fq + e) * GDV + 16 * (svt + 1) + fr] = S1[e]; } }
}
template <bool F32A, bool PAIR, class Epi> DEV void sgemm_wg(const void* Aptr, int lda, const bf16_t* Bt, int ldb, int K, int n0, int n1, int wave, int lane, LAS float* red, Epi epi) {
    const int r32 = lane & 31, hi = lane >> 5, kper = K / 8, kb = wave * kper;
    f32x16 acc0, acc1;
#pragma unroll
    for (int r = 0; r < 16; ++r) { acc0[r] = 0.f; acc1[r] = 0.f; }
    float ss = 0.f;
    const bf16_t* bp0 = Bt + (size_t)(n0 + r32) * ldb + 8 * hi; const bf16_t* bp1 = Bt + (size_t)(n1 + r32) * ldb + 8 * hi;
    __syncthreads();
#pragma unroll 8
    for (int k = kb; k < kb + kper; k += 16) {
        bf16x8 a;
        if (F32A) { const float* ap = (const float*)Aptr + (size_t)r32 * lda + k + 8 * hi; const f32x4 x0 = *(const f32x4*)ap, x1 = *(const f32x4*)(ap + 4);
            ss += (x0.x * x0.x + x0.y * x0.y) + (x0.z * x0.z + x0.w * x0.w) + (x1.x * x1.x + x1.y * x1.y) + (x1.z * x1.z + x1.w * x1.w);
            u32x4 w; w.x = pk2(x0.x, x0.y); w.y = pk2(x0.z, x0.w); w.z = pk2(x1.x, x1.y); w.w = pk2(x1.z, x1.w); a = __builtin_bit_cast(bf16x8, w); }
        else a = *(const bf16x8*)((const bf16_t*)Aptr + (size_t)r32 * lda + k + 8 * hi);
        acc0 = __builtin_amdgcn_mfma_f32_32x32x16_bf16(a, *(const bf16x8*)(bp0 + k), acc0, 0, 0, 0);
        if (PAIR) acc1 = __builtin_amdgcn_mfma_f32_32x32x16_bf16(a, *(const bf16x8*)(bp1 + k), acc1, 0, 0, 0);
    }
    LAS float* ssw = red + 2 * 8 * 1024;
#pragma unroll
    for (int r = 0; r < 16; ++r) { red[(wave * 16 + r) * 64 + lane] = acc0[r]; if (PAIR) red[8 * 1024 + (wave * 16 + r) * 64 + lane] = acc1[r]; }
    if (F32A) { ss += shfl_xor_(ss, 32); if (lane < 32) ssw[wave * 32 + lane] = ss; }
    __syncthreads();
#pragma unroll
    for (int i = 0; i < 2; ++i) { const int e = wave * 64 + lane + 512 * i, r = e >> 6, ln = e & 63, row = crow(r, ln >> 5);
        float v0 = 0.f, v1 = 0.f, sq = 0.f;
#pragma unroll
        for (int w = 0; w < 8; ++w) { v0 += red[(w * 16 + r) * 64 + ln]; if (PAIR) v1 += red[8 * 1024 + (w * 16 + r) * 64 + ln]; if (F32A) sq += ssw[w * 32 + row]; }
        epi(row, ln & 31, v0, v1, sq); }
}
DEV void wg_wait(const unsigned* c0, unsigned n0, const unsigned* c1, unsigned n1, int wave_s) { if (wave_s == 0) { const bool second = c1 != nullptr && (lane_id() & 1);
        pg8::poll_ge_lanes(second ? c1 : c0, second ? n1 : n0); pg8::acq_agent(); } __syncthreads(); }
DEV void wg_wait8(const unsigned* c, unsigned n, int wave_s) { if (wave_s == 0) { pg8::poll_ge_lanes(c + 64 * (lane_id() & 7), n); pg8::acq_agent(); } __syncthreads(); }
DEV void wg_post(unsigned* c, int wave_s) { __syncthreads(); if (wave_s == 0 && lane_id() == 0) { __builtin_amdgcn_fence(__ATOMIC_RELEASE, "agent"); asm volatile("s_waitcnt vmcnt(0)" ::: "memory"); __hip_atomic_fetch_add(c, 1u, __ATOMIC_RELAXED, __HIP_MEMORY_SCOPE_AGENT); } }
struct SampleW { const float *s5_c_re, *s5_c_im, *s5_d, *s5_w_glu, *s5_b_glu, *q_norm_g, *w_qb, *kv_norm_g, *w_uk, *w_uv, *w_gate, *b_gate, *gla_norm_g, *state_s5, *state_gla; };
template <int K> DEV float dot_bf16row(const bf16_t* row, const LAS float* x) {
    float a = 0.f;
#pragma unroll 8
    for (int k = 0; k < K; k += 8) { const u32x4 w = *(const u32x4*)(row + k); const f32x4 x0 = *(const LAS f32x4*)(x + k), x1 = *(const LAS f32x4*)(x + k + 4);
        const f32x4 w0 = pg8::unpk_lo(w.x, w.y), w1 = pg8::unpk_lo(w.z, w.w);
        a += (w0[0] * x0[0] + w0[1] * x0[1]) + (w0[2] * x0[2] + w0[3] * x0[3]) + (w1[0] * x1[0] + w1[1] * x1[1]) + (w1[2] * x1[2] + w1[3] * x1[3]); }
    return a;
}
template <int K> DEV float dot_f32row(const float* row, const LAS float* x) {
    float a = 0.f;
#pragma unroll 8
    for (int k = 0; k < K; k += 4) { const f32x4 w = *(const f32x4*)(row + k), xx = *(const LAS f32x4*)(x + k); a += (w[0] * xx[0] + w[1] * xx[1]) + (w[2] * xx[2] + w[3] * xx[3]); }
    return a;
}
DEV void sample_prep_task(int l, int b, int t, LAS unsigned char* sm, unsigned char* ws, float* out, const SampleW& w, const bf16_t* wqb, const bf16_t* wglu) {
    LAS float* u = (LAS float*)sm; LAS float* ys = u + 256; LAS float* cqn = ys + 256; LAS float* qv = cqn + 256; LAS float* red = qv + 768; LAS float* gdec = red + 16; LAS float* hsr = gdec + 128; LAS float* hsi = hsr + 1024;
    const int lane = t & 63, wv = t >> 6; const bool act = t < 256;
    const float* ps = (const float*)(ws + WS_PS) + (size_t)b * DINP;
    bf16_t* mixs = (bf16_t*)(ws + WS_MIXS) + (size_t)b * DM;
    __syncthreads();
    float cq = 0.f, t2 = 0.f;
    if (act) { u[t] = ps[t]; cq = ps[256 + t]; t2 = ps[512 + t];
        const float s1 = wave_sum(cq * cq), s2 = wave_sum(t < 128 ? t2 * t2 : 0.f);
        if (lane == 0) { red[wv] = s1; red[4 + wv] = s2; } }
    __syncthreads();
    const float rq = rsqrtf(((red[0] + red[1]) + (red[2] + red[3])) * (1.f / 256.f) + EPS), rk = rsqrtf(((red[4] + red[5]) + (red[6] + red[7])) * (1.f / 128.f) + EPS);
    if (act) cqn[t] = cq * rq;
#pragma unroll
    for (int i = 0; i < 2; ++i) { const int s = t + 512 * i, g = s >> 6, p = s & 63, lg = l * 16 + g;
        const float2 a = ((const float2*)(ws + WS_S5 + (size_t)lg * S5_SIZE + S5_ABAR))[p];
        const f32x4* bb = (const f32x4*)((const float2*)(ws + WS_S5 + (size_t)lg * S5_SIZE + S5_BBAR) + p * 16);
        const float2 h0 = *(const float2*)(w.state_s5 + ((((size_t)l * SB + b) * S5G + g) * S5P + p) * 2);
        float hr = a.x * h0.x - a.y * h0.y, hi = a.x * h0.y + a.y * h0.x;
#pragma unroll
        for (int c = 0; c < 8; ++c) { const f32x4 b2 = bb[c]; const float u0 = u[g * 16 + 2 * c], u1 = u[g * 16 + 2 * c + 1]; hr += b2[0] * u0 + b2[2] * u1; hi += b2[1] * u0 + b2[3] * u1; }
        hsr[s] = hr; hsi[s] = hi;
        *(float2*)(out + O_S5S + ((((size_t)l * SB + b) * S5G + g) * S5P + p) * 2) = make_float2(hr, hi); }
    __syncthreads();
    qv[t] = dot_bf16row<256>(wqb + (size_t)t * 256, cqn);
    if (act) { const int g = t >> 4, c = t & 15; const float* cr = w.s5_c_re + (((size_t)l * 16 + g) * 16 + c) * 64; const float* ci = w.s5_c_im + (((size_t)l * 16 + g) * 16 + c) * 64;
        const float y = dot_f32row<64>(cr, hsr + g * 64) - dot_f32row<64>(ci, hsi + g * 64) + w.s5_d[l * 256 + t] * u[t]; ys[t] = gelu_tanh(y); }
    else qv[256 + t] = dot_bf16row<256>(wqb + (size_t)(256 + t) * 256, cqn);
    __syncthreads();
    float* qlat = (float*)(ws + WS_QLAT) + (size_t)b * MH * 160;
#pragma unroll
    for (int i = 0; i < 2; ++i) { const int idx = t + 512 * i, h = idx >> 7, lp = idx & 127;
        qlat[h * 160 + lp] = dot_f32row<64>(w.w_uk + (((size_t)l * 128 + lp) * 8 + h) * 64, qv + h * 64) * QSCALE; }
    if (act) { const float z = dot_bf16row<256>(wglu + (size_t)t * 256, ys) + w.s5_b_glu[l * 256 + t]; mixs[t] = f2bf(ys[t] * sigmoidf_(z));
        const float* cosS = (const float*)(ws + WS_COS) + SEQ * 16; const float* sinS = (const float*)(ws + WS_SIN) + SEQ * 16;
        { const int h = t >> 5, j = t & 31, i = j & 15; const float x1 = qv[512 + h * 32 + rope_phys(i)], x2 = qv[512 + h * 32 + rope_phys(i + 16)];
            qlat[h * 160 + 128 + j] = (j < 16 ? x1 * cosS[i] - x2 * sinS[i] : x1 * sinS[i] + x2 * cosS[i]) * QSCALE; }
        float* kvnew = (float*)(ws + WS_KVNEW) + (size_t)b * 160;
        if (t < 128) { const float v = t2 * rk * w.kv_norm_g[l * 128 + t]; kvnew[t] = v; out[O_CKVS + ((size_t)l * SB + b) * KVL + t] = v; }
        else if (t < 160) { const int j = t - 128, i = j & 15; const float x1 = ps[640 + i], x2 = ps[656 + i];
            const float v = j < 16 ? x1 * cosS[i] - x2 * sinS[i] : x1 * sinS[i] + x2 * cosS[i]; kvnew[t] = v; out[O_KRS + ((size_t)l * SB + b) * ROPE + j] = v; }
        if (t < 128) { float z2 = w.b_gate[l * 128 + t];
#pragma unroll
            for (int r = 0; r < 16; ++r) z2 += ps[672 + r] * w.w_gate[((size_t)l * 16 + r) * 128 + t];
            gdec[t] = fexp(log_sigmoid(z2) * (1.f / 16.f)); } }
    __syncthreads();
    if (act) { const int h = t >> 6, v = t & 63; const float vv = ps[1024 + t]; float o = 0.f;
        const float* s0 = w.state_gla + (((size_t)l * SB + b) * GH + h) * GDK * GDV; float* so = out + O_GLAS + (((size_t)l * SB + b) * GH + h) * GDK * GDV;
#pragma unroll 8
        for (int d = 0; d < 32; ++d) { const float sN = gdec[h * 32 + d] * s0[d * 64 + v] + ps[896 + h * 32 + d] * vv; so[d * 64 + v] = sN; o += ps[768 + h * 32 + d] * 0.17677669529663687f * sN; }
        const float r = rsqrtf(wave_sum(o * o) * (1.f / 64.f) + EPS); const float gr = ps[1280 + t];
        mixs[768 + t] = f2bf(o * r * w.gla_norm_g[l * 256 + t] * gr * sigmoidf_(gr)); }
    __syncthreads();
}
DEV void sample_attn_task(int l, int item, int t, LAS unsigned char* sm, unsigned char* ws, const float* cache_ckv, const float* cache_kr, const int* page_table, const float* w_uv) {
    constexpr int KST = 168;
    LAS bf16_t* KB = (LAS bf16_t*)sm; LAS float* WO = (LAS float*)sm;
    LAS bf16_t* QB = (LAS bf16_t*)(sm + 256 * KST * 2); LAS float* QS = (LAS float*)(QB + 32 * KST);     LAS float* OL = QS + 8 * 160; LAS float* WM = OL + 8 * 128; LAS unsigned* FLAG = (LAS unsigned*)(WM + 128);
    const int b = item / NSPLIT, sp = item % NSPLIT, lane = t & 63, h = t >> 6, wv = h, r32 = lane & 31, hi = lane >> 5;
    __syncthreads();
    for (int i = t; i < 8 * 160; i += 512) QS[i] = ((const float*)(ws + WS_QLAT))[(size_t)b * 1280 + i];
    for (int i = t; i < 32 * KST / 2; i += 512) { const int row = (2 * i) / KST, col = (2 * i) % KST; float x0 = 0.f, x1 = 0.f;
        if (row < 8 && col < 160) { const float* qp = (const float*)(ws + WS_QLAT) + (size_t)b * 1280 + row * 160 + col; x0 = qp[0]; x1 = qp[1]; }
        ((LAS unsigned*)QB)[i] = pk2(x0, x1); }
    float m = -INFINITY, lsum = 0.f; f32x16 O[4];
#pragma unroll
    for (int c = 0; c < 4; ++c)
#pragma unroll
        for (int r = 0; r < 16; ++r) O[c][r] = 0.f;
    const LAS bf16_t* vtb = KB + (32 * wv + 4 * hi + ((lane & 15) >> 2)) * KST + 16 * ((lane >> 4) & 1) + 4 * (lane & 3);
    f32x4 pk[16], pr[4];
#define LOAD_STEP(it_) do { _Pragma("unroll") for (int pg_ = 0; pg_ < 2; ++pg_) { const int phys_ = page_table[b * NPAGES + sp * (KPS / PAGE) + 2 * (it_) + pg_]; \
        const f32x4* s1_ = (const f32x4*)(cache_ckv + ((size_t)l * NPOOL + phys_) * PAGE * KVL) + t; const f32x4* s2_ = (const f32x4*)(cache_kr + ((size_t)l * NPOOL + phys_) * PAGE * ROPE) + t; \
        _Pragma("unroll") for (int i_ = 0; i_ < 8; ++i_) pk[8 * pg_ + i_] = __builtin_nontemporal_load(s1_ + 512 * i_); pr[2 * pg_] = __builtin_nontemporal_load(s2_); pr[2 * pg_ + 1] = __builtin_nontemporal_load(s2_ + 512); } } while (0)
    LOAD_STEP(0);
    for (int it = 0; it < KPS / 256; ++it) {
        lds_barrier();
#pragma unroll
        for (int pg = 0; pg < 2; ++pg) {
#pragma unroll
            for (int i = 0; i < 8; ++i) { const int e = t + 512 * i, key = e >> 5, c4 = e & 31; const f32x4 v = pk[8 * pg + i]; u32x2 w; w.x = pk2(v[0], v[1]); w.y = pk2(v[2], v[3]); *(LAS u32x2*)(KB + (128 * pg + key) * KST + 4 * c4) = w; }
#pragma unroll
            for (int i = 0; i < 2; ++i) { const int e = t + 512 * i, key = e >> 3, c4 = e & 7; const f32x4 v = pr[2 * pg + i]; u32x2 w; w.x = pk2(v[0], v[1]); w.y = pk2(v[2], v[3]); *(LAS u32x2*)(KB + (128 * pg + key) * KST + 128 + 4 * c4) = w; } }
        if (it + 1 < KPS / 256) LOAD_STEP(it + 1);
        lds_barrier();
        f32x16 S;
#pragma unroll
        for (int r = 0; r < 16; ++r) S[r] = 0.f;
        const LAS bf16_t* kr_ = KB + (32 * wv + r32) * KST + 8 * hi;
#pragma unroll
        for (int s2 = 0; s2 < 10; ++s2) S = __builtin_amdgcn_mfma_f32_32x32x16_bf16(*(const LAS bf16x8*)(kr_ + 16 * s2), *(const LAS bf16x8*)(QB + r32 * KST + 8 * hi + 16 * s2), S, 0, 0, 0);
        float mx = S[0];
#pragma unroll
        for (int r = 1; r < 16; ++r) mx = fmaxf(mx, S[r]);
        mx = fmaxf(mx, shfl_xor_(mx, 32));
        const float mn = fmaxf(m, mx), al_ = fexp2(m - mn); float psum = 0.f;
#pragma unroll
        for (int r = 0; r < 16; ++r) { S[r] = fexp2(S[r] - mn); psum += S[r]; }
        psum += shfl_xor_(psum, 32); lsum = lsum * al_ + psum; m = mn;
        u32x4 pb[2];
#pragma unroll
        for (int ks = 0; ks < 2; ++ks) { pb[ks].x = pk2(S[8 * ks + 0], S[8 * ks + 1]); pb[ks].y = pk2(S[8 * ks + 2], S[8 * ks + 3]); pb[ks].z = pk2(S[8 * ks + 4], S[8 * ks + 5]); pb[ks].w = pk2(S[8 * ks + 6], S[8 * ks + 7]); }
#pragma unroll
        for (int c = 0; c < 4; ++c) {
#pragma unroll
            for (int r = 0; r < 16; ++r) O[c][r] *= al_;
#pragma unroll
            for (int ks = 0; ks < 2; ++ks) {
                const attn_body::s16x4 lo = attn_body::vtr((attn_body::lds_cptr)(vtb + (16 * ks) * KST + 32 * c)), hi4 = attn_body::vtr((attn_body::lds_cptr)(vtb + (16 * ks + 8) * KST + 32 * c));
                const bf16x8 af = {lo[0], lo[1], lo[2], lo[3], hi4[0], hi4[1], hi4[2], hi4[3]};
                O[c] = __builtin_amdgcn_mfma_f32_32x32x16_bf16(af, __builtin_bit_cast(bf16x8, pb[ks]), O[c], 0, 0, 0); } }
    }
#undef LOAD_STEP
    __syncthreads();
    if (r32 < 8 && hi == 0) { WM[(wv * 8 + r32) * 2] = m; WM[(wv * 8 + r32) * 2 + 1] = lsum; }
#pragma unroll
    for (int c = 0; c < 4; ++c) if (r32 < 8) {
#pragma unroll
        for (int r = 0; r < 16; ++r) WO[(wv * 8 + r32) * 128 + 32 * c + crow(r, hi)] = O[c][r]; }
    __syncthreads();
    float o0 = 0.f, o1 = 0.f;
    { float mx = -INFINITY;
#pragma unroll
      for (int w2 = 0; w2 < 8; ++w2) mx = fmaxf(mx, WM[(w2 * 8 + h) * 2]);
      float L = 0.f;
#pragma unroll
      for (int w2 = 0; w2 < 8; ++w2) { const float f = fexp2(WM[(w2 * 8 + h) * 2] - mx); L += f * WM[(w2 * 8 + h) * 2 + 1]; o0 += f * WO[(w2 * 8 + h) * 128 + lane]; o1 += f * WO[(w2 * 8 + h) * 128 + 64 + lane]; }
      m = mx; lsum = L; }
    float* opl = (float*)(ws + WS_OP) + (size_t)l * SB * NSPLIT * MH * 128; float* mll = (float*)(ws + WS_ML) + (size_t)l * SB * NSPLIT * MH * 2;
    { float* op = opl + (((size_t)b * NSPLIT + sp) * MH + h) * 128;
      __hip_atomic_store(op + lane, o0, __ATOMIC_RELAXED, __HIP_MEMORY_SCOPE_AGENT); __hip_atomic_store(op + 64 + lane, o1, __ATOMIC_RELAXED, __HIP_MEMORY_SCOPE_AGENT);
      if (lane == 0) { float* ml = mll + (((size_t)b * NSPLIT + sp) * MH + h) * 2; __hip_atomic_store(ml, m, __ATOMIC_RELAXED, __HIP_MEMORY_SCOPE_AGENT); __hip_atomic_store(ml + 1, lsum, __ATOMIC_RELAXED, __HIP_MEMORY_SCOPE_AGENT); } }
    asm volatile("s_waitcnt vmcnt(0)" ::: "memory");
    __syncthreads();
    if (t == 0) { unsigned* cnt = (unsigned*)(ws + WS_CTL) + CW_CNT + (l * SB + b) * 64;
        const unsigned old = __hip_atomic_fetch_add(cnt, 1u, __ATOMIC_RELAXED, __HIP_MEMORY_SCOPE_AGENT);
        const unsigned last = old == (unsigned)(NSPLIT - 1) ? 1u : 0u;
        if (last) __builtin_amdgcn_fence(__ATOMIC_ACQUIRE, "agent");
        FLAG[0] = last; }
    __syncthreads();
    if (FLAG[0] != 0u) {
        const float* kn = (const float*)(ws + WS_KVNEW) + (size_t)b * 160;
        float sn = QS[h * 160 + lane] * kn[lane] + QS[h * 160 + 64 + lane] * kn[64 + lane] + (lane < 32 ? QS[h * 160 + 128 + lane] * kn[128 + lane] : 0.f);
        sn = wave_sum(sn);
        const float* ml = mll + ((size_t)b * NSPLIT * MH + h) * 2; const float* op = opl + ((size_t)b * NSPLIT * MH + h) * 128;
        float mx = sn;
        for (int s = 0; s < NSPLIT; ++s) mx = fmaxf(mx, ml[s * MH * 2]);
        const float wn = fexp2(sn - mx); float L = wn, a0 = wn * kn[lane], a1 = wn * kn[64 + lane];
#pragma unroll
        for (int s = 0; s < NSPLIT; ++s) { const float ws_ = fexp2(ml[s * MH * 2] - mx); L += ws_ * ml[s * MH * 2 + 1]; a0 += ws_ * op[s * MH * 128 + lane]; a1 += ws_ * op[s * MH * 128 + 64 + lane]; }
        const float inv = 1.f / L; OL[h * 128 + lane] = a0 * inv; OL[h * 128 + 64 + lane] = a1 * inv;
        asm volatile("s_waitcnt lgkmcnt(0)" ::: "memory");
        float a = 0.f; const float* uv = w_uv + (size_t)l * 128 * 512 + h * 64 + lane;
#pragma unroll 16
        for (int lp = 0; lp < 128; ++lp) a += OL[h * 128 + lp] * uv[(size_t)lp * 512];
        ((bf16_t*)(ws + WS_MIXS))[(size_t)b * DM + 256 + h * 64 + lane] = f2bf(a);
        wg_post((unsigned*)(ws + WS_CTL) + CW_DR + 64 * l, h);
    }
}
#ifndef MK_CUT
#define MK_CUT 0
#endif
__global__ void __launch_bounds__(512, 2) mk_fwd(MKArgs args) {
    extern __shared__ __attribute__((aligned(16))) unsigned char lds[];
    LAS unsigned char* ldsl = (LAS unsigned char*)lds;
    volatile LAS unsigned* MISC = (volatile LAS unsigned*)(ldsl + MISC_OFF);
    const int wave_s = __builtin_amdgcn_readfirstlane((int)threadIdx.x >> 6);
#define PHASE_IDS int tid = wave_s * 64 + lane_id(); asm volatile("" : "+v"(tid)); const int lane = tid & 63, wave = __builtin_amdgcn_readfirstlane(tid >> 6), gw = bx * 8 + wave, gtid = bx * 512 + tid; (void)lane; (void)gw; (void)gtid;
    { const int bx = blockIdx.x; PHASE_IDS
      for (int u = tid; u < (LDS_BYTES - LDSCTL_OFF) / 4; u += 512) ((LAS unsigned*)(ldsl + LDSCTL_OFF))[u] = 0u; }
    __syncthreads();
    XcdBarrier bar = xcd_barrier_post((unsigned*)(args.ws + WS_CTL) + CW_BAR + args.li * XCD_BAR_WORDS, MISC + 8, wave_s == 0 && lane_id() == 0);
    const int lo = args.ph_lo, hi = args.ph_hi; (void)lo; (void)hi;
#if MK_CUT
#define IN(k) (lo <= (k) && (k) < hi)
#else
#define IN(k) true
#endif
#define SEAM(k) do { if (IN(k) && IN((k) + 1)) xcd_barrier(bar, wave_s == 0 && lane_id() == 0); } while (0)
#define PHASE_PTRS const CAS unsigned long long* ap = (const CAS unsigned long long*)__builtin_amdgcn_kernarg_segment_ptr(); asm volatile("" : "+s"(ap)); unsigned char* ws = KPTR(unsigned char, ap, 36); float* out = KPTR(float, ap, 35); int G = (int)gridDim.x, bx = (int)blockIdx.x; unsigned ldsb_ = 0u; asm volatile("" : "+s"(G), "+s"(bx), "+s"(ldsb_)); \
    const int ngw = G * 8, gthreads = G * 512; LAS unsigned char* ldsl = (LAS unsigned char*)lds + ldsb_; (void)ngw; (void)gthreads; (void)ldsl; \
    bf16_t* XB = (bf16_t*)(ws + WS_XB); float* RSX = (float*)(ws + WS_RSX); float* xp = out + O_YP; float* xs = out + O_YS; \
    const float* x_prompt = KPTR(const float, ap, 0); const float* x_sample = KPTR(const float, ap, 1); (void)XB; (void)RSX; (void)xp; (void)xs; (void)x_prompt; (void)x_sample;

#define S5M_LAYER(L, T0, TS) do { const float *a_re_ = KPTR(const float, ap, 10), *a_im_ = KPTR(const float, ap, 11), *ldt_ = KPTR(const float, ap, 12), *c_re_ = KPTR(const float, ap, 15), *c_im_ = KPTR(const float, ap, 16); \
    for (int id = (T0); id < 16 * 63 * 32; id += (TS)) s5_mat_T(a_re_, a_im_, ldt_, c_re_, c_im_, ws, (L) * 16 * 63 * 32 + id); \
    for (int id = (T0); id < 16 * 128 * 32; id += (TS)) s5_mat_Q(a_re_, a_im_, ldt_, ws, (L) * 16 * 128 * 32 + id); \
    for (int id = (T0); id < 16 * 32 * 16 * 16; id += (TS)) s5_mat_P(a_re_, a_im_, ldt_, c_re_, c_im_, ws, (L) * 16 * 32 * 16 * 16 + id); \
    for (int id = (T0); id < 16 * 64; id += (TS)) { const int gi_ = (L) * 16 * 64 + id; ((float2*)(ws + WS_S5 + (size_t)(gi_ >> 6) * S5_SIZE + S5_AL))[gi_ & 63] = ((const float2*)(ws + WS_APOW))[((size_t)(gi_ >> 6) * 33 + 32) * 64 + (gi_ & 63)]; } } while (0)
#ifndef REP_P0
#define REP_P0 1
#endif
#ifndef REP_P2
#define REP_P2 1
#endif
#ifndef REP_P3
#define REP_P3 1
#endif
#ifndef REP_P1
#define REP_P1 1
#endif
#ifndef REP_P5
#define REP_P5 1
#endif
#ifndef REP_GLA
#define REP_GLA 1
#endif
#ifndef REP_S5
#define REP_S5 1
#endif
#ifndef REP_PREP
#define REP_PREP 1
#endif
#ifndef REP_MISC
#define REP_MISC 1
#endif
#ifndef REP_ATTN
#define REP_ATTN 1
#endif
#ifndef REP_DEC
#define REP_DEC 1
#endif
    for (int rep_ = 0; rep_ < REP_P0; ++rep_) {
    if (rep_) xcd_barrier(bar, wave_s == 0 && lane_id() == 0);
    if (IN(0)) { PHASE_PTRS PHASE_IDS
        cvt_layer_wg(0, bx, G, tid, ldsl + RING_OFF, ws, ap);
        for (int id = gtid; id < DEPTH * 16 * 64; id += gthreads) s5_pre_item(KPTR(const float, ap, 10), KPTR(const float, ap, 11), KPTR(const float, ap, 12), KPTR(const float, ap, 13), KPTR(const float, ap, 14), ws, id >> 6, id & 63);
        for (int id = gtid; id < (SEQ + 1) * 16; id += gthreads) rope_item(ws, id);
        for (int id = gtid; id < DEPTH * 16 * 33 * 64; id += gthreads) { const int p = id & 63, tau = (id >> 6) % 33, lg = id / (33 * 64);
            ((float2*)(ws + WS_APOW))[id] = cpow_(KPTR(const float, ap, 10)[lg * 64 + p], KPTR(const float, ap, 11)[lg * 64 + p], expf(KPTR(const float, ap, 12)[lg]), tau); }
        for (int row = gw; row < M; row += ngw) xprep_row(x_prompt, XB, RSX, row, lane);
    }
    SEAM(0);
    if (IN(1)) { PHASE_PTRS PHASE_IDS
        S5M_LAYER(0, gtid, gthreads);
    }
    }

    for (int l = 0; l < DEPTH; ++l) {
        const int pb = 2 + 7 * l;
#define LAYER_PTRS PHASE_PTRS unsigned char* wl = ws + WS_W + (size_t)l * WL_SIZE; const float* xin_s = l == 0 ? x_sample : xs; (void)wl; (void)xin_s;
        for (int rep_ = 0; rep_ < REP_P1; ++rep_) { if (rep_) xcd_barrier(bar, wave_s == 0 && lane_id() == 0);
        if (IN(pb + 0)) { LAYER_PTRS
            const bool rd = G == 256; unsigned* ctl = (unsigned*)(ws + WS_CTL);
            if (rd && l > 0) wg_wait(ctl + CW_WIN + 64 * l, 384u / CVT_CH, nullptr, 0u, wave_s);
            { pg8::Gemm g{XB, (const bf16_t*)(wl + WL_IN), M, DINP, DM}; pg8::Order1 S; S.init(M, DINP, G, bx); S.redeal = rd; S.x = bx & 7; S.r = bx >> 3; S.wv = wave_s;
              S.rdy = ctl + CW_P6 + (l > 0 ? l - 1 : 0) * 64 * 64; S.need = l > 0 ? 32u : 0u;
              pg8::EpiWin E{RSX, (bf16_t*)(ws + WS_U5), (bf16_t*)(ws + WS_CQB), (float*)(ws + WS_RSCQ), (float*)(ws + WS_T2F), (bf16_t*)(ws + WS_T2B), (float*)(ws + WS_RSKV), (float*)(ws + WS_QKF), (bf16_t*)(ws + WS_GVB), (bf16_t*)(ws + WS_GRB), (LAS float*)(ldsl + XCH_OFF) + 1024};
              pg8::gemm_phase<pg8::EpiWin, pg8::Order1, true, true>(ldsl + RING_OFF, g, S, E, wave_s); }
            { PHASE_IDS float* PS = (float*)(ws + WS_PS);
              const int k0_ = rd ? bx - 128 : G - 1 - bx;
              if (rd && l > 0 && k0_ >= 0 && k0_ < DINP / 32) wg_wait(ctl + CW_S6 + 64 * (l - 1), DM / 32, nullptr, 0u, wave_s);
              for (int k = k0_; k >= 0 && k < DINP / 32; k += G)
                sgemm_wg<true, false>(xin_s, DM, (const bf16_t*)(wl + WL_IN), DM, DM, 32 * k, 0, wave, lane, (LAS float*)(ldsl + RING_OFF), [&](int row, int c, float v, float, float ssq) { PS[(size_t)row * DINP + 32 * k + c] = v * rsqrtf(ssq * (1.f / DM) + EPS); }); }
        }
        }
        SEAM(pb + 0);
        for (int rep_ = 0; rep_ < REP_P2; ++rep_) { if (rep_) xcd_barrier(bar, wave_s == 0 && lane_id() == 0);
        if (IN(pb + 1)) { LAYER_PTRS
            constexpr int NGLA = NB * GH;
            if (bx < NGLA && G > NGLA) xcd_barrier<true>(bar, wave_s == 0 && lane_id() == 0);
            if (bx >= NGLA) { pg8::Gemm g{(const bf16_t*)(ws + WS_CQB), (const bf16_t*)(wl + WL_QB), M, 768, 256}; pg8::StaticOrder S; S.init(M, 768, G - NGLA, bx - NGLA);
              pg8::EpiQ E{(const float*)(ws + WS_RSCQ), (const float*)(ws + WS_COS), (const float*)(ws + WS_SIN), (bf16_t*)(ws + WS_QN), (bf16_t*)(ws + WS_QP)};
              pg8::gemm_phase<pg8::EpiQ, pg8::StaticOrder, true, true>(ldsl + RING_OFF, g, S, E, wave_s); }
            if (bx >= NGLA) { pg8::Gemm g{(const bf16_t*)(ws + WS_T2B), (const bf16_t*)(wl + WL_KV), M, 1024, 256}; pg8::StaticOrder S; S.init(M, 1024, G - NGLA, bx - NGLA);
              pg8::EpiKV E{(const float*)(ws + WS_RSKV), (bf16_t*)(ws + WS_KN), (bf16_t*)(ws + WS_VB)};
              pg8::gemm_phase<pg8::EpiKV, pg8::StaticOrder, true, true>(ldsl + RING_OFF, g, S, E, wave_s); }
            for (int r2_ = 0; r2_ < REP_GLA; ++r2_) { PHASE_IDS for (int k = bx; k < NB * GH; k += G) { gla_task(l, k >> 2, k & 3, wave, lane, ldsl + RING_OFF, ws, out, KPTR(const float, ap, 27), KPTR(const float, ap, 25) + (size_t)l * 16 * 128, KPTR(const float, ap, 26) + l * 128);
                wg_post((unsigned*)(ws + WS_CTL) + CW_GL + (l * NB + (k >> 2)) * 64, wave_s); } }
            for (int r2_ = 0; r2_ < REP_S5 + REP_PREP - 1; ++r2_) { PHASE_IDS if (r2_ == 0 || REP_S5 > 1) for (int k = (2 * G - 33 - bx) % G; k < NB * 16; k += G) s5_task(l, k >> 4, k & 15, wave, lane, ldsl + RING_OFF, ws, out, KPTR(const float, ap, 17));
            { const SampleW sw{KPTR(const float, ap, 15), KPTR(const float, ap, 16), KPTR(const float, ap, 17), KPTR(const float, ap, 18), KPTR(const float, ap, 19), KPTR(const float, ap, 20), KPTR(const float, ap, 21), KPTR(const float, ap, 22), KPTR(const float, ap, 23), KPTR(const float, ap, 24), KPTR(const float, ap, 25), KPTR(const float, ap, 26), KPTR(const float, ap, 27), KPTR(const float, ap, 5), KPTR(const float, ap, 6)};
              if (r2_ == 0 || REP_PREP > 1) for (int b = G - 1 - bx; b < SB; b += G) sample_prep_task(l, b, tid, ldsl + RING_OFF, ws, out, sw, (const bf16_t*)(wl + WL_QB), (const bf16_t*)(wl + WL_GLU)); } }
            if (bx >= NGLA) { volatile LAS unsigned* LQ = (volatile LAS unsigned*)(ldsl + LDSCTL_OFF + 512); unsigned* q2 = (unsigned*)(ws + WS_CTL) + CW_Q2 + 64 * l;
              for (;;) {
                  if (wave_s == 0 && lane_id() == 0) LQ[1] = __hip_atomic_fetch_add(q2, 1u, __ATOMIC_RELAXED, __HIP_MEMORY_SCOPE_AGENT);
                  __syncthreads(); const unsigned blk = LQ[1]; __syncthreads();
                  if (blk >= (unsigned)(M / 32)) break;
                  { PHASE_IDS
                    misc_rows4(l, (int)blk * 32 + wave * 4, lane, ws, out, KPTR(const float, ap, 22) + l * 128); } } }
            if ((bx >= NGLA || G <= NGLA) && IN(pb + 2)) xcd_barrier<true>(bar, wave_s == 0 && lane_id() == 0);
            if (l + 1 < DEPTH && bx >= NB * GH && G > NB * GH) { PHASE_IDS const int t0_ = gtid - NB * GH * 512, ts_ = (G - NB * GH) * 512;
              if (CVT_Q0 > 0) cvt_layer_wg(l + 1, bx - NB * GH, G - NB * GH, tid, ldsl + RING_OFF, ws, ap, 0, CVT_Q0);
              S5M_LAYER(l + 1, t0_, ts_); }
        }
        }
        if (IN(pb + 1) && IN(pb + 2)) xcd_barrier_wait(bar, wave_s == 0 && lane_id() == 0);
        for (int rep_ = 0; rep_ < REP_P3; ++rep_) { if (rep_) xcd_barrier(bar, wave_s == 0 && lane_id() == 0);
        if (IN(pb + 2)) { LAYER_PTRS
            { volatile LAS unsigned* LQ = (volatile LAS unsigned*)(ldsl + LDSCTL_OFF + 512);
              unsigned* qd = (unsigned*)(ws + WS_CTL) + CW_Q3 + 128 * l; unsigned* qa = qd + 64;
              const bool dclass = ((bx >> 3) % 5) == 4;
              constexpr unsigned ND = SB * NSPLIT, NA = NB * MH * 8 + M / 256;
              for (;;) {
                  if (wave_s == 0 && lane_id() == 0) { unsigned kind = 2u, idx = 0u;
                      if (dclass) { idx = __hip_atomic_fetch_add(qd, 1u, __ATOMIC_RELAXED, __HIP_MEMORY_SCOPE_AGENT); if (idx < ND) kind = 0u; else { idx = __hip_atomic_fetch_add(qa, 1u, __ATOMIC_RELAXED, __HIP_MEMORY_SCOPE_AGENT); if (idx < NA) kind = 1u; } }
                      else { idx = __hip_atomic_fetch_add(qa, 1u, __ATOMIC_RELAXED, __HIP_MEMORY_SCOPE_AGENT); if (idx < NA) kind = 1u; else { idx = __hip_atomic_fetch_add(qd, 1u, __ATOMIC_RELAXED, __HIP_MEMORY_SCOPE_AGENT); if (idx < ND) kind = 0u; } }
                      LQ[0] = kind; LQ[1] = idx; }
                  __syncthreads();
                  const unsigned kind = LQ[0], idx = LQ[1];
                  __syncthreads();
                  if (kind == 2u) break;
                  if (kind == 0u) { PHASE_IDS sample_attn_task(l, (int)idx, tid, ldsl + RING_OFF, ws, KPTR(const float, ap, 2), KPTR(const float, ap, 3), (const int*)KPTR(const float, ap, 4), KPTR(const float, ap, 24)); }
                  else if (idx < (unsigned)(M / 256)) {
                      pg8::Gemm g{(const bf16_t*)(ws + WS_Y5), (const bf16_t*)(wl + WL_GLU), M, 256, 256}; const pg8::OneUnitPub S{(int)idx, 0, (unsigned*)(ws + WS_CTL) + CW_MX + (l * 64 + (int)idx) * 64};
                      pg8::EpiGlu E{(const bf16_t*)(ws + WS_Y5), KPTR(const float, ap, 19) + l * 256, (bf16_t*)(ws + WS_MIX)};
                      pg8::gemm_phase<pg8::EpiGlu, pg8::OneUnitPub, true, true>(ldsl + RING_OFF, g, S, E, wave_s); }
                  else { const int ia = (int)idx - M / 256, qb = 7 - (ia >> 6), bh = ia & 63;
                      attn_body::attn_unit<8>(wave_s, bh / attn_body::NHEAD, bh % attn_body::NHEAD, qb, (const attn_body::bf16*)(ws + WS_QN), (const attn_body::bf16*)(ws + WS_QP), (const attn_body::bf16*)(ws + WS_KN), (const attn_body::bf16*)(ws + WS_KP), (const attn_body::bf16*)(ws + WS_VB), (attn_body::bf16*)(ws + WS_MIX), (char*)lds + RING_OFF);
                      pg8::pub_wave((unsigned*)(ws + WS_CTL) + CW_MX + (l * 64 + (bh / attn_body::NHEAD) * 8 + qb) * 64); }
              } }
        }
        }
        if ((int)gridDim.x != 256) SEAM(pb + 2);
        if (IN(pb + 3)) { LAYER_PTRS
            const bool mrg = G == 256; unsigned* ctl = (unsigned*)(ws + WS_CTL);
            const int pm4 = 8 * (bx & 7) + 7 - (bx >> 5), pn4 = (bx >> 3) & 3;
            if (mrg) wg_wait(ctl + CW_MX + (l * 64 + pm4) * 64, 9u * 8u, ctl + CW_GL + (l * NB + (bx & 7)) * 64, (unsigned)GH, wave_s);
            { pg8::Gemm g{(const bf16_t*)(ws + WS_MIX), (const bf16_t*)(wl + WL_OUT), M, DM, DM}; pg8::Order6 S; S.init(M, DM, G, bx); S.redeal = mrg; S.pm0 = pm4; S.pn0 = pn4; S.cnt = ctl + CW_P4 + l * 64 * 64;
              pg8::EpiResidT<true> E{l == 0 ? x_prompt : nullptr, XB, RSX};
              pg8::gemm_phase<pg8::EpiResidT<true>, pg8::Order6, true, true>(ldsl + RING_OFF, g, S, E, wave_s); }
            if (l + 1 < DEPTH) { volatile LAS unsigned* LQ = (volatile LAS unsigned*)(ldsl + LDSCTL_OFF + 512); unsigned* qc = ctl + CW_Q3 + 128 * l + 32;
              constexpr unsigned NC = (CVT_TILES_PER_LAYER - CVT_Q0 + CVT_CH - 1) / CVT_CH;
              for (;;) {
                  if (wave_s == 0 && lane_id() == 0) LQ[1] = __hip_atomic_fetch_add(qc, 1u, __ATOMIC_RELAXED, __HIP_MEMORY_SCOPE_AGENT);
                  __syncthreads(); const unsigned idx = LQ[1]; __syncthreads();
                  if (idx >= NC) break;
                  { PHASE_IDS const int tb_ = CVT_Q0 + CVT_CH * (int)idx; cvt_layer_wg(l + 1, 0, 1, tid, ldsl + RING_OFF, ws, ap, tb_, tb_ + CVT_CH < CVT_TILES_PER_LAYER ? tb_ + CVT_CH : CVT_TILES_PER_LAYER); }
                  if (mrg && CVT_CH * (idx + 1) <= 384u) wg_post(ctl + CW_WIN + 64 * (l + 1), wave_s); } }
            if (mrg && G - 1 - bx < DM / 32) wg_wait(ctl + CW_DR + 64 * l, (unsigned)SB, nullptr, 0u, wave_s);
            { PHASE_IDS for (int k = G - 1 - bx; k < DM / 32; k += G) {
                sgemm_wg<false, false>(ws + WS_MIXS, DM, (const bf16_t*)(wl + WL_OUT), DM, DM, 32 * k, 0, wave, lane, (LAS float*)(ldsl + RING_OFF), [&](int row, int c, float v, float, float) { const size_t o = (size_t)row * DM + 32 * k + c; xs[o] = xin_s[o] + v; });
                if (mrg) wg_post(ctl + CW_S4 + 64 * l, wave_s); } }
        }
        if ((int)gridDim.x != 256) SEAM(pb + 3);
        for (int rep_ = 0; rep_ < REP_P5; ++rep_) { if (rep_) xcd_barrier(bar, wave_s == 0 && lane_id() == 0);
        if (IN(pb + 4)) { LAYER_PTRS
            const bool rd = G == 256; unsigned* ctl = (unsigned*)(ws + WS_CTL);
            if (rd) wg_wait8(ctl + CW_P4 + (l * 64 + 8 * (bx & 7)) * 64, 4u * 8u, wave_s);
            { pg8::Gemm g{XB, (const bf16_t*)(wl + WL_FFI), M, DFF2, DM}; pg8::Order5 S; S.init(M, DFF2, G, bx); S.redeal = rd; S.x = bx & 7; S.r = bx >> 3; S.grp = ctl + CW_G5 + l * 16 * 64;
              pg8::EpiFfi E{RSX, KPTR(const float, ap, 31) + (size_t)l * 3 * DFF, KPTR(const float, ap, 32) + (size_t)l * DFF, (bf16_t*)(ws + WS_H), (float*)(ws + WS_FV), (float*)(ws + WS_FG), (float*)(ws + WS_LG), out + O_CONVP + (size_t)l * NB * 2 * DFF, (LAS float*)(ldsl + XCH_OFF)};
              pg8::gemm_phase<pg8::EpiFfi, pg8::Order5, true, true>(ldsl + RING_OFF, g, S, E, wave_s); }
            { PHASE_IDS const float* cw = KPTR(const float, ap, 31) + (size_t)l * 3 * DFF; const float* cbs = KPTR(const float, ap, 32) + (size_t)l * DFF; const float* stc = KPTR(const float, ap, 7) + (size_t)l * SB * 2 * DFF;
              bf16_t* HS = (bf16_t*)(ws + WS_HS); float* oc = out + O_CONVS + (size_t)l * SB * 2 * DFF;
              if (rd && G - 1 - bx < DFF / 32) wg_wait(ctl + CW_S4 + 64 * l, DM / 32, nullptr, 0u, wave_s);
              for (int k = G - 1 - bx; k < DFF / 32; k += G) { const int pv = 256 * (k >> 2) + 32 * (k & 3);
                sgemm_wg<true, true>(xs, DM, (const bf16_t*)(wl + WL_FFI), DM, DM, pv, pv + 128, wave, lane, (LAS float*)(ldsl + RING_OFF), [&](int row, int cc, float v, float gt, float ssq) {
                    const float r = rsqrtf(ssq * (1.f / DM) + EPS); const int c = 32 * k + cc; const float g0 = gt * r, b0 = stc[((size_t)row * 2 + 0) * DFF + c], b1 = stc[((size_t)row * 2 + 1) * DFF + c];
                    const float conv = cbs[c] + cw[c] * b0 + cw[DFF + c] * b1 + cw[2 * DFF + c] * g0;
                    HS[(size_t)row * DFF + c] = f2bf(gelu_tanh(conv) * v * r); oc[((size_t)row * 2 + 0) * DFF + c] = b1; oc[((size_t)row * 2 + 1) * DFF + c] = g0; });
                if (rd) wg_post(ctl + CW_S5 + 64 * l, wave_s); } }
        }
        }
        if ((int)gridDim.x != 256) SEAM(pb + 4);
        if (IN(pb + 6)) { LAYER_PTRS
            const bool rd = G == 256; unsigned* ctl = (unsigned*)(ws + WS_CTL);
            const int r6_ = bx >> 3, g6_ = r6_ >= 16 ? 0 : 1, j6_ = r6_ & 15, pm6 = 8 * (bx & 7) + 4 * g6_ + (j6_ & 3), pn6 = j6_ >> 2;
            if (rd) wg_wait(ctl + CW_G5 + (l * 16 + 2 * (bx & 7) + g6_) * 64, 88u * 8u, g6_ ? ctl + CW_G5 + (l * 16 + 2 * (bx & 7)) * 64 : nullptr, 88u * 8u, wave_s);
            { PHASE_IDS const float* cw = KPTR(const float, ap, 31) + (size_t)l * 3 * DFF; const float* cbs = KPTR(const float, ap, 32) + (size_t)l * DFF;
              const float* FV = (const float*)(ws + WS_FV); const float* FG = (const float*)(ws + WS_FG); const float* LG = (const float*)(ws + WS_LG); bf16_t* H = (bf16_t*)(ws + WS_H);
#pragma unroll 1
              for (int i = 0;; ++i) { const int pm = __builtin_amdgcn_readfirstlane(rd ? (i == 0 ? pm6 : -1) : pg8::static_pm(M, DM, G, bx, i)); if (pm < 0) break; const bool first = (pm & 7) == 0;
#pragma unroll
                  for (int k = 0; k < 2 * DFF / 512; ++k) { const int id = tid + 512 * k, rr = id >= DFF ? 1 : 0, c = id - rr * DFF;
                      const float g0 = FG[((size_t)pm * 2 + rr) * DFF + c], lg1 = first ? 0.f : LG[((size_t)(pm - 1) * 2 + 1) * DFF + c], lg0 = first ? 0.f : LG[((size_t)(pm - 1) * 2 + 0) * DFF + c];
                      const float gm1 = rr == 1 ? FG[((size_t)pm * 2 + 0) * DFF + c] : lg1, gm2 = rr == 1 ? lg1 : lg0;
                      const float conv = cbs[c] + cw[c] * gm2 + cw[DFF + c] * gm1 + cw[2 * DFF + c] * g0;
                      H[((size_t)pm * 256 + rr) * DFF + c] = f2bf(gelu_tanh(conv) * FV[((size_t)pm * 2 + rr) * DFF + c]); } }
              __syncthreads(); }
            { pg8::Gemm g{(const bf16_t*)(ws + WS_H), (const bf16_t*)(wl + WL_FFO), M, DM, DFF}; pg8::Order6 S; S.init(M, DM, G, bx); S.redeal = rd; S.pm0 = pm6; S.pn0 = pn6; S.cnt = ctl + CW_P6 + l * 64 * 64;
              pg8::EpiResidT<true> E{nullptr, XB, RSX};
              pg8::gemm_phase<pg8::EpiResidT<true>, pg8::Order6, true, true>(ldsl + RING_OFF, g, S, E, wave_s); }
            { PHASE_IDS const int k0_ = rd ? bx - 128 : G - 1 - bx;
              if (rd && k0_ >= 0 && k0_ < DM / 32) wg_wait(ctl + CW_S5 + 64 * l, DFF / 32, nullptr, 0u, wave_s);
              for (int k = k0_; k >= 0 && k < DM / 32; k += G) {
                sgemm_wg<false, false>(ws + WS_HS, DFF, (const bf16_t*)(wl + WL_FFO), DFF, DFF, 32 * k, 0, wave, lane, (LAS float*)(ldsl + RING_OFF), [&](int row, int c, float v, float, float) { xs[(size_t)row * DM + 32 * k + c] += v; });
                if (rd) wg_post(ctl + CW_S6 + 64 * l, wave_s); } }
        }
        if ((int)gridDim.x != 256) SEAM(pb + 6);
    }
    if (IN(N_PHASES - 1)) { PHASE_PTRS PHASE_IDS
        const float* g = KPTR(const float, ap, 34);
        const bool mrg = G == 256; unsigned* ctl = (unsigned*)(ws + WS_CTL);
        const int r6_ = bx >> 3, g6_ = r6_ >= 16 ? 0 : 1, j6_ = r6_ & 15, rb_ = 256 * (8 * (bx & 7) + 4 * g6_ + (j6_ & 3)) + 64 * (j6_ >> 2) + 8 * wave;
        if (mrg) wg_wait(ctl + CW_P6 + ((DEPTH - 1) * 64 + (rb_ >> 8)) * 64, 4u * 8u, bx < 4 ? ctl + CW_S6 + 64 * (DEPTH - 1) : nullptr, DM / 32, wave_s);
        const int nit_ = mrg ? (bx < 4 ? 5 : 4) : (M + SB - gw + 2 * ngw - 1) / (2 * ngw);
#pragma unroll 1
        for (int it_ = 0; it_ < nit_; ++it_) {
            f32x4 v[2][4]; float s2[2] = {0.f, 0.f};
            const int rowA_ = mrg ? (it_ < 4 ? rb_ + 2 * it_ : M + 8 * bx + wave) : gw + 2 * it_ * ngw, rowB_ = mrg ? (it_ < 4 ? rowA_ + 1 : M + SB) : rowA_ + ngw;
#pragma unroll
            for (int q = 0; q < 2; ++q) { const int row = q ? rowB_ : rowA_;
                if (row < M) {
#pragma unroll
                    for (int j2 = 0; j2 < 4; ++j2) { const u32x2 w = *(const u32x2*)(XB + (size_t)row * DM + 256 * j2 + 4 * lane); v[q][j2] = pg8::unpk_lo(w.x, w.y); }
                } else if (row < M + SB) {
#pragma unroll
                    for (int j2 = 0; j2 < 4; ++j2) v[q][j2] = *(const f32x4*)(xs + (size_t)(row - M) * DM + 256 * j2 + 4 * lane);
                } else {
#pragma unroll
                    for (int j2 = 0; j2 < 4; ++j2) v[q][j2] = (f32x4){0.f, 0.f, 0.f, 0.f}; } }
#pragma unroll
            for (int q = 0; q < 2; ++q) { const int row = q ? rowB_ : rowA_;
#pragma unroll
                for (int j2 = 0; j2 < 4; ++j2) s2[q] += (v[q][j2].x * v[q][j2].x + v[q][j2].y * v[q][j2].y) + (v[q][j2].z * v[q][j2].z + v[q][j2].w * v[q][j2].w);
                const float r = rsqrtf(wave_sum(s2[q]) * (1.f / DM) + EPS);
                if (row < M + SB) { float* yo = row < M ? xp + (size_t)row * DM : xs + (size_t)(row - M) * DM;
#pragma unroll
                    for (int j2 = 0; j2 < 4; ++j2) { const f32x4 gg = *(const f32x4*)(g + 256 * j2 + 4 * lane); *(f32x4*)(yo + 256 * j2 + 4 * lane) = v[q][j2] * r * gg; } } }
        }
    }
#undef IN
#undef SEAM
}

#include <string.h>
extern "C" void kernel_launch(void* const* d_in, const int* in_sizes, int n_in, void* d_out, int out_size, void* d_ws, size_t ws_size, hipStream_t stream) {
    static int grid = 0;
    if (grid == 0) {
        if (n_in != 35 || (size_t)out_size != O_END || ws_size < WS_END) { fprintf(stderr, "kernel_launch: unexpected sizes n_in %d out %d ws %zu (need %zu)\n", n_in, out_size, ws_size, (size_t)WS_END); grid = -1; return; }
        int dev = 0, cus = 0, per_cu = 0;
        if (hipGetDevice(&dev) != hipSuccess || hipDeviceGetAttribute(&cus, hipDeviceAttributeMultiprocessorCount, dev) != hipSuccess) { grid = -1; return; }
        if (hipFuncSetAttribute((const void*)mk_fwd, hipFuncAttributeMaxDynamicSharedMemorySize, LDS_BYTES) != hipSuccess) { fprintf(stderr, "kernel_launch: hipFuncSetAttribute failed\n"); grid = -1; return; }
        if (hipOccupancyMaxActiveBlocksPerMultiprocessor(&per_cu, (const void*)mk_fwd, 512, LDS_BYTES) != hipSuccess || per_cu < 1) fprintf(stderr, "kernel_launch: occupancy query reports %d\n", per_cu);
        (void)hipGetLastError();
        grid = cus;
    }
    if (grid < 0) return;
    if (hipMemsetAsync((char*)d_ws + WS_CTL, 0, CTL_BYTES, stream) != hipSuccess) { fprintf(stderr, "kernel_launch: memset failed\n"); return; }
    MKArgs a; memset(&a, 0, sizeof a);
    for (int i = 0; i < 35; ++i) a.in[i] = (const float*)d_in[i];
    a.out = (float*)d_out; a.ws = (unsigned char*)d_ws;
    const int nl = MK_CUT ? N_PHASES : 1;
    for (int li = 0; li < nl; ++li) {
        a.ph_lo = MK_CUT ? li : 0; a.ph_hi = MK_CUT ? li + 1 : N_PHASES; a.li = li;
        hipLaunchKernelGGL(mk_fwd, dim3(grid), dim3(512), LDS_BYTES, stream, a);
        const hipError_t le = hipPeekAtLastError();
        if (le != hipSuccess) { fprintf(stderr, "kernel_launch: launch %d failed: %s\n", li, hipGetErrorName(le)); break; }
    }
}
```

```cpp
#include <hip/hip_runtime.h>
#include <stdint.h>
#include <stddef.h>
#include <stdio.h>
#include <math.h>

#define DEV __device__ __forceinline__
typedef unsigned short bf16_t;
typedef short bf16x8 __attribute__((ext_vector_type(8)));
typedef float f32x4 __attribute__((ext_vector_type(4)));
typedef float f32x16 __attribute__((ext_vector_type(16)));
typedef unsigned u32x4 __attribute__((ext_vector_type(4)));
typedef unsigned u32x2 __attribute__((ext_vector_type(2)));

constexpr int DM = 1024, NB = 8, SEQ = 2048, M = NB * SEQ, DEPTH = 4, SB = 32, PAST = 16384, PAGE = 128, NPAGES = 128, NPOOL = 5120;
constexpr int DIN = 1456, DINP = 1536;
constexpr int S5G = 16, S5P = 64;
constexpr int MH = 8, QL = 256, KVL = 128, ROPE = 32;
constexpr int GH = 4, GDK = 32, GDV = 64;
constexpr int DFF = 2816, DFF2 = 5632;
constexpr float EPS = 1e-6f;
constexpr float QSCALE = 0.10206207261596575f * 1.4426950408889634f;
constexpr int NSPLIT = 8, KPS = PAST / NSPLIT;

constexpr size_t O_YP = 0, O_YS = O_YP + (size_t)M * DM, O_CKVP = O_YS + (size_t)SB * DM, O_KRP = O_CKVP + (size_t)DEPTH * M * KVL,
    O_S5P = O_KRP + (size_t)DEPTH * M * ROPE, O_GLAP = O_S5P + (size_t)DEPTH * NB * S5G * S5P * 2, O_CONVP = O_GLAP + (size_t)DEPTH * NB * GH * GDK * GDV,
    O_CKVS = O_CONVP + (size_t)DEPTH * NB * 2 * DFF, O_KRS = O_CKVS + (size_t)DEPTH * SB * KVL, O_S5S = O_KRS + (size_t)DEPTH * SB * ROPE,
    O_GLAS = O_S5S + (size_t)DEPTH * SB * S5G * S5P * 2, O_CONVS = O_GLAS + (size_t)DEPTH * SB * GH * GDK * GDV, O_END = O_CONVS + (size_t)DEPTH * SB * 2 * DFF;

constexpr size_t al(size_t x) { return (x + 255) & ~(size_t)255; }
constexpr size_t WS_CTL = 0, CTL_BYTES = 1 << 20;
constexpr size_t WL_IN = 0, WL_QB = WL_IN + (size_t)DINP * DM * 2, WL_KV = WL_QB + (size_t)768 * 256 * 2, WL_GLU = WL_KV + (size_t)1024 * 256 * 2,
    WL_OUT = WL_GLU + (size_t)256 * 256 * 2, WL_FFI = WL_OUT + (size_t)DM * DM * 2, WL_FFO = WL_FFI + (size_t)DFF2 * DM * 2, WL_SIZE = WL_FFO + (size_t)DM * DFF * 2;
constexpr size_t WS_W = WS_CTL + CTL_BYTES;
constexpr size_t S5_ABAR = 0, S5_BBAR = 512, S5_AL = 8704, S5_TQ = 9216, S5_P = S5_TQ + (size_t)640 * 512 * 2, S5_SIZE = S5_P + (size_t)512 * 128 * 2;
constexpr size_t WS_S5 = al(WS_W + DEPTH * WL_SIZE);
constexpr size_t WS_COS = al(WS_S5 + (size_t)DEPTH * S5G * S5_SIZE), WS_SIN = WS_COS + (size_t)(SEQ + 1) * 16 * 4;
constexpr size_t WS_APOW = al(WS_SIN + (size_t)(SEQ + 1) * 16 * 4);
constexpr size_t WS_XB = al(WS_APOW + (size_t)DEPTH * 16 * 33 * 64 * 8);
constexpr size_t WS_RSX = al(WS_XB + (size_t)M * DM * 2);
constexpr size_t WS_U5 = al(WS_RSX + (size_t)M * 64);
constexpr size_t WS_CQB = al(WS_U5 + (size_t)M * 256 * 2);
constexpr size_t WS_RSCQ = al(WS_CQB + (size_t)M * 256 * 2);
constexpr size_t WS_T2B = al(WS_RSCQ + (size_t)M * 16);
constexpr size_t WS_RSKV = al(WS_T2B + (size_t)M * 256 * 2);
constexpr size_t WS_QKF = al(WS_RSKV + (size_t)M * 16);
constexpr size_t WS_GLG = al(WS_QKF + (size_t)M * 256 * 4);
constexpr size_t WS_GVB = al(WS_GLG + (size_t)M * 128 * 4);
constexpr size_t WS_GRB = al(WS_GVB + (size_t)M * 256 * 2);
constexpr size_t WS_QN = al(WS_GRB + (size_t)M * 256 * 2);
constexpr size_t WS_QP = al(WS_QN + (size_t)M * 512 * 2);
constexpr size_t WS_KN = al(WS_QP + (size_t)M * 256 * 2);
constexpr size_t WS_KP = al(WS_KN + (size_t)M * 512 * 2);
constexpr size_t WS_VB = al(WS_KP + (size_t)M * 32 * 2);
constexpr size_t WS_Y5 = al(WS_VB + (size_t)M * 512 * 2);
constexpr size_t WS_MIX = al(WS_Y5 + (size_t)M * 256 * 2);
constexpr size_t WS_H = al(WS_MIX + (size_t)M * DM * 2);
constexpr size_t WS_XSB = al(WS_H + (size_t)M * DFF * 2);
constexpr size_t WS_RSXS = al(WS_XSB + (size_t)SB * DM * 2);
constexpr size_t WS_PS = al(WS_RSXS + (size_t)SB * 16);
constexpr size_t WS_QLAT = al(WS_PS + (size_t)SB * DINP * 4);
constexpr size_t WS_KVNEW = al(WS_QLAT + (size_t)SB * MH * 160 * 4);
constexpr size_t WS_MIXS = al(WS_KVNEW + (size_t)SB * 160 * 4);
constexpr size_t WS_OP = al(WS_MIXS + (size_t)SB * DM * 2);
constexpr size_t WS_ML = al(WS_OP + (size_t)DEPTH * SB * NSPLIT * MH * 128 * 4);
constexpr size_t WS_HVS = al(WS_ML + (size_t)DEPTH * SB * NSPLIT * MH * 2 * 4);
constexpr size_t WS_HS = al(WS_HVS + (size_t)SB * DFF2 * 4);
constexpr size_t WS_T2F = al(WS_HS + (size_t)SB * DFF * 2);
constexpr size_t WS_HB = al(WS_T2F + (size_t)M * 256 * 4);
constexpr size_t WS_HV = al(WS_HB + (size_t)M * 1024 * 8);
constexpr size_t WS_FV = WS_HV, WS_FG = WS_HV + (2u << 20), WS_LG = WS_HV + (4u << 20);
constexpr size_t WS_END = al(WS_HV + (size_t)M * DFF2 * 4);

DEV bf16_t f2bf(float f) { unsigned u = __float_as_uint(f); u += 0x7fffu + ((u >> 16) & 1u); return (bf16_t)(u >> 16); }
DEV float bf2f(bf16_t h) { return __uint_as_float((unsigned)h << 16); }
DEV unsigned pk2(float lo, float hi) { return (unsigned)f2bf(lo) | ((unsigned)f2bf(hi) << 16); }
DEV int lane_id() { int l; asm volatile("v_mbcnt_lo_u32_b32 %0, -1, 0\n\tv_mbcnt_hi_u32_b32 %0, -1, %0" : "=v"(l)); return l; }
DEV float shfl_xor_(float v, int m) { return __builtin_bit_cast(float, __builtin_amdgcn_ds_bpermute((lane_id() ^ m) << 2, __builtin_bit_cast(int, v))); }
DEV float shfl_(float v, int src) { return __builtin_bit_cast(float, __builtin_amdgcn_ds_bpermute(src << 2, __builtin_bit_cast(int, v))); }
DEV float wave_sum(float v) {
#pragma unroll
    for (int o = 1; o < 64; o <<= 1) v += shfl_xor_(v, o);
    return v;
}
DEV float wave_max(float v) {
#pragma unroll
    for (int o = 1; o < 64; o <<= 1) v = fmaxf(v, shfl_xor_(v, o));
    return v;
}
DEV float fexp2(float x) { return __builtin_amdgcn_exp2f(x); }
DEV float fexp(float x) { return __builtin_amdgcn_exp2f(1.4426950408889634f * x); }
DEV float sigmoidf_(float x) { return __builtin_amdgcn_rcpf(1.f + fexp(-x)); }
DEV float gelu_tanh(float x) { const float u = 0.7978845608028654f * (x + 0.044715f * x * x * x); return x * sigmoidf_(2.f * u); }
DEV float log_sigmoid(float x) { return fminf(x, 0.f) - 0.6931471805599453f * __builtin_amdgcn_logf(1.f + fexp(-fabsf(x))); }
DEV void lds_barrier() { asm volatile("s_waitcnt lgkmcnt(0)" ::: "memory"); __builtin_amdgcn_s_barrier(); asm volatile("" ::: "memory"); }
DEV int crow(int r, int hi) { return (r & 3) + 8 * (r >> 2) + 4 * hi; }
DEV float rs4(const float* p, float inv_n) { const f32x4 v = *(const f32x4*)p; return rsqrtf(((v.x + v.y) + (v.z + v.w)) * inv_n + EPS); }

DEV int colmap_win(int n) {
    const int t = n >> 8, c = n & 255;
    switch (t) {
        case 0: return c;
        case 1: return 256 + c;
        case 2: return c < 128 ? 512 + c : (c < 160 ? 640 + (c - 128) : (c < 176 ? 1184 + (c - 160) : -1));
        case 3: return c < 128 ? 672 + c : 800 + (c - 128);
        case 4: return 928 + c;
        default: return 1200 + c;
    }
}
DEV int rope_logical(int j) { return ((j >> 2) & 1) * 16 + 4 * (j >> 3) + (j & 3); }
DEV int rope_phys(int lg) { const int nn = lg >> 4, i = lg & 15; return 8 * (i >> 2) + 4 * nn + (i & 3); }
DEV int colmap_qb(int n) {
    if (n < 512) return (n >> 6) * 96 + (n & 63);
    const int c = n - 512, h = c >> 5, j = c & 31; return h * 96 + 64 + rope_logical(j);
}
DEV int colmap_ffi(int n) { const int j = n >> 8, r = n & 255; return r < 128 ? 128 * j + r : DFF + 128 * j + (r - 128); }


namespace pg8 {
#define PG8_LAS __attribute__((address_space(3)))
typedef unsigned short bf16_t;
typedef short bf16x8 __attribute__((ext_vector_type(8)));
typedef float f32x4 __attribute__((ext_vector_type(4)));
typedef unsigned u32x4 __attribute__((ext_vector_type(4)));
constexpr int BM = 256, BK = 64, HALF = 128, HTB = HALF * BK * 2  , STAGE_BYTES = 8 * HTB, NXCD = 8, WGM = 8;

__host__ __device__ __forceinline__ int lds_byte(int r, int c) { const int st = (r >> 4) * 2 + (c >> 5), rr = r & 15, cc = c & 31, ob = rr * 64 + cc * 2; return st * 1024 + (ob ^ (((ob >> 9) & 1) << 5)); }
__host__ __device__ __forceinline__ void stage_rc(int b, int& R, int& C) { const int st = b / 1024, sb = b % 1024, swz = sb ^ (((sb >> 9) & 1) << 5); R = (st >> 1) * 16 + swz / 64; C = (st & 1) * 32 + (swz % 64) / 2; }
__host__ __device__ __forceinline__ int perm32(int rho) { const int n = rho >> 4, i = rho & 15; return 8 * (i >> 2) + 4 * n + (i & 3); }

struct Unit { int pm, pn; };
struct Gemm { const bf16_t* A; const bf16_t* Bt; int M, N, K; };

struct StaticOrder {
    int nM, nN, nwg, G, c;
    __host__ __device__ void init(int M, int N, int G_, int c_) { nM = M / BM; nN = N / BM; nwg = nM * nN; G = G_; c = c_; }
    __host__ __device__ bool next(int i, Unit& u) const {
        const long L = (long)i * G + c; if (L >= nwg) return false;
        int wgid = (int)L; { const int q = nwg / NXCD, r = nwg % NXCD, xcd = wgid % NXCD, off = wgid / NXCD; wgid = (xcd < r ? xcd * (q + 1) : r * (q + 1) + (xcd - r) * q) + off; }
        const int nig = WGM * nN, gid = wgid / nig, fm = gid * WGM, gsz = (nM - fm) < WGM ? (nM - fm) : WGM;
        u.pm = fm + ((wgid % nig) % gsz); u.pn = (wgid % nig) / gsz; return true;
    }
    __device__ __forceinline__ void a_ready(const Unit&) const {}
    __device__ __forceinline__ void done(const Unit&) const {}
};

__device__ __forceinline__ int static_pm(int M, int N, int G, int c, int i) {
    const int nM = M / BM, nN = N / BM, nwg = nM * nN; const long L = (long)i * G + c; if (L >= nwg) return -1;
    int wgid = (int)L; { const int q = nwg / NXCD, r = nwg % NXCD, xcd = wgid % NXCD, off = wgid / NXCD; wgid = (xcd < r ? xcd * (q + 1) : r * (q + 1) + (xcd - r) * q) + off; }
    const int nig = WGM * nN, gid = wgid / nig, fm = gid * WGM, gsz = (nM - fm) < WGM ? (nM - fm) : WGM;
    return fm + ((wgid % nig) % gsz);
}
__device__ __forceinline__ void st16_wt(void* p, u32x4 v) { asm volatile("global_store_dwordx4 %0, %1, off sc1\n\ts_nop 1" :: "v"(p), "v"(v) : "memory"); }
__device__ __forceinline__ void st16_wt(void* p, f32x4 v) { asm volatile("global_store_dwordx4 %0, %1, off sc1\n\ts_nop 1" :: "v"(p), "v"(v) : "memory"); }
__device__ __forceinline__ void st4_wt(float* p, float v) { asm volatile("global_store_dword %0, %1, off sc1\n\ts_nop 1" :: "v"(p), "v"(v) : "memory"); }
__device__ __forceinline__ void pub_wave(unsigned* cnt) { asm volatile("s_waitcnt vmcnt(0)" ::: "memory"); if (lane_id() == 0) __hip_atomic_fetch_add(cnt, 1u, __ATOMIC_RELAXED, __HIP_MEMORY_SCOPE_AGENT); }
__device__ __forceinline__ void poll_ge(const unsigned* cnt, unsigned need) {
    unsigned sp = 0;
    while ((unsigned)__builtin_amdgcn_readfirstlane((int)__hip_atomic_load((unsigned*)cnt, __ATOMIC_RELAXED, __HIP_MEMORY_SCOPE_AGENT)) < need) { __builtin_amdgcn_s_sleep(2); if (++sp > (1u << 22)) break; }
}
__device__ __forceinline__ void acq_agent() { __builtin_amdgcn_fence(__ATOMIC_ACQUIRE, "agent"); asm volatile("s_waitcnt vmcnt(0)" ::: "memory"); }
struct Order5 : StaticOrder { int redeal, x, r; unsigned* grp;
    __device__ __forceinline__ bool next(int i, Unit& u) const { if (!redeal) return StaticOrder::next(i, u);
        const int E = r + 32 * i; if (E >= 176) return false; const int g = E >= 88 ? 1 : 0, e = E - 88 * g; u.pm = 8 * x + 4 * g + (e & 3); u.pn = e >> 2; return true; }
    __device__ __forceinline__ void a_ready(const Unit&) const {}
    __device__ __forceinline__ void done(const Unit& u) const { if (!redeal) return;
        const int g = (u.pm >> 2) & 1, E = 88 * g + 4 * u.pn + (u.pm & 3);
        if (E + 32 < (g ? 176 : 88)) return;
        const int n0 = (87 - r) / 32 + 1, n = g ? (175 - r) / 32 + 1 - n0 : n0;
        asm volatile("s_waitcnt vmcnt(0)" ::: "memory"); if (lane_id() == 0) __hip_atomic_fetch_add(grp + (u.pm >> 2) * 64, (unsigned)n, __ATOMIC_RELAXED, __HIP_MEMORY_SCOPE_AGENT); }
};
struct Order6 : StaticOrder { int redeal, pm0, pn0; unsigned* cnt;
    __device__ __forceinline__ bool next(int i, Unit& u) const { if (!redeal) return StaticOrder::next(i, u); if (i != 0) return false; u.pm = pm0; u.pn = pn0; return true; }
    __device__ __forceinline__ void a_ready(const Unit&) const {}
    __device__ __forceinline__ void done(const Unit& u) const { if (redeal && cnt) pub_wave(cnt + u.pm * 64); }
};
struct Order1 : StaticOrder { int redeal, x, r, wv; const unsigned* rdy; unsigned need;
    __device__ __forceinline__ bool next(int i, Unit& u) const { if (!redeal) return StaticOrder::next(i, u);
        int g, j;
        if (r >= 24) { if (i == 0) { g = 0; j = r - 8; } else if (i == 1) { g = 1; j = r - 24; } else return false; }
        else if (r >= 16) { if (i > 1) return false; g = 0; j = r - 16 + 8 * i; }
        else { if (i > 0) return false; g = 1; j = 8 + r; }
        u.pm = 8 * x + 4 * g + (j & 3); u.pn = j >> 2; return true; }
    __device__ __forceinline__ void a_ready(const Unit& u) const {
        if (redeal) { if (wv == 0 && need) { poll_ge(rdy + u.pm * 64, need); acq_agent(); }
            asm volatile("" ::: "memory"); __builtin_amdgcn_s_barrier(); asm volatile("" ::: "memory"); } }
    __device__ __forceinline__ void done(const Unit&) const {}
};

__device__ __forceinline__ unsigned cvt_pk_bf16(float lo, float hi) { unsigned r; asm volatile("v_cvt_pk_bf16_f32 %0, %1, %2" : "=v"(r) : "v"(lo), "v"(hi)); return r; }
typedef float f32x2 __attribute__((ext_vector_type(2)));

template <class Epi, class Sched, bool ALIGN_EPI = false, bool SP2 = false>
__device__ __forceinline__ void gemm_phase(PG8_LAS unsigned char* lds, const Gemm g, const Sched& S, const Epi& E, const int wave_id  ) {
    int tid_l = wave_id * 64 + lane_id(); asm volatile("" : "+v"(tid_l));
    const int tid = tid_l, wid = __builtin_amdgcn_readfirstlane(tid >> 6), lane = tid & 63, wr = wid >> 2, wc = wid & 3, fr = lane & 15, fq = lane >> 4;
    const int K = g.K, nt = K / BK;
    unsigned voffA[2], voffB[2];
#pragma unroll
    for (int i = 0; i < 2; ++i) { int R, C; stage_rc(tid * 16 + i * 8192, R, C); const int Rb = Epi::PERM ? ((R & ~31) + perm32(R & 31)) : R;
        voffA[i] = (unsigned)(R * K + C) * 2u; voffB[i] = (unsigned)(Rb * K + C) * 2u; }
    const size_t kstep = (size_t)(BK * 2);
    const size_t hstep = (size_t)HALF * K * 2;
    const size_t tstep = 2 * hstep;
    const unsigned ldsw = (unsigned)wid * 1024u;
    const int aoff = lds_byte(wr * 64 + fr, fq * 8), boff = lds_byte(wc * 32 + fr, fq * 8);
#define PG8_SA(b, h) (((b) * 2 + (h)) * HTB)
#define PG8_SB(b, h) ((4 + (b) * 2 + (h)) * HTB)
#define PG8_STAGE(bufoff, gbase, voff) do { _Pragma("unroll") for (int _i = 0; _i < 2; ++_i) \
        __builtin_amdgcn_global_load_lds((const unsigned*)((const char*)(gbase) + (voff)[_i]), (PG8_LAS unsigned*)(lds + (bufoff) + ldsw + _i * 8192), 16, 0, 0); } while (0)
#define PG8_LDA(dst, b, h) do { _Pragma("unroll") for (int m = 0; m < 4; ++m) _Pragma("unroll") for (int k = 0; k < 2; ++k) dst[m][k] = *(const PG8_LAS bf16x8*)(lds + PG8_SA(b, h) + aoff + m * 2048 + k * 1024); } while (0)
#define PG8_LDB(dst, b, h) do { _Pragma("unroll") for (int n = 0; n < 2; ++n) _Pragma("unroll") for (int k = 0; k < 2; ++k) dst[n][k] = *(const PG8_LAS bf16x8*)(lds + PG8_SB(b, h) + boff + n * 2048 + k * 1024); } while (0)
#define PG8_MMA(ai, bj, At, Bt) do { __builtin_amdgcn_s_setprio(1); _Pragma("unroll") for (int m = 0; m < 4; ++m) _Pragma("unroll") for (int n = 0; n < 2; ++n) _Pragma("unroll") for (int k = 0; k < 2; ++k) \
        acc[ai][bj][m][n] = __builtin_amdgcn_mfma_f32_16x16x32_bf16(Bt[n][k], At[m][k], acc[ai][bj][m][n], 0, 0, 0); __builtin_amdgcn_s_setprio(0); } while (0)
#define PG8_WAIT_V(n) asm volatile("s_waitcnt vmcnt(" #n ")" ::: "memory")
#define PG8_WAIT_L(n) asm volatile("s_waitcnt lgkmcnt(" #n ")" ::: "memory")
#define PG8_BAR __builtin_amdgcn_s_barrier()
#define PG8_SCHED __builtin_amdgcn_sched_barrier(0)
    Unit cur, nxt; int ui = 0;
    if (!S.next(0, cur)) return;
    f32x4 acc[2][2][4][2];
#pragma unroll
    for (int a = 0; a < 2; ++a)
#pragma unroll
        for (int b = 0; b < 2; ++b)
#pragma unroll
            for (int m = 0; m < 4; ++m)
#pragma unroll
                for (int n = 0; n < 2; ++n) acc[a][b][m][n] = (f32x4){0.f, 0.f, 0.f, 0.f};
    bf16x8 At[4][2], B0[2][2], B1[2][2];
    const char* cA = (const char*)g.A + (size_t)cur.pm * tstep; const char* cB = (const char*)g.Bt + (size_t)cur.pn * tstep;
    S.a_ready(cur);
    if constexpr (SP2) {
        PG8_STAGE(PG8_SB(0, 0), cB, voffB); PG8_STAGE(PG8_SB(0, 1), cB + hstep, voffB); PG8_STAGE(PG8_SA(0, 0), cA, voffA); PG8_STAGE(PG8_SA(0, 1), cA + hstep, voffA);
        if (wr == 1) PG8_BAR;
        PG8_WAIT_V(2); PG8_BAR;
        PG8_STAGE(PG8_SB(1, 0), cB + kstep, voffB); PG8_STAGE(PG8_SA(1, 0), cA + kstep, voffA); PG8_STAGE(PG8_SB(1, 1), cB + hstep + kstep, voffB);
        PG8_WAIT_V(6); PG8_BAR;
    } else {
        PG8_STAGE(PG8_SB(0, 0), cB, voffB); PG8_STAGE(PG8_SA(0, 0), cA, voffA); PG8_STAGE(PG8_SB(0, 1), cB + hstep, voffB); PG8_STAGE(PG8_SA(0, 1), cA + hstep, voffA);
        if (wr == 1) PG8_BAR;
        PG8_WAIT_V(4); PG8_BAR;
        PG8_STAGE(PG8_SB(1, 0), cB + kstep, voffB); PG8_STAGE(PG8_SA(1, 0), cA + kstep, voffA); PG8_STAGE(PG8_SB(1, 1), cB + hstep + kstep, voffB);
        PG8_WAIT_V(6); PG8_BAR;
    }
    for (;;) {
        const bool has_next = S.next(ui + 1, nxt);
        const char* nA = has_next ? (const char*)g.A + (size_t)nxt.pm * tstep : cA; const char* nB = has_next ? (const char*)g.Bt + (size_t)nxt.pn * tstep : cB;
        for (int t = 0; t < nt; t += 2) {
            const bool last = (t == nt - 2);
            const char* a1 = cA + (size_t)(t + 1) * kstep;
            const char* a2 = last ? nA : cA + (size_t)(t + 2) * kstep; const char* b2 = last ? nB : cB + (size_t)(t + 2) * kstep;
            const char* a3 = a2 + kstep; const char* b3 = b2 + kstep;
            if (last && has_next) S.a_ready(nxt);
            if constexpr (SP2) {
            PG8_LDB(B0, 0, 0); PG8_LDB(B1, 0, 1); PG8_SCHED; PG8_LDA(At, 0, 0); PG8_STAGE(PG8_SA(1, 1), a1 + hstep, voffA);
            PG8_WAIT_V(8); PG8_WAIT_L(0); PG8_BAR; PG8_MMA(0, 0, At, B0); PG8_MMA(0, 1, At, B1); PG8_BAR; PG8_SCHED;
            PG8_LDA(At, 0, 1); PG8_STAGE(PG8_SB(0, 0), b2, voffB); PG8_STAGE(PG8_SB(0, 1), b2 + hstep, voffB); PG8_STAGE(PG8_SA(0, 0), a2, voffA);
            PG8_WAIT_V(8); PG8_WAIT_L(0); PG8_BAR; PG8_MMA(1, 0, At, B0); PG8_MMA(1, 1, At, B1); PG8_BAR; PG8_SCHED;
            PG8_LDB(B0, 1, 0); PG8_LDB(B1, 1, 1); PG8_SCHED; PG8_LDA(At, 1, 0); PG8_STAGE(PG8_SA(0, 1), a2 + hstep, voffA);
            PG8_WAIT_V(8); PG8_WAIT_L(0); PG8_BAR; PG8_MMA(0, 0, At, B0); PG8_MMA(0, 1, At, B1); PG8_BAR; PG8_SCHED;
            PG8_LDA(At, 1, 1); PG8_STAGE(PG8_SB(1, 0), b3, voffB); PG8_STAGE(PG8_SB(1, 1), b3 + hstep, voffB); PG8_STAGE(PG8_SA(1, 0), a3, voffA);
            PG8_WAIT_V(8); PG8_WAIT_L(0); PG8_BAR; PG8_MMA(1, 0, At, B0); PG8_MMA(1, 1, At, B1); PG8_BAR; PG8_SCHED;
            } else {
            PG8_LDB(B0, 0, 0); PG8_SCHED; PG8_LDA(At, 0, 0); PG8_STAGE(PG8_SA(1, 1), a1 + hstep, voffA);
            PG8_WAIT_L(8); PG8_BAR; PG8_WAIT_L(0); PG8_MMA(0, 0, At, B0); PG8_BAR; PG8_SCHED;
            PG8_LDB(B1, 0, 1); PG8_STAGE(PG8_SB(0, 0), b2, voffB);
            PG8_BAR; PG8_WAIT_L(0); PG8_MMA(0, 1, At, B1); PG8_BAR;
            PG8_LDA(At, 0, 1); PG8_STAGE(PG8_SA(0, 0), a2, voffA);
            PG8_BAR; PG8_WAIT_L(0); PG8_MMA(1, 0, At, B0); PG8_BAR; PG8_SCHED;
            PG8_STAGE(PG8_SB(0, 1), b2 + hstep, voffB);
            PG8_WAIT_V(6); PG8_BAR; PG8_MMA(1, 1, At, B1); PG8_BAR;
            PG8_LDB(B0, 1, 0); PG8_SCHED; PG8_LDA(At, 1, 0); PG8_STAGE(PG8_SA(0, 1), a2 + hstep, voffA);
            PG8_WAIT_L(8); PG8_BAR; PG8_WAIT_L(0); PG8_MMA(0, 0, At, B0); PG8_BAR; PG8_SCHED;
            PG8_LDB(B1, 1, 1); PG8_STAGE(PG8_SB(1, 0), b3, voffB);
            PG8_BAR; PG8_WAIT_L(0); PG8_MMA(0, 1, At, B1); PG8_BAR;
            PG8_LDA(At, 1, 1); PG8_STAGE(PG8_SA(1, 0), a3, voffA);
            PG8_BAR; PG8_WAIT_L(0); PG8_MMA(1, 0, At, B0); PG8_BAR; PG8_SCHED;
            PG8_STAGE(PG8_SB(1, 1), b3 + hstep, voffB);
            PG8_WAIT_V(6); PG8_BAR; PG8_MMA(1, 1, At, B1); PG8_BAR;
            }
        }
        if constexpr (ALIGN_EPI) { if (wr == 0) PG8_BAR; }
        if constexpr (!Epi::AFTER_DRAIN) { E(acc, cur, wr, wc, fr, fq); S.done(cur); }
        if (!has_next) break;
#pragma unroll
        for (int a = 0; a < 2; ++a)
#pragma unroll
            for (int b = 0; b < 2; ++b)
#pragma unroll
                for (int m = 0; m < 4; ++m)
#pragma unroll
                    for (int n = 0; n < 2; ++n) acc[a][b][m][n] = (f32x4){0.f, 0.f, 0.f, 0.f};
        cur = nxt; cA = nA; cB = nB; ++ui;
        if constexpr (ALIGN_EPI) { if (wr == 1) PG8_BAR; }
    }
    PG8_WAIT_V(0);
    if constexpr (!ALIGN_EPI) { if (wr == 0) PG8_BAR; }
    PG8_BAR;
    if constexpr (Epi::AFTER_DRAIN) { E.fused(acc, cur, wr, wc, fr, fq, lds, wid, lane); S.done(cur); }
#undef PG8_SA
#undef PG8_SB
#undef PG8_STAGE
#undef PG8_LDA
#undef PG8_LDB
#undef PG8_MMA
#undef PG8_WAIT_V
#undef PG8_WAIT_L
#undef PG8_BAR
#undef PG8_SCHED
}
}

namespace pg8 { struct OneUnit { int pm, pn;
    __device__ __forceinline__ bool next(int i, Unit& u) const { if (i != 0) return false; u.pm = pm; u.pn = pn; return true; }
    __device__ __forceinline__ void a_ready(const Unit&) const {}
    __device__ __forceinline__ void done(const Unit&) const {} }; }
namespace pg8 { struct OneUnitPub { int pm, pn; unsigned* cnt;
    __device__ __forceinline__ bool next(int i, Unit& u) const { if (i != 0) return false; u.pm = pm; u.pn = pn; return true; }
    __device__ __forceinline__ void a_ready(const Unit&) const {}
    __device__ __forceinline__ void done(const Unit&) const { pub_wave(cnt); } }; }
namespace pg8 {
__device__ __forceinline__ u32x4 pack8(const f32x4& a, const f32x4& b) { u32x4 w; w.x = cvt_pk_bf16(a[0], a[1]); w.y = cvt_pk_bf16(a[2], a[3]); w.z = cvt_pk_bf16(b[0], b[1]); w.w = cvt_pk_bf16(b[2], b[3]); return w; }
__device__ __forceinline__ float hsum4(const f32x4& v) { return (v[0] + v[1]) + (v[2] + v[3]); }
__device__ __forceinline__ float hsq4(const f32x4& v) { return (v[0] * v[0] + v[1] * v[1]) + (v[2] * v[2] + v[3] * v[3]); }
__device__ __forceinline__ float rstd16(const float* rs, int row, float inv_n) { const f32x4* p = (const f32x4*)(rs + 16 * (size_t)row); const f32x4 a = p[0], b = p[1], c = p[2], d = p[3];
    return rsqrtf(((hsum4(a) + hsum4(b)) + (hsum4(c) + hsum4(d))) * inv_n + EPS); }
__device__ __forceinline__ float rstd4(const float* rs, int row, float inv_n) { const f32x4 a = *(const f32x4*)(rs + 4 * (size_t)row); return rsqrtf(hsum4(a) * inv_n + EPS); }
__device__ __forceinline__ float red_fq(float s) { s += shfl_xor_(s, 16); s += shfl_xor_(s, 32); return s; }
__device__ __forceinline__ float fsigmoid(float x) { return __builtin_amdgcn_rcpf(1.f + __builtin_amdgcn_exp2f(-1.4426950408889634f * x)); }
__device__ __forceinline__ f32x4 unpk_lo(unsigned a, unsigned b) { return (f32x4){__uint_as_float(a << 16), __uint_as_float(a & 0xffff0000u), __uint_as_float(b << 16), __uint_as_float(b & 0xffff0000u)}; }
#define EPI_LAUNDER { const int ln_ = lane_id(); fr = ln_ & 15; fq = ln_ >> 4; }
#define EPI_ROWS_BEGIN _Pragma("unroll") for (int ai = 0; ai < 2; ++ai) _Pragma("unroll") for (int m = 0; m < 4; ++m) { const int row = u.pm * BM + ai * HALF + wr * 64 + m * 16 + fr;
#define EPI_ROWS_END asm volatile("" ::: "memory"); }

struct EpiWin { static constexpr bool PERM = true, AFTER_DRAIN = false;
    const float* rsx; bf16_t* u5; bf16_t* cqb; float* rscq; float* t2f; bf16_t* t2b; float* rskv; float* qkf; bf16_t* gvb; bf16_t* grb; PG8_LAS float* rst;
    __device__ __forceinline__ void operator()(const f32x4 (&acc)[2][2][4][2], const Unit& u, int wr, int wc, int fr, int fq) const {
        EPI_LAUNDER const int cb = wc * 32 + 8 * fq, tid = (wr * 4 + wc) * 64 + fq * 16 + fr;
        if (tid < 256) rst[tid] = rstd16(rsx, u.pm * BM + tid, 1.f / 1024.f);
        asm volatile("s_waitcnt lgkmcnt(0)" ::: "memory"); __builtin_amdgcn_s_barrier(); asm volatile("" ::: "memory");
        EPI_ROWS_BEGIN
            const float r = rst[ai * HALF + wr * 64 + m * 16 + fr];
            f32x4 v[2][2];
#pragma unroll
            for (int bj = 0; bj < 2; ++bj) { v[bj][0] = acc[ai][bj][m][0] * r; v[bj][1] = acc[ai][bj][m][1] * r; }
            if (u.pn == 0) {
#pragma unroll
                for (int bj = 0; bj < 2; ++bj) { const int c = bj * HALF + cb; *(u32x4*)(u5 + ((size_t)(c >> 4) * ::M + row) * 16 + (c & 15)) = pack8(v[bj][0], v[bj][1]); }
            } else if (u.pn == 1) { float s = 0.f;
#pragma unroll
                for (int bj = 0; bj < 2; ++bj) { *(u32x4*)(cqb + (size_t)row * 256 + bj * HALF + cb) = pack8(v[bj][0], v[bj][1]); s += hsq4(v[bj][0]) + hsq4(v[bj][1]); }
                s = red_fq(s); if (fq == 0) rscq[(size_t)row * 4 + wc] = s;
            } else if (u.pn == 2) {
#pragma unroll
                for (int bj = 0; bj < 2; ++bj) { float* p = t2f + (size_t)row * 256 + bj * HALF + cb; *(f32x4*)p = v[bj][0]; *(f32x4*)(p + 4) = v[bj][1];
                    *(u32x4*)(t2b + (size_t)row * 256 + bj * HALF + cb) = pack8(v[bj][0], v[bj][1]); }
                const float s = red_fq(hsq4(v[0][0]) + hsq4(v[0][1])); if (fq == 0) rskv[(size_t)row * 4 + wc] = s;
            } else if (u.pn == 3) {
#pragma unroll
                for (int bj = 0; bj < 2; ++bj) { float* p = qkf + (size_t)row * 256 + bj * HALF + cb; *(f32x4*)p = v[bj][0]; *(f32x4*)(p + 4) = v[bj][1]; }
            } else { bf16_t* dst = u.pn == 4 ? gvb : grb;
#pragma unroll
                for (int bj = 0; bj < 2; ++bj) *(u32x4*)(dst + (size_t)row * 256 + bj * HALF + cb) = pack8(v[bj][0], v[bj][1]);
            }
        EPI_ROWS_END
    }
};
struct EpiQ { static constexpr bool PERM = true, AFTER_DRAIN = false;
    const float* rscq; const float* cosT; const float* sinT; bf16_t* qn; bf16_t* qp;
    __device__ __forceinline__ void operator()(const f32x4 (&acc)[2][2][4][2], const Unit& u, int wr, int wc, int fr, int fq) const {
        EPI_LAUNDER const int cb = wc * 32 + 8 * fq;
        EPI_ROWS_BEGIN
            const float r = rstd4(rscq, row, 1.f / 256.f) * QSCALE;
            if (u.pn < 2) {
#pragma unroll
                for (int bj = 0; bj < 2; ++bj) *(u32x4*)(qn + (size_t)row * 512 + u.pn * 256 + bj * HALF + cb) = pack8(acc[ai][bj][m][0] * r, acc[ai][bj][m][1] * r);
            } else { const int pos = row & (SEQ - 1); const f32x4 cs = *(const f32x4*)(cosT + pos * 16 + 4 * fq), sn = *(const f32x4*)(sinT + pos * 16 + 4 * fq);
#pragma unroll
                for (int bj = 0; bj < 2; ++bj) { const f32x4 x1 = acc[ai][bj][m][0] * r, x2 = acc[ai][bj][m][1] * r;
                    *(u32x4*)(qp + (size_t)row * 256 + bj * HALF + cb) = pack8(x1 * cs - x2 * sn, x1 * sn + x2 * cs); }
            }
        EPI_ROWS_END
    }
};
struct EpiKV { static constexpr bool PERM = true, AFTER_DRAIN = false;
    const float* rskv; bf16_t* kn; bf16_t* vb;
    __device__ __forceinline__ void operator()(const f32x4 (&acc)[2][2][4][2], const Unit& u, int wr, int wc, int fr, int fq) const {
        EPI_LAUNDER const int cb = wc * 32 + 8 * fq; bf16_t* dst = (u.pn < 2 ? kn : vb) + (u.pn & 1) * 256;
        EPI_ROWS_BEGIN
            const float r = rstd4(rskv, row, 1.f / 128.f);
#pragma unroll
            for (int bj = 0; bj < 2; ++bj) *(u32x4*)(dst + (size_t)row * 512 + bj * HALF + cb) = pack8(acc[ai][bj][m][0] * r, acc[ai][bj][m][1] * r);
        EPI_ROWS_END
    }
};
struct EpiGlu { static constexpr bool PERM = true, AFTER_DRAIN = false;
    const bf16_t* y5; const float* bias; bf16_t* mix;
    __device__ __forceinline__ void operator()(const f32x4 (&acc)[2][2][4][2], const Unit& u, int wr, int wc, int fr, int fq) const {
        EPI_LAUNDER const int cb = wc * 32 + 8 * fq;
        EPI_ROWS_BEGIN
#pragma unroll
            for (int bj = 0; bj < 2; ++bj) { const int c = bj * HALF + cb; const u32x4 yw = *(const u32x4*)(y5 + (size_t)row * 256 + c);
                const f32x4 y0 = unpk_lo(yw.x, yw.y), y1 = unpk_lo(yw.z, yw.w), b0 = *(const f32x4*)(bias + c), b1 = *(const f32x4*)(bias + c + 4);
                f32x4 o0, o1;
#pragma unroll
                for (int e = 0; e < 4; ++e) { o0[e] = y0[e] * fsigmoid(acc[ai][bj][m][0][e] + b0[e]); o1[e] = y1[e] * fsigmoid(acc[ai][bj][m][1][e] + b1[e]); }
                st16_wt(mix + (size_t)row * DM + c, pack8(o0, o1)); }
        EPI_ROWS_END
    }
};
template <bool WT> struct EpiResidT { static constexpr bool PERM = true, AFTER_DRAIN = false;
    const float* xin_f32; bf16_t* xb; float* rsx;
    __device__ __forceinline__ void operator()(const f32x4 (&acc)[2][2][4][2], const Unit& u, int wr, int wc, int fr, int fq) const {
        EPI_LAUNDER const int cb = wc * 32 + 8 * fq;
        EPI_ROWS_BEGIN
            float s = 0.f;
#pragma unroll
            for (int bj = 0; bj < 2; ++bj) { const size_t o = (size_t)row * DM + u.pn * 256 + bj * HALF + cb;
                f32x4 a0, a1;
                if (xin_f32) { a0 = *(const f32x4*)(xin_f32 + o); a1 = *(const f32x4*)(xin_f32 + o + 4); }
                else { const u32x4 w = *(const u32x4*)(xb + o); a0 = unpk_lo(w.x, w.y); a1 = unpk_lo(w.z, w.w); }
                a0 = a0 + acc[ai][bj][m][0]; a1 = a1 + acc[ai][bj][m][1];
                if (WT) st16_wt(xb + o, pack8(a0, a1)); else *(u32x4*)(xb + o) = pack8(a0, a1); s += hsq4(a0) + hsq4(a1); }
            s = red_fq(s); if (fq == 0) { if (WT) st4_wt(rsx + (size_t)row * 16 + u.pn * 4 + wc, s); else rsx[(size_t)row * 16 + u.pn * 4 + wc] = s; }
        EPI_ROWS_END
    }
};
using EpiResid = EpiResidT<false>;
template <int CTRL> __device__ __forceinline__ float dpp_mov(float x) { return __builtin_bit_cast(float, __builtin_amdgcn_update_dpp(0, __builtin_bit_cast(int, x), CTRL, 0xf, 0xf, false)); }
__device__ __forceinline__ float fgelu(float x) { const float t = x * x; const float u = x * (1.5957691216057308f + 0.07135481627159432f * t);
    return x * __builtin_amdgcn_rcpf(1.f + __builtin_amdgcn_exp2f(-1.4426950408889634f * u)); }
struct EpiFfi { static constexpr bool PERM = true, AFTER_DRAIN = false;
    const float* rsx; const float* cw; const float* cbias; bf16_t* h; float* fv; float* fg; float* lg; float* convout; PG8_LAS float* xch;
    __device__ __forceinline__ void operator()(const f32x4 (&acc)[2][2][4][2], const Unit& u, int wr, int wc, int fr, int fq) const {
        EPI_LAUNDER const int cb = wc * 32 + 8 * fq, c0 = u.pn * HALF + cb, tid = (wr * 4 + wc) * 64 + fq * 16 + fr;
        PG8_LAS float* RST = xch + 1024;
        if (tid < 256) RST[tid] = rstd16(rsx, u.pm * BM + tid, 1.f / 1024.f);
#pragma unroll
        for (int ai = 0; ai < 2; ++ai) if (fr >= 14) { PG8_LAS float* p = xch + ((2 * ai + wr) * 2 + (fr - 14)) * 128 + cb; *(PG8_LAS f32x4*)p = acc[ai][1][3][0]; *(PG8_LAS f32x4*)(p + 4) = acc[ai][1][3][1]; }
        f32x4 w0[2], w1[2], w2[2], bb[2];
#pragma unroll
        for (int n = 0; n < 2; ++n) { w0[n] = *(const f32x4*)(cw + c0 + 4 * n); w1[n] = *(const f32x4*)(cw + DFF + c0 + 4 * n); w2[n] = *(const f32x4*)(cw + 2 * DFF + c0 + 4 * n); bb[n] = *(const f32x4*)(cbias + c0 + 4 * n); }
        asm volatile("s_waitcnt lgkmcnt(0)" ::: "memory"); __builtin_amdgcn_s_barrier(); asm volatile("" ::: "memory");
#pragma unroll
        for (int ai = 0; ai < 2; ++ai) { const int bnd = 2 * ai + wr;
            f32x4 hp0[2], hp1[2], gp[2];
            { const int pb_ = bnd > 0 ? bnd - 1 : 0; const float r0 = bnd > 0 ? RST[64 * bnd - 2] : 0.f, r1 = bnd > 0 ? RST[64 * bnd - 1] : 0.f;
#pragma unroll
              for (int n = 0; n < 2; ++n) { hp0[n] = *(const PG8_LAS f32x4*)(xch + (pb_ * 2 + 0) * 128 + cb + 4 * n) * r0; hp1[n] = *(const PG8_LAS f32x4*)(xch + (pb_ * 2 + 1) * 128 + cb + 4 * n) * r1; gp[n] = hp0[n]; } }
#pragma unroll
            for (int m = 0; m < 4; ++m) { const int rit = ai * HALF + wr * 64 + m * 16 + fr, row = u.pm * BM + rit; const float r = RST[rit];
                f32x4 g[2], vv[2], hv[2];
#pragma unroll
                for (int n = 0; n < 2; ++n) { g[n] = acc[ai][1][m][n] * r; vv[n] = acc[ai][0][m][n] * r;
#pragma unroll
                    for (int e = 0; e < 4; ++e) { const float a1 = dpp_mov<0x121>(g[n][e]), a2 = dpp_mov<0x122>(g[n][e]);
                        const float b1 = m == 0 ? hp1[n][e] : dpp_mov<0x121>(gp[n][e]), b2 = m == 0 ? (fr == 1 ? hp1[n][e] : hp0[n][e]) : dpp_mov<0x122>(gp[n][e]);
                        const float p1 = fr >= 1 ? a1 : b1, p2 = fr >= 2 ? a2 : b2;
                        const float cv = bb[n][e] + w0[n][e] * p2 + w1[n][e] * p1 + w2[n][e] * g[n][e];
                        hv[n][e] = fgelu(cv) * vv[n][e]; } }
                if (m == 0 && bnd == 0 && fr < 2) { float* p = fv + ((size_t)u.pm * 2 + fr) * DFF + c0; st16_wt(p, vv[0]); st16_wt(p + 4, vv[1]); float* q = fg + ((size_t)u.pm * 2 + fr) * DFF + c0; st16_wt(q, g[0]); st16_wt(q + 4, g[1]); }
                else st16_wt(h + (size_t)row * DFF + c0, pack8(hv[0], hv[1]));
                if (m == 3 && bnd == 3 && fr >= 14) { float* p = lg + ((size_t)u.pm * 2 + (fr - 14)) * DFF + c0; st16_wt(p, g[0]); st16_wt(p + 4, g[1]);
                    if ((u.pm & 7) == 7) { float* q = convout + ((size_t)(u.pm >> 3) * 2 + (fr - 14)) * DFF + c0; *(f32x4*)q = g[0]; *(f32x4*)(q + 4) = g[1]; } }
                gp[0] = g[0]; gp[1] = g[1];
                asm volatile("" ::: "memory"); }
        }
    }
};
}

#include <hip/hip_bf16.h>
#include <cmath>
namespace attn_body {
using bf16=__hip_bfloat16;
using bf16x8=__attribute__((ext_vector_type(8)))short;
using s16x4=__attribute__((ext_vector_type(4)))short;
using f32x16=__attribute__((ext_vector_type(16)))float;
using u32x4=__attribute__((ext_vector_type(4)))unsigned;
constexpr int BATCH=8,NHEAD=8,SEQ=2048,D=64,DR=32;
constexpr int QNP=512,QPP=256,KNP=512,KPP=32,VP=512,OP=1024,OCOL=256;
constexpr int NW=8,QBLK=32,QB=QBLK*NW,KVBLK=64,NQB=SEQ/QB;
constexpr int ATTN_UNIT_ROWS=QB;
__device__ __forceinline__ int crow(int r,int hi){return (r&3)+8*(r>>2)+4*hi;}
#define SBAR() __builtin_amdgcn_sched_barrier(0)
__device__ __forceinline__ void cmask(f32x16&p0,f32x16&p1,int jb,int qrel,int hi){
  const float NEG=-INFINITY; int kb=64*jb+4*hi;
  #pragma unroll
  for(int r=0;r<16;++r){int kv=kb+(r&3)+8*(r>>2); if(kv>qrel)p0[r]=NEG; if(kv+32>qrel)p1[r]=NEG;}
}

constexpr int NSLOT=3, SLOTB=8192, KSLOTB=12288;
constexpr int LDS_K=0, LDS_V=NSLOT*KSLOTB, LDS_WS=LDS_V+NSLOT*SLOTB, LDS_OST=LDS_WS+NW*64*4, LDS_BYTES=LDS_OST+NW*4096;
constexpr float C2=0.10206207261596575f*1.4426950408889634f;
__device__ __forceinline__ void glds16(const void*gsrc,unsigned lds_dst){unsigned keep;
  asm volatile("s_mov_b32 %0, m0\n\ts_mov_b32 m0, %2\n\ts_nop 0\n\tglobal_load_lds_dwordx4 %1, off\n\ts_mov_b32 m0, %0":"=&s"(keep):"v"(gsrc),"s"(lds_dst):"memory");}
__device__ __forceinline__ float max3f(float a,float b,float c){float r;asm("v_max3_f32 %0, %1, %2, %3":"=v"(r):"v"(a),"v"(b),"v"(c));return r;}
__device__ __forceinline__ float max2f(float a,float b){float r;asm("v_max_f32_e32 %0, %1, %2":"=v"(r):"v"(a),"v"(b));return r;}
__device__ __forceinline__ float fadd_s(float a,float b){float r;asm("v_add_f32_e32 %0, %1, %2":"=v"(r):"v"(a),"v"(b));return r;}
__device__ __forceinline__ float fsub_s(float a,float b){float r;asm("v_sub_f32_e32 %0, %1, %2":"=v"(r):"v"(a),"v"(b));return r;}
typedef float f32x2_t __attribute__((ext_vector_type(2))); typedef __bf16 bf16x2_t __attribute__((ext_vector_type(2)));
__device__ __forceinline__ unsigned cvtpk_s(float lo,float hi){f32x2_t v={lo,hi};bf16x2_t b=__builtin_convertvector(v,bf16x2_t);return __builtin_bit_cast(unsigned,b);}
#define WAIT_BAR(N) asm volatile("s_waitcnt vmcnt(" #N ") lgkmcnt(0)\n\ts_barrier":::"memory")

__device__ __forceinline__ void qkt(f32x16&p0,f32x16&p1,const char*Kslot,const bf16x8*qr,const f32x16&negm,int r32,int hi){
  const char*kb=Kslot+hi*1024+r32*16;
  #pragma unroll
  for(int d0=0;d0<6;++d0){
    const bf16x8 b0=*reinterpret_cast<const bf16x8*>(kb+d0*2048);
    const bf16x8 b1=*reinterpret_cast<const bf16x8*>(kb+d0*2048+512);
    if(d0==0){p0=__builtin_amdgcn_mfma_f32_32x32x16_bf16(b0,qr[0],negm,0,0,0);p1=__builtin_amdgcn_mfma_f32_32x32x16_bf16(b1,qr[0],negm,0,0,0);}
    else{p0=__builtin_amdgcn_mfma_f32_32x32x16_bf16(b0,qr[d0],p0,0,0,0);p1=__builtin_amdgcn_mfma_f32_32x32x16_bf16(b1,qr[d0],p1,0,0,0);}}
}
typedef __attribute__((address_space(3))) const char* lds_cptr;
typedef short v4i16_t __attribute__((ext_vector_type(4)));
__device__ __forceinline__ void kload8(bf16x8*kf,lds_cptr kp){
  kf[0]=*(const __attribute__((address_space(3))) bf16x8*)(kp);      kf[1]=*(const __attribute__((address_space(3))) bf16x8*)(kp+512);
  kf[2]=*(const __attribute__((address_space(3))) bf16x8*)(kp+2048); kf[3]=*(const __attribute__((address_space(3))) bf16x8*)(kp+2560);
  kf[4]=*(const __attribute__((address_space(3))) bf16x8*)(kp+4096); kf[5]=*(const __attribute__((address_space(3))) bf16x8*)(kp+4608);
  kf[6]=*(const __attribute__((address_space(3))) bf16x8*)(kp+6144); kf[7]=*(const __attribute__((address_space(3))) bf16x8*)(kp+6656);
  kf[8]=*(const __attribute__((address_space(3))) bf16x8*)(kp+8192); kf[9]=*(const __attribute__((address_space(3))) bf16x8*)(kp+8704);
  kf[10]=*(const __attribute__((address_space(3))) bf16x8*)(kp+10240); kf[11]=*(const __attribute__((address_space(3))) bf16x8*)(kp+10752);
}
__device__ __forceinline__ void kload2(bf16x8*kf,lds_cptr kp,int j){ kf[2*j]=*(const __attribute__((address_space(3))) bf16x8*)(kp+j*2048); kf[2*j+1]=*(const __attribute__((address_space(3))) bf16x8*)(kp+j*2048+512); }
__device__ __forceinline__ s16x4 vtr(lds_cptr p){ return __builtin_bit_cast(s16x4,__builtin_amdgcn_ds_read_tr16_b64_v4i16((__attribute__((address_space(3))) v4i16_t*)p)); }
__device__ __forceinline__ float rowmax(const f32x16&p0,const f32x16&p1){
  float a=max3f(p0[0],p0[1],p1[0]),b=max3f(p0[2],p0[3],p1[1]);a=max3f(a,p1[2],p1[3]);
  #pragma unroll
  for(int r=4;r<16;r+=4){a=max3f(a,p0[r],p0[r+1]);b=max3f(b,p0[r+2],p0[r+3]);a=max3f(a,p1[r],p1[r+1]);b=max3f(b,p1[r+2],p1[r+3]);}
  const float m=max2f(a,b);
  auto rr=__builtin_amdgcn_permlane32_swap(__float_as_uint(m),__float_as_uint(m),false,false);
  return max2f(__uint_as_float(rr[0]),__uint_as_float(rr[1]));
}
__device__ __forceinline__ void pv(f32x16*o,int vb,bf16x8 pa0,bf16x8 pa1,bf16x8 pa2,bf16x8 pa3){
  #pragma unroll
  for(int d0=0;d0<2;++d0){s16x4 lo[4],hi[4];
    #pragma unroll
    for(int ks=0;ks<4;++ks){
      asm volatile("ds_read_b64_tr_b16 %0,%1 offset:%c2":"=&v"(lo[ks]):"v"(vb),"i"(d0*4096+ks*1024):"memory");
      asm volatile("ds_read_b64_tr_b16 %0,%1 offset:%c2":"=&v"(hi[ks]):"v"(vb),"i"(d0*4096+ks*1024+512):"memory");}
    asm volatile("s_waitcnt lgkmcnt(0)":::"memory");SBAR();
    #define PK(k) (bf16x8){lo[k][0],lo[k][1],lo[k][2],lo[k][3],hi[k][0],hi[k][1],hi[k][2],hi[k][3]}
    o[d0]=__builtin_amdgcn_mfma_f32_32x32x16_bf16(pa0,PK(0),o[d0],0,0,0);
    o[d0]=__builtin_amdgcn_mfma_f32_32x32x16_bf16(pa1,PK(1),o[d0],0,0,0);
    o[d0]=__builtin_amdgcn_mfma_f32_32x32x16_bf16(pa2,PK(2),o[d0],0,0,0);
    o[d0]=__builtin_amdgcn_mfma_f32_32x32x16_bf16(pa3,PK(3),o[d0],0,0,0);
    #undef PK
  }
}

#ifndef ATTN_STORE16
#define ATTN_STORE16(p,v) pg8::st16_wt((void*)(p),(v))
#endif
template<int THRL> __device__ __forceinline__ void attn_unit(const int wave_id,int b,int h,int qb,const bf16*QN,const bf16*QP,const bf16*__restrict__ KN,const bf16*__restrict__ KP,const bf16*__restrict__ V,bf16*O,char*shm){
  int tid_=wave_id*64+lane_id(); asm volatile("":"+v"(tid_)); const int tid=tid_,lane=tid&63,r32=lane&31,hi=lane>>5; const int wid=__builtin_amdgcn_readfirstlane(tid>>6);
  const long rowbase=(long)b*SEQ; const int q0=qb*QB;
  const bf16*Qwn=QN+(rowbase+q0+wid*QBLK)*QNP+h*D,*Qwp=QP+(rowbase+q0+wid*QBLK)*QPP+h*DR;
  const bf16*Kh=KN+rowbase*KNP+h*D,*Kr=KP+rowbase*KPP,*Vh=V+rowbase*VP+h*D;
  const unsigned lds0=(unsigned)(uintptr_t)shm;
  float*wsf=(float*)(shm+LDS_WS)+wid*64;
  const bf16*ksrc=Kh+(long)lane*KNP+wid*8;
  const bf16*ksrc2=Kr+(long)lane*KPP+(wid&3)*8;
  const bf16*vsrc=Vh+(long)(16*(wid&3)+(lane>>2))*VP+(wid>>2)*32+(lane&3)*8;
  const unsigned kdst=lds0+LDS_K+wid*1024, kdst2=lds0+LDS_K+(8+(wid&3))*1024, vdst=lds0+LDS_V+wid*1024;
  #define KS_(slot) ((slot)+((slot)>>1))
  #define DMA_K(t,slot) do{ glds16(ksrc+(long)(t)*KVBLK*KNP,(unsigned)__builtin_amdgcn_readfirstlane(kdst+KS_(slot))); glds16(ksrc2+(long)(t)*KVBLK*KPP,(unsigned)__builtin_amdgcn_readfirstlane(kdst2+KS_(slot))); }while(0)
  #define DMA_V(t,slot) glds16(vsrc+(long)(t)*KVBLK*VP,(unsigned)__builtin_amdgcn_readfirstlane(vdst+(slot)))
  const int vb0=(int)(lds0+LDS_V)+((lane>>4)&1)*32+(lane&3)*8+(4*hi+((lane&15)>>2))*64;
  const char*Kbase=shm+LDS_K; bf16x8 kf[12];
  const lds_cptr shm3=(lds_cptr)shm; const lds_cptr kp0=shm3+LDS_K+hi*1024+r32*16; const lds_cptr vp0=shm3+LDS_V+((lane>>4)&1)*32+(lane&3)*8+(4*hi+((lane&15)>>2))*64;
  const int NT=(q0+QB)/KVBLK;
  DMA_K(0,0);DMA_V(0,0);DMA_K(1,SLOTB);
  bf16x8 qr[6];
  #pragma unroll
  for(int d0=0;d0<4;++d0)qr[d0]=*reinterpret_cast<const bf16x8*>(&Qwn[(long)r32*QNP+d0*16+hi*8]);
  #pragma unroll
  for(int d0=0;d0<2;++d0)qr[4+d0]=*reinterpret_cast<const bf16x8*>(&Qwp[(long)r32*QPP+d0*16+hi*8]);
  float mhat=0.f,l_reg=0.f;f32x16 o[2];o[0]=f32x16{};o[1]=f32x16{};const f32x16 zero16=f32x16{};
  const int qrel=wid*QBLK+r32;
  #define CMASK(P0,P1,t) do{int jb_=(t)-(NT-4); if(jb_>=0)cmask(P0,P1,jb_,qrel,hi);}while(0)
  bool resc=false;
  #define START(P0,P1) do{ const float rm=rowmax(P0,P1); resc=false; \
    { const float dl=rm; mhat=fadd_s(mhat,dl); \
      _Pragma("unroll") for(int r=0;r<16;++r){P0[r]=fsub_s(P0[r],dl);P1[r]=fsub_s(P1[r],dl);} } \
    _Pragma("unroll") for(int r=0;r<16;++r)P0[r]=__builtin_amdgcn_exp2f(P0[r]); }while(0)
  #define RESC() do{ if(resc){ asm volatile("s_waitcnt lgkmcnt(0)":::"memory"); \
      _Pragma("unroll") for(int d_=0;d_<2;++d_) _Pragma("unroll") for(int r=0;r<16;++r)o[d_][r]*=wsf[crow(r,hi)]; } }while(0)
  f32x16 pA0,pA1,pB0,pB1;
  int sl_prev=0,sl_cur=0,sl_next=SLOTB;
  #define ROT() do{sl_prev=sl_cur;sl_cur=sl_next;sl_next=(sl_next==(NSLOT-1)*SLOTB)?0:sl_next+SLOTB;}while(0)
  DMA_K(2,2*SLOTB);
  WAIT_BAR(5);
  qkt(pA0,pA1,Kbase,qr,zero16,r32,hi);asm volatile("s_nop 15\n\ts_nop 7":"+v"(pA0),"+v"(pA1));CMASK(pA0,pA1,0);
  START(pA0,pA1);
  _Pragma("unroll") for(int r=0;r<16;++r)pA1[r]=__builtin_amdgcn_exp2f(pA1[r]);
  WAIT_BAR(0);
  DMA_K(3,0);DMA_V(1,SLOTB);
  ROT();
  kload8(kf,kp0+KS_(sl_cur));
  WAIT_BAR(3);
  s16x4 vlo[8],vhi[8]; u32x4 pw0,pw1,pw2,pw3;
  #define PKW(P,B) cvtpk_s(P[B],P[B+1])
  #define PAF(k) __builtin_bit_cast(bf16x8,pw##k)
  #define VFR(i) (bf16x8){vlo[i][0],vlo[i][1],vlo[i][2],vlo[i][3],vhi[i][0],vhi[i][1],vhi[i][2],vhi[i][3]}
  #define PIN(x) asm volatile("":"+v"(x))
  #define MX3(a,b,c) __builtin_fmaxf(__builtin_fmaxf((a),(b)),(c))
  #define GAPA(MF,A0,A1,A2,A3,W0,W1,PW) do{ MF; sacc+=A0; sacc+=A1; sacc+=A2; sacc+=A3; PIN(sacc); W0; W1; PIN(PW); SBAR(); }while(0)
  #define EX(v) __builtin_amdgcn_exp2f(v)
  #define GAPB(MF,X,B) do{ MF; X[B]=EX(X[B]); X[B+1]=EX(X[B+1]); X[B+2]=EX(X[B+2]); X[B+3]=EX(X[B+3]); PIN(X); SBAR(); }while(0)
  #define VRD(i) do{ vlo[i]=vtr(vp_+(((i)>>2)*4096+((i)&3)*1024)); vhi[i]=vtr(vp_+(((i)>>2)*4096+((i)&3)*1024+512)); }while(0)
  #define KRD(G,j) do{ if(G){ kload2(kf,kp0+KS_(sl_next),j); SBAR(); } }while(0)
  #define STEP(C0,C1,P0,P1,t,GK,GV,GL) do{ SBAR(); \
    const lds_cptr vp_=vp0+sl_prev; \
    VRD(0); SBAR(); float sacc=(P0[0]+P0[1]); \
    GAPA(C0=__builtin_amdgcn_mfma_f32_32x32x16_bf16(kf[0],qr[0],zero16,0,0,0), P0[2],P0[3],P0[4],P0[5],     pw0[0]=PKW(P0,0), pw0[1]=PKW(P0,2), pw0); \
    VRD(4); SBAR(); GAPA(C1=__builtin_amdgcn_mfma_f32_32x32x16_bf16(kf[1],qr[0],zero16,0,0,0), P0[6],P0[7],P0[8],P0[9],     pw0[2]=PKW(P0,4), pw0[3]=PKW(P0,6), pw0); \
    VRD(1); SBAR(); GAPA(C0=__builtin_amdgcn_mfma_f32_32x32x16_bf16(kf[2],qr[1],C0,0,0,0),   P0[10],P0[11],P0[12],P0[13], pw1[0]=PKW(P0,8), pw1[1]=PKW(P0,10), pw1); \
    VRD(5); SBAR(); GAPA(C1=__builtin_amdgcn_mfma_f32_32x32x16_bf16(kf[3],qr[1],C1,0,0,0),   P0[14],P0[15],P1[0],P1[1],   pw1[2]=PKW(P0,12),pw1[3]=PKW(P0,14), pw1); \
    VRD(2); SBAR(); GAPA(C0=__builtin_amdgcn_mfma_f32_32x32x16_bf16(kf[4],qr[2],C0,0,0,0),   P1[2],P1[3],P1[4],P1[5],     pw2[0]=PKW(P1,0), pw2[1]=PKW(P1,2), pw2); \
    VRD(6); SBAR(); GAPA(C1=__builtin_amdgcn_mfma_f32_32x32x16_bf16(kf[5],qr[2],C1,0,0,0),   P1[6],P1[7],P1[8],P1[9],     pw2[2]=PKW(P1,4), pw2[3]=PKW(P1,6), pw2); \
    VRD(3); SBAR(); GAPA(C0=__builtin_amdgcn_mfma_f32_32x32x16_bf16(kf[6],qr[3],C0,0,0,0),   P1[10],P1[11],P1[12],P1[13], pw3[0]=PKW(P1,8), pw3[1]=PKW(P1,10), pw3); \
    VRD(7); SBAR(); GAPA(C1=__builtin_amdgcn_mfma_f32_32x32x16_bf16(kf[7],qr[3],C1,0,0,0),   P1[14],P1[15],0.f,0.f,       pw3[2]=PKW(P1,12),pw3[3]=PKW(P1,14), pw3); \
    C0=__builtin_amdgcn_mfma_f32_32x32x16_bf16(kf[8],qr[4],C0,0,0,0); C1=__builtin_amdgcn_mfma_f32_32x32x16_bf16(kf[9],qr[4],C1,0,0,0); \
    C0=__builtin_amdgcn_mfma_f32_32x32x16_bf16(kf[10],qr[5],C0,0,0,0); C1=__builtin_amdgcn_mfma_f32_32x32x16_bf16(kf[11],qr[5],C1,0,0,0); SBAR(); \
    _Pragma("unroll") for(int r=0;r<16;++r){C0[r]-=mhat;C1[r]-=mhat;} \
    l_reg+=sacc; \
    if(GK){DMA_K((t)+3,sl_cur);} if(GV){DMA_V((t)+1,sl_next);} \
    CMASK(C0,C1,t); \
    { float a=MX3(C0[0],C0[1],C1[0]),b=MX3(C0[2],C0[3],C1[1]); a=MX3(a,C1[2],C1[3]); \
      _Pragma("unroll") for(int r=4;r<16;r+=4){a=MX3(a,C0[r],C0[r+1]);b=MX3(b,C0[r+2],C0[r+3]);a=MX3(a,C1[r],C1[r+1]);b=MX3(b,C1[r+2],C1[r+3]);} \
      float rm=__builtin_fmaxf(a,b); { auto rr=__builtin_amdgcn_permlane32_swap(__float_as_uint(rm),__float_as_uint(rm),false,false); rm=__builtin_fmaxf(__uint_as_float(rr[0]),__uint_as_float(rr[1])); } \
      resc=false; \
      if(__builtin_expect(__any(rm>(float)THRL),0)){ const float dl=__builtin_fmaxf(rm,0.f); mhat+=dl; \
        _Pragma("unroll") for(int r=0;r<16;++r){C0[r]-=dl;C1[r]-=dl;} \
        const float f=__builtin_amdgcn_exp2f(-dl); l_reg*=f; if(hi==0)wsf[r32]=f; resc=true; } } \
    SBAR(); \
    GAPB(o[0]=__builtin_amdgcn_mfma_f32_32x32x16_bf16(PAF(0),VFR(0),o[0],0,0,0), C0,0); \
    GAPB(o[1]=__builtin_amdgcn_mfma_f32_32x32x16_bf16(PAF(0),VFR(4),o[1],0,0,0), C0,4); \
    KRD(GL,0); GAPB(o[0]=__builtin_amdgcn_mfma_f32_32x32x16_bf16(PAF(1),VFR(1),o[0],0,0,0), C0,8); \
    KRD(GL,1); GAPB(o[1]=__builtin_amdgcn_mfma_f32_32x32x16_bf16(PAF(1),VFR(5),o[1],0,0,0), C0,12); \
    KRD(GL,2); GAPB(o[0]=__builtin_amdgcn_mfma_f32_32x32x16_bf16(PAF(2),VFR(2),o[0],0,0,0), C1,0); \
    KRD(GL,3); GAPB(o[1]=__builtin_amdgcn_mfma_f32_32x32x16_bf16(PAF(2),VFR(6),o[1],0,0,0), C1,4); \
    KRD(GL,4); GAPB(o[0]=__builtin_amdgcn_mfma_f32_32x32x16_bf16(PAF(3),VFR(3),o[0],0,0,0), C1,8); \
    KRD(GL,5); GAPB(o[1]=__builtin_amdgcn_mfma_f32_32x32x16_bf16(PAF(3),VFR(7),o[1],0,0,0), C1,12); \
    }while(0)
  int t=1;
  #undef CMASK
  #define CMASK(P0,P1,t) do{}while(0)
  for(;t+5<NT;t+=2){
    STEP(pB0,pB1,pA0,pA1,t,true,true,true);     WAIT_BAR(3); RESC(); ROT();
    STEP(pA0,pA1,pB0,pB1,t+1,true,true,true);   WAIT_BAR(3); RESC(); ROT();
  }
  #undef CMASK
  #define CMASK(P0,P1,t) do{int jb_=(t)-(NT-4); if(jb_>=0)cmask(P0,P1,jb_,qrel,hi);}while(0)
  #define ENDW(tt) do{ if((tt)+3<NT){WAIT_BAR(3);} else if((tt)+2<NT){WAIT_BAR(1);} else {WAIT_BAR(0);} }while(0)
  for(;t+1<NT;t+=2){
    STEP(pB0,pB1,pA0,pA1,t,(t+3<NT),(t+1<NT),(t+1<NT));       ENDW(t);   RESC(); ROT();
    STEP(pA0,pA1,pB0,pB1,t+1,(t+4<NT),(t+2<NT),(t+2<NT));     ENDW(t+1); RESC(); ROT();
  }
  STEP(pB0,pB1,pA0,pA1,NT-1,false,false,false); RESC();
  { float sacc=pB0[0]+pB0[1]; _Pragma("unroll") for(int r=2;r<16;++r)sacc+=pB0[r]; _Pragma("unroll") for(int r=0;r<16;++r)sacc+=pB1[r]; l_reg+=sacc;
    pw0=(u32x4){PKW(pB0,0),PKW(pB0,2),PKW(pB0,4),PKW(pB0,6)};pw1=(u32x4){PKW(pB0,8),PKW(pB0,10),PKW(pB0,12),PKW(pB0,14)};pw2=(u32x4){PKW(pB1,0),PKW(pB1,2),PKW(pB1,4),PKW(pB1,6)};pw3=(u32x4){PKW(pB1,8),PKW(pB1,10),PKW(pB1,12),PKW(pB1,14)};
    SBAR(); pv(o,vb0+sl_cur,PAF(0),PAF(1),PAF(2),PAF(3)); }
  #undef PKW
  #undef PAF
  #undef VFR
  #undef PIN
  #undef MX3
  #undef GAPA
  #undef GAPB
  #undef EX
  #undef VRD
  #undef KRD
  #undef STEP
  #undef ENDW
  {auto rr=__builtin_amdgcn_permlane32_swap(__float_as_uint(l_reg),__float_as_uint(l_reg),false,false);l_reg=__uint_as_float(rr[0])+__uint_as_float(rr[1]);}
  if(hi==0)wsf[32+r32]=l_reg;asm volatile("s_waitcnt lgkmcnt(0)":::"memory");
  float rli[16];
  #pragma unroll
  for(int r=0;r<16;++r)rli[r]=__builtin_amdgcn_rcpf(wsf[32+crow(r,hi)]);
  bf16*Ow=O+(rowbase+q0+wid*QBLK)*OP+OCOL+h*D;
  { bf16*stg=(bf16*)(shm+LDS_OST)+wid*2048;
    #pragma unroll
    for(int r=0;r<16;++r){const int orow=crow(r,hi);
      #pragma unroll
      for(int d0=0;d0<2;++d0)stg[orow*64+d0*32+r32]=__float2bfloat16(o[d0][r]*rli[r]);}
    asm volatile("s_waitcnt lgkmcnt(0)":::"memory");
    #pragma unroll
    for(int i=0;i<4;++i){const int row=i*8+(lane>>3),ch=lane&7; const u32x4 v=*(const u32x4*)(stg+row*64+ch*8); ATTN_STORE16(Ow+(long)row*OP+ch*8,v);} }
  asm volatile("s_waitcnt lgkmcnt(0)\n\ts_barrier":::"memory");
  #undef DMA_K
  #undef DMA_V
  #undef KS_
  #undef CMASK
  #undef START
  #undef RESC
  #undef ROT
}
constexpr int ATTN_LDS_BYTES=LDS_BYTES;
struct AttnTensors { const bf16* QN; const bf16* QP; const bf16* KN; const bf16* KP; const bf16* V; bf16* O; };
struct AttnUnit { int bh; int qb; };
struct StaticOrder {
  int vcu, G;
  __device__ __forceinline__ explicit StaticOrder(int grid,int block):vcu((grid%8==0)?(block%8)*(grid/8)+block/8:block),G(grid){}
  __device__ __forceinline__ bool next(int i,AttnUnit&u)const{ const int idx=vcu+(i>>1)*G; if(idx>=BATCH*NHEAD*(NQB/2))return false; const int s=idx&3; u.bh=idx>>2; u.qb=(i&1)?7-s:s; return true; }
  __device__ __forceinline__ void a_ready(const AttnUnit&)const{}
  __device__ __forceinline__ void done(const AttnUnit&)const{}
};
template<class Sched,int THRL=8> __device__ __forceinline__ void attn_phase(char*lds,const AttnTensors&T,const Sched&S,const int wave_id){
  AttnUnit u;
  for(int i=0;S.next(i,u);++i){ S.a_ready(u); attn_unit<THRL>(wave_id,u.bh/NHEAD,u.bh%NHEAD,u.qb,T.QN,T.QP,T.KN,T.KP,T.V,T.O,lds); S.done(u); }
}
#undef SBAR
#undef WAIT_BAR
}

#define LAS __attribute__((address_space(3)))
#define CAS __attribute__((address_space(4)))
#define KPTR(T, ap64, i) ((T*)(__attribute__((address_space(1))) T*)(ap64)[i])
constexpr int RING_OFF = 0, RING_BYTES = 131072, LDSCTL_OFF = RING_BYTES, MISC_OFF = LDSCTL_OFF + 320, XCH_OFF = LDSCTL_OFF + 1024  , LDS_BYTES = 147456;
constexpr int N_PHASES = 3 + 7 * DEPTH;
constexpr int CW_P4 = 213760  , CW_WIN = 230144  , CW_S4 = 230400  ;
constexpr int CW_MX = 193024  , CW_GL = 209408  , CW_DR = 211456  ;
constexpr int CW_G5 = 172032  , CW_P6 = 176128  , CW_S5 = 192512, CW_S6 = 192768  ;
constexpr int CW_BAR = 4096, CW_CNT = 160000, CW_Q3 = 170000, CW_Q2 = 171000;
#define XB_TMO      128
#define XB_XCNT(j)  (256  + 64 * (j))
#define XB_XSUB(j)  (1280 + 64 * (j))
#define XB_XGEN(j)  (2304 + 64 * (j))
#define XB_TOP      3328
#define XB_TOPGEN   3392
#define XCD_BAR_WORDS 3456
#define XB_SPIN_CAP (1u << 18)

__device__ __forceinline__ unsigned xb_ld(unsigned* p)              { return __hip_atomic_load(p, __ATOMIC_RELAXED, __HIP_MEMORY_SCOPE_AGENT); }
__device__ __forceinline__ unsigned xb_add(unsigned* p, unsigned v) { return __hip_atomic_fetch_add(p, v, __ATOMIC_RELAXED, __HIP_MEMORY_SCOPE_AGENT); }
__device__ __forceinline__ unsigned xb_xcc_id() { return (unsigned)__builtin_amdgcn_s_getreg((3 << 11) | 20) & 0xFu; }
#define XB_SPIN(cond, bar) do { unsigned _sp = 0; while (cond) { __builtin_amdgcn_s_sleep(1); \
    if ((++_sp & 255u) == 0u) { if (xb_ld(&(bar)[XB_TMO])) break; if (_sp > XB_SPIN_CAP) { atomicAdd(&(bar)[XB_TMO], 1u); break; } } } } while (0)

struct XcdBarrier {
    unsigned* bar; unsigned x;
    volatile LAS unsigned* st;
};

__device__ __forceinline__ XcdBarrier xcd_barrier_post(unsigned* bar, volatile LAS unsigned* st, const bool t0  ) {
    XcdBarrier b; b.bar = bar; b.x = xb_xcc_id(); b.st = st;
    if (t0) (void)xb_add(&bar[XB_XCNT(b.x)], 1u);
    return b;
}
__device__ __forceinline__ void xcd_barrier_complete(unsigned* bar, unsigned x, unsigned& nloc, unsigned& nx) {
    const unsigned G = gridDim.x * gridDim.y * gridDim.z;
    unsigned sum, cnt, mine, sp = 0u;
    for (;;) {
        sum = 0u; cnt = 0u; mine = 0u;
#pragma unroll
        for (unsigned j = 0; j < 16; ++j) { const unsigned c = xb_ld(&bar[XB_XCNT(j)]); sum += c; cnt += (c > 0u) ? 1u : 0u; mine = (j == x) ? c : mine; }
        if (sum == G) break;
        __builtin_amdgcn_s_sleep(1);
        if ((++sp & 255u) == 0u) { if (xb_ld(&bar[XB_TMO])) break; if (sp > XB_SPIN_CAP) { atomicAdd(&bar[XB_TMO], 1u); break; } }
    }
    nloc = mine > 0u ? mine : 1u; nx = cnt > 0u ? cnt : 1u;
}

template <bool ARRIVE_ONLY = false>
__device__ __forceinline__ void xcd_barrier(const XcdBarrier& b, const bool t0) {
    asm volatile("s_waitcnt vmcnt(0)" ::: "memory");
    __syncthreads();
    if (t0) {
        unsigned* bar = b.bar; unsigned bx_ = b.x; asm volatile("" : "+s"(bx_));
        __builtin_amdgcn_s_waitcnt(0);
        unsigned nloc = b.st[0], nx = b.st[1];
        if (nloc == 0u) { xcd_barrier_complete(bar, bx_, nloc, nx); b.st[0] = nloc; b.st[1] = nx; }
        const unsigned old = xb_add(&bar[XB_XSUB(bx_)], 1u);
        const unsigned gen = old / nloc;
        if (old + 1u == (gen + 1u) * nloc) {
            __builtin_amdgcn_fence(__ATOMIC_RELEASE, "agent");
            asm volatile("s_waitcnt vmcnt(0)" ::: "memory");
            const unsigned og = xb_add(&bar[XB_TOP], 1u);
            const unsigned tg = og / nx;
            if (og + 1u == (tg + 1u) * nx) xb_add(&bar[XB_TOPGEN], 1u);
            else XB_SPIN(xb_ld(&bar[XB_TOPGEN]) == tg, bar);
            __builtin_amdgcn_fence(__ATOMIC_ACQUIRE, "agent");
            xb_add(&bar[XB_XGEN(bx_)], 1u);
            asm volatile("s_waitcnt vmcnt(0)" ::: "memory");
            if constexpr (ARRIVE_ONLY) b.st[2] = 0xFFFFFFFFu;
        } else if constexpr (ARRIVE_ONLY) { b.st[2] = gen;
        } else {
            XB_SPIN(xb_ld(&bar[XB_XGEN(bx_)]) == gen, bar);
            __builtin_amdgcn_fence(__ATOMIC_ACQUIRE, "agent");
            asm volatile("s_waitcnt vmcnt(0)" ::: "memory");
        }
    }
    __syncthreads();
}
__device__ __forceinline__ void xcd_barrier_wait(const XcdBarrier& b, const bool t0) {
    if (t0) { unsigned* bar = b.bar; unsigned bx_ = b.x; asm volatile("" : "+s"(bx_)); const unsigned gen = b.st[2];
        if (gen != 0xFFFFFFFFu) { XB_SPIN(xb_ld(&bar[XB_XGEN(bx_)]) == gen, bar); __builtin_amdgcn_fence(__ATOMIC_ACQUIRE, "agent"); asm volatile("s_waitcnt vmcnt(0)" ::: "memory"); } }
    __syncthreads();
}

struct MKArgs { const float* in[35]; float* out; unsigned char* ws; int ph_lo, ph_hi, li, pad; };
static_assert(sizeof(MKArgs) == 37 * 8 + 16 && offsetof(MKArgs, out) == 35 * 8 && offsetof(MKArgs, ws) == 36 * 8, "MKArgs has no padding; KPTR indices");
static_assert((CW_BAR + 32 * XCD_BAR_WORDS) <= CW_CNT && (CW_CNT + DEPTH * SB * 64) <= CW_Q3 && (CW_Q3 + DEPTH * 128) * 4 <= (int)CTL_BYTES, "control words");

enum { CV_WIN = 0, CV_WQB, CV_WKV, CV_T, CV_WFFI };
DEV f32x4 cvt_src4(int kind, const float* src, const float* src2, const float* gain, int ld, int k, int n) {
    f32x4 v = (f32x4){0.f, 0.f, 0.f, 0.f}; float g = 1.f;
    if (kind == CV_WIN) { const int c = colmap_win(n); if (c >= 0) { v = *(const f32x4*)(src + (size_t)k * DIN + c); g = gain[k]; } }
    else if (kind == CV_WQB) { v = *(const f32x4*)(src + (size_t)k * 768 + colmap_qb(n)); g = gain[k]; }
    else if (kind == CV_WKV) { if (k < 128) { const int nn = n & 511; v = *(const f32x4*)((n < 512 ? src : src2) + ((size_t)k * 8 + (nn >> 6)) * 64 + (nn & 63)); g = gain[k]; } }
    else if (kind == CV_T) v = *(const f32x4*)(src + (size_t)k * ld + n);
    else { v = *(const f32x4*)(src + (size_t)k * DFF2 + colmap_ffi(n)); g = gain[k]; }
    return v * g;
}
struct CvtMat { const float* src; const float* src2; const float* gain; bf16_t* dst; int kind, N, K, ld, tm; };
#define CVT_TILES_PER_LAYER 2880
#ifndef CVT_Q0
#define CVT_Q0 0
#endif
#ifndef CVT_CH
#define CVT_CH 4
#endif
#ifndef CVT_CUT_A
#define CVT_CUT_A 1088
#endif
#ifndef CVT_CUT_B
#define CVT_CUT_B 1760
#endif
template <class AP> DEV CvtMat cvt_mat_of(int L, int t, unsigned char* ws, AP ap) {
    unsigned char* wl = ws + WS_W + (size_t)L * WL_SIZE; CvtMat m;
    if (t < 384) { m = CvtMat{KPTR(const float, ap, 9) + (size_t)L * DM * DIN, nullptr, KPTR(const float, ap, 8) + L * DM, (bf16_t*)(wl + WL_IN), CV_WIN, DINP, DM, 0, t}; }
    else if (t < 432) { m = CvtMat{KPTR(const float, ap, 21) + (size_t)L * 256 * 768, nullptr, KPTR(const float, ap, 20) + L * 256, (bf16_t*)(wl + WL_QB), CV_WQB, 768, 256, 0, t - 384}; }
    else if (t < 496) { m = CvtMat{KPTR(const float, ap, 23) + (size_t)L * 128 * 512, KPTR(const float, ap, 24) + (size_t)L * 128 * 512, KPTR(const float, ap, 22) + L * 128, (bf16_t*)(wl + WL_KV), CV_WKV, 1024, 256, 0, t - 432}; }
    else if (t < 512) { m = CvtMat{KPTR(const float, ap, 18) + (size_t)L * 65536, nullptr, nullptr, (bf16_t*)(wl + WL_GLU), CV_T, 256, 256, 256, t - 496}; }
    else if (t < 768) { m = CvtMat{KPTR(const float, ap, 28) + (size_t)L * DM * DM, nullptr, nullptr, (bf16_t*)(wl + WL_OUT), CV_T, DM, DM, DM, t - 512}; }
    else if (t < 2176) { m = CvtMat{KPTR(const float, ap, 30) + (size_t)L * DM * DFF2, nullptr, KPTR(const float, ap, 29) + L * DM, (bf16_t*)(wl + WL_FFI), CV_WFFI, DFF2, DM, 0, t - 768}; }
    else { m = CvtMat{KPTR(const float, ap, 33) + (size_t)L * DFF * DM, nullptr, nullptr, (bf16_t*)(wl + WL_FFO), CV_T, DM, DFF, DM, t - 2176}; }
    return m;
}
template <class AP> DEV void cvt_layer_wg(int L, int wgi, int nwg, int tid, LAS unsigned char* sm, unsigned char* ws, AP ap, int t_begin = 0, int t_end = CVT_TILES_PER_LAYER) {
    LAS bf16_t* T = (LAS bf16_t*)sm;
    const int kk = tid >> 3, nq = tid & 7;
    f32x4 c0 = (f32x4){0.f, 0.f, 0.f, 0.f}, c1 = c0;
    int t = t_begin + wgi;
    if (t < t_end) { const CvtMat m = cvt_mat_of(L, t, ws, ap); const int nb = m.N / 64, k0 = 64 * (m.tm / nb), n0 = 64 * (m.tm % nb);
        c0 = cvt_src4(m.kind, m.src, m.src2, m.gain, m.ld, k0 + kk, n0 + 8 * nq); c1 = cvt_src4(m.kind, m.src, m.src2, m.gain, m.ld, k0 + kk, n0 + 8 * nq + 4); }
    for (; t < t_end; t += nwg) {
        const CvtMat m = cvt_mat_of(L, t, ws, ap); const int nb = m.N / 64, k0 = 64 * (m.tm / nb), n0 = 64 * (m.tm % nb);
        lds_barrier();
#pragma unroll
        for (int e = 0; e < 4; ++e) { T[(8 * nq + e) * 72 + kk] = f2bf(c0[e]); T[(8 * nq + 4 + e) * 72 + kk] = f2bf(c1[e]); }
        if (t + nwg < t_end) { const CvtMat m2 = cvt_mat_of(L, t + nwg, ws, ap); const int nb2 = m2.N / 64, k2 = 64 * (m2.tm / nb2), n2 = 64 * (m2.tm % nb2);
            c0 = cvt_src4(m2.kind, m2.src, m2.src2, m2.gain, m2.ld, k2 + kk, n2 + 8 * nq); c1 = cvt_src4(m2.kind, m2.src, m2.src2, m2.gain, m2.ld, k2 + kk, n2 + 8 * nq + 4); }
        lds_barrier();
        { const int nl = tid >> 3, kc = tid & 7; *(u32x4*)(m.dst + (size_t)(n0 + nl) * m.K + k0 + 8 * kc) = *(const LAS u32x4*)(T + nl * 72 + 8 * kc); }
    }
    lds_barrier();
}
DEV void s5_pre_item(const float* a_re, const float* a_im, const float* log_dt, const float* b_re, const float* b_im, unsigned char* ws, int lg, int p) {
    const float dt = expf(log_dt[lg]);
    const double lr = a_re[lg * 64 + p], li = a_im[lg * 64 + p];
    const double er = exp(lr * dt), ar = er * cos(li * dt), ai = er * sin(li * dt);
    const double nr = ar - 1.0, ni = ai, den = lr * lr + li * li;
    const double cr = (nr * lr + ni * li) / den, ci = (ni * lr - nr * li) / den;
    float2* abar = (float2*)(ws + WS_S5 + (size_t)lg * S5_SIZE + S5_ABAR);
    float2* bbar = (float2*)(ws + WS_S5 + (size_t)lg * S5_SIZE + S5_BBAR);
    abar[p] = make_float2((float)ar, (float)ai);
    for (int c = 0; c < 16; ++c) { const double br = b_re[((size_t)lg * 64 + p) * 16 + c], bi = b_im[((size_t)lg * 64 + p) * 16 + c];
        bbar[p * 16 + c] = make_float2((float)(cr * br - ci * bi), (float)(cr * bi + ci * br)); }
}
DEV void rope_item(unsigned char* ws, int id) {
    const int pr = id >> 4, i = id & 15; const double pos = pr < SEQ ? (double)pr : (double)PAST;
    const float inv = (float)pow(10000.0, -(double)i / 16.0);
    const double ang = pos * (double)inv;
    ((float*)(ws + WS_COS))[id] = (float)cos(ang); ((float*)(ws + WS_SIN))[id] = (float)sin(ang);
}
DEV void xprep_row(const float* x, bf16_t* xb, float* rs, int row, int lane) {
    const f32x4* xr = (const f32x4*)(x + (size_t)row * DM) + lane;
    float part[4];
#pragma unroll
    for (int j = 0; j < 4; ++j) { const f32x4 v = xr[64 * j]; part[j] = wave_sum((v.x * v.x + v.y * v.y) + (v.z * v.z + v.w * v.w));
        u32x2 o; o.x = pk2(v.x, v.y); o.y = pk2(v.z, v.w); *(u32x2*)(xb + (size_t)row * DM + 256 * j + 4 * lane) = o; }
    if (lane < 16) rs[(size_t)row * 16 + lane] = (lane & 3) ? 0.f : (lane == 0 ? part[0] : lane == 4 ? part[1] : lane == 8 ? part[2] : part[3]);
}

DEV float2 cpow_(float lr, float li, float dt, int tau) {
    const float mag = expf((float)tau * lr * dt), ang = li * dt * (float)tau;
    float sn, cs; sincosf(ang, &sn, &cs); return make_float2(mag * cs, mag * sn);
}
DEV void s5_mat_T(const float* a_re, const float* a_im, const float* log_dt, const float* c_re, const float* c_im, unsigned char* ws, int id) {
    const int cg = id & 1, c = (id >> 1) & 15, dj = ((id >> 5) % 63) - 31, lg = id / (32 * 63);
    float kk[8];
#pragma unroll
    for (int i = 0; i < 8; ++i) kk[i] = 0.f;
    if (dj >= 0) { const float2* bb = (const float2*)(ws + WS_S5 + (size_t)lg * S5_SIZE + S5_BBAR); const float2* apw = (const float2*)(ws + WS_APOW) + ((size_t)lg * 33 + dj) * 64;
        for (int p = 0; p < 64; ++p) { const float2 ap = apw[p];
            const float cr = c_re[((size_t)lg * 16 + c) * 64 + p], ci = c_im[((size_t)lg * 16 + c) * 64 + p];
            const float br = cr * ap.x - ci * ap.y, bi = cr * ap.y + ci * ap.x;
#pragma unroll
            for (int i = 0; i < 8; ++i) { const float2 b = bb[p * 16 + cg * 8 + i]; kk[i] += br * b.x - bi * b.y; } } }
    u32x4 o; o.x = pk2(kk[0], kk[1]); o.y = pk2(kk[2], kk[3]); o.z = pk2(kk[4], kk[5]); o.w = pk2(kk[6], kk[7]);
    bf16_t* T = (bf16_t*)(ws + WS_S5 + (size_t)lg * S5_SIZE + S5_TQ);
    const int j0 = dj >= 0 ? dj : 0, j1 = dj >= 0 ? 31 : 31 + dj;
    for (int j = j0; j <= j1; ++j) *(u32x4*)(T + (size_t)(j * 16 + c) * 512 + (j - dj) * 16 + cg * 8) = o;
}
DEV void s5_mat_Q(const float* a_re, const float* a_im, const float* log_dt, unsigned char* ws, int id) {
    const int jp = id & 31, sidx = (id >> 5) & 127, lg = id >> 12, p = sidx & 63;
    const float2 ap = ((const float2*)(ws + WS_APOW))[((size_t)lg * 33 + (31 - jp)) * 64 + p];
    const float2* bb = (const float2*)(ws + WS_S5 + (size_t)lg * S5_SIZE + S5_BBAR) + p * 16;
    float v[16];
#pragma unroll
    for (int c = 0; c < 16; ++c) { const float2 b = bb[c]; v[c] = sidx < 64 ? ap.x * b.x - ap.y * b.y : ap.x * b.y + ap.y * b.x; }
    bf16_t* Q = (bf16_t*)(ws + WS_S5 + (size_t)lg * S5_SIZE + S5_TQ) + (size_t)(512 + sidx) * 512 + jp * 16;
    u32x4 o; o.x = pk2(v[0], v[1]); o.y = pk2(v[2], v[3]); o.z = pk2(v[4], v[5]); o.w = pk2(v[6], v[7]); *(u32x4*)Q = o;
    o.x = pk2(v[8], v[9]); o.y = pk2(v[10], v[11]); o.z = pk2(v[12], v[13]); o.w = pk2(v[14], v[15]); *(u32x4*)(Q + 8) = o;
}
DEV void s5_mat_P(const float* a_re, const float* a_im, const float* log_dt, const float* c_re, const float* c_im, unsigned char* ws, int id) {
    const int sg = id & 15, c = (id >> 4) & 15, j = (id >> 8) & 31, lg = id >> 13;
    float v[8];
#pragma unroll
    for (int i = 0; i < 8; ++i) { const int sidx = sg * 8 + i, p = sidx & 63; const float2 ap = ((const float2*)(ws + WS_APOW))[((size_t)lg * 33 + (j + 1)) * 64 + p];
        const float cr = c_re[((size_t)lg * 16 + c) * 64 + p], ci = c_im[((size_t)lg * 16 + c) * 64 + p];
        v[i] = sidx < 64 ? cr * ap.x - ci * ap.y : -(cr * ap.y + ci * ap.x); }
    u32x4 o; o.x = pk2(v[0], v[1]); o.y = pk2(v[2], v[3]); o.z = pk2(v[4], v[5]); o.w = pk2(v[6], v[7]);
    *(u32x4*)((bf16_t*)(ws + WS_S5 + (size_t)lg * S5_SIZE + S5_P) + (size_t)(j * 16 + c) * 128 + sg * 8) = o;
}
DEV void s5_task(int l, int b, int g, int wave, int lane, LAS unsigned char* sm, unsigned char* ws, float* out, const float* dskip) {
    const int lg = l * 16 + g, fr = lane & 15, fq = lane >> 4;
    const bf16_t* TQ = (const bf16_t*)(ws + WS_S5 + (size_t)lg * S5_SIZE + S5_TQ); const bf16_t* PM = (const bf16_t*)(ws + WS_S5 + (size_t)lg * S5_SIZE + S5_P);
    const bf16_t* U = (const bf16_t*)(ws + WS_U5) + ((size_t)g * M + (size_t)b * SEQ) * 16;
    LAS float* Hloc = (LAS float*)sm; LAS bf16_t* Hin = (LAS bf16_t*)(sm + 32768);
    f32x4 acc[5][4];
#pragma unroll
    for (int i = 0; i < 5; ++i)
#pragma unroll
        for (int nt = 0; nt < 4; ++nt) acc[i][nt] = (f32x4){0.f, 0.f, 0.f, 0.f};
    __syncthreads();
#pragma unroll 4
    for (int s = 0; s < 16; ++s) { const int k0 = 32 * s + 8 * fq;
        bf16x8 bfr[4];
#pragma unroll
        for (int nt = 0; nt < 4; ++nt) bfr[nt] = *(const bf16x8*)(U + (size_t)(nt * 16 + fr) * 512 + k0);
#pragma unroll
        for (int i = 0; i < 4; ++i) { const int rt = wave + 8 * i;
            if (2 * s <= rt) { const bf16x8 a = *(const bf16x8*)(TQ + (size_t)(rt * 16 + fr) * 512 + k0);
#pragma unroll
                for (int nt = 0; nt < 4; ++nt) acc[i][nt] = __builtin_amdgcn_mfma_f32_16x16x32_bf16(a, bfr[nt], acc[i][nt], 0, 0, 0); } }
        { const bf16x8 a = *(const bf16x8*)(TQ + (size_t)((32 + wave) * 16 + fr) * 512 + k0);
#pragma unroll
            for (int nt = 0; nt < 4; ++nt) acc[4][nt] = __builtin_amdgcn_mfma_f32_16x16x32_bf16(a, bfr[nt], acc[4][nt], 0, 0, 0); }
    }
#pragma unroll
    for (int nt = 0; nt < 4; ++nt) *(LAS f32x4*)(Hloc + (nt * 16 + fr) * 128 + 16 * wave + 4 * fq) = acc[4][nt];
    __syncthreads();
    if (wave == 0) { const float2 aL = ((const float2*)(ws + WS_S5 + (size_t)lg * S5_SIZE + S5_AL))[lane]; float hr = 0.f, hi = 0.f;
        for (int n = 0; n < 64; ++n) { Hin[n * 128 + lane] = f2bf(hr); Hin[n * 128 + 64 + lane] = f2bf(hi);
            const float lr = Hloc[n * 128 + lane], li = Hloc[n * 128 + 64 + lane];
            const float nr = aL.x * hr - aL.y * hi + lr, ni = aL.x * hi + aL.y * hr + li; hr = nr; hi = ni; }
        float* o = out + O_S5P + ((((size_t)l * NB + b) * S5G + g) * S5P + lane) * 2; o[0] = hr; o[1] = hi; }
    __syncthreads();
#pragma unroll
    for (int s = 0; s < 4; ++s) { const int k0 = 32 * s + 8 * fq;
        bf16x8 bfr[4];
#pragma unroll
        for (int nt = 0; nt < 4; ++nt) bfr[nt] = *(const LAS bf16x8*)(Hin + (nt * 16 + fr) * 128 + k0);
#pragma unroll
        for (int i = 0; i < 4; ++i) { const int rt = wave + 8 * i; const bf16x8 a = *(const bf16x8*)(PM + (size_t)(rt * 16 + fr) * 128 + k0);
#pragma unroll
            for (int nt = 0; nt < 4; ++nt) acc[i][nt] = __builtin_amdgcn_mfma_f32_16x16x32_bf16(a, bfr[nt], acc[i][nt], 0, 0, 0); } }
    const f32x4 dd = *(const f32x4*)(dskip + l * 256 + g * 16 + 4 * fq);
#pragma unroll
    for (int i = 0; i < 4; ++i) { const int rt = wave + 8 * i;
#pragma unroll
        for (int nt = 0; nt < 4; ++nt) { const int n = nt * 16 + fr; const size_t row = (size_t)b * SEQ + 32 * n + rt;
            const u32x2 uw = *(const u32x2*)((const bf16_t*)(ws + WS_U5) + ((size_t)g * M + row) * 16 + 4 * fq);
            const f32x4 uu = pg8::unpk_lo(uw.x, uw.y); f32x4 y = acc[i][nt] + dd * uu;
            u32x2 o; o.x = pk2(gelu_tanh(y[0]), gelu_tanh(y[1])); o.y = pk2(gelu_tanh(y[2]), gelu_tanh(y[3]));
            *(u32x2*)((bf16_t*)(ws + WS_Y5) + row * 256 + g * 16 + 4 * fq) = o; } }
}
DEV void misc_row(int l, int row, int lane, unsigned char* ws, float* out, const float* g_kv, const float* w_gate, const float* b_gate) {
    const float* t2 = (const float*)(ws + WS_T2F) + (size_t)row * 256;
    f32x4 v = (f32x4){0.f, 0.f, 0.f, 0.f}; if (lane < 44) v = *(const f32x4*)(t2 + 4 * lane);
    const float rk = pg8::rstd4((const float*)(ws + WS_RSKV), row, 1.f / 128.f);
    if (lane < 32) { const f32x4 g = *(const f32x4*)(g_kv + 4 * lane); *(f32x4*)(out + O_CKVP + ((size_t)l * M + row) * KVL + 4 * lane) = v * rk * g; }
    const int pos = row & (SEQ - 1);
    f32x4 pt;
#pragma unroll
    for (int e = 0; e < 4; ++e) pt[e] = shfl_xor_(v[e], 4);
    if (lane >= 32 && lane < 40) { const int q = lane - 32, qi = q & 3;
        const f32x4 cs = *(const f32x4*)((const float*)(ws + WS_COS) + pos * 16 + 4 * qi), sn = *(const f32x4*)((const float*)(ws + WS_SIN) + pos * 16 + 4 * qi);
        const f32x4 o = q < 4 ? v * cs - pt * sn : pt * sn + v * cs;
        *(f32x4*)(out + O_KRP + ((size_t)l * M + row) * ROPE + 4 * q) = o;
        u32x2 w; w.x = pk2(o[0], o[1]); w.y = pk2(o[2], o[3]); *(u32x2*)((bf16_t*)(ws + WS_KP) + (size_t)row * 32 + 8 * qi + 4 * (q >> 2)) = w; }
}
DEV void misc_rows4(int l, int row0, int lane, unsigned char* ws, float* out, const float* g_kv) {
    f32x4 v[4], cs[4], sn[4]; float rk[4];
    const int q = lane - 32, qi = q & 3; const bool rp = lane >= 32 && lane < 40;
#pragma unroll
    for (int r = 0; r < 4; ++r) { const int row = row0 + r; const float* t2 = (const float*)(ws + WS_T2F) + (size_t)row * 256;
        v[r] = (f32x4){0.f, 0.f, 0.f, 0.f}; if (lane < 44) v[r] = *(const f32x4*)(t2 + 4 * lane);
        rk[r] = pg8::rstd4((const float*)(ws + WS_RSKV), row, 1.f / 128.f);
        cs[r] = v[r]; sn[r] = v[r];
        if (rp) { const int pos = row & (SEQ - 1); cs[r] = *(const f32x4*)((const float*)(ws + WS_COS) + pos * 16 + 4 * qi); sn[r] = *(const f32x4*)((const float*)(ws + WS_SIN) + pos * 16 + 4 * qi); } }
    f32x4 g = (f32x4){0.f, 0.f, 0.f, 0.f}; if (lane < 32) g = *(const f32x4*)(g_kv + 4 * lane);
#pragma unroll
    for (int r = 0; r < 4; ++r) { const int row = row0 + r;
        if (lane < 32) *(f32x4*)(out + O_CKVP + ((size_t)l * M + row) * KVL + 4 * lane) = v[r] * rk[r] * g;
        f32x4 pt;
#pragma unroll
        for (int e = 0; e < 4; ++e) pt[e] = shfl_xor_(v[r][e], 4);
        if (rp) { const f32x4 o = q < 4 ? v[r] * cs[r] - pt * sn[r] : pt * sn[r] + v[r] * cs[r];
            *(f32x4*)(out + O_KRP + ((size_t)l * M + row) * ROPE + 4 * q) = o;
            u32x2 w; w.x = pk2(o[0], o[1]); w.y = pk2(o[2], o[3]); *(u32x2*)((bf16_t*)(ws + WS_KP) + (size_t)row * 32 + 8 * qi + 4 * (q >> 2)) = w; } }
}
template <int CTRL, int RMASK> DEV float dpp0(float x) { return __builtin_bit_cast(float, __builtin_amdgcn_update_dpp(0, __builtin_bit_cast(int, x), CTRL, RMASK, 0xf, false)); }
DEV float wave_scan_incl(float x, int row16  ) { x += dpp0<0x111, 0xf>(x); x += dpp0<0x112, 0xf>(x); x += dpp0<0x114, 0xf>(x); x += dpp0<0x118, 0xf>(x);
    const float t0 = shfl_(x, 15), t1 = shfl_(x, 31), t2 = shfl_(x, 47);
    return x + (row16 == 0 ? 0.f : row16 == 1 ? t0 : row16 == 2 ? t0 + t1 : (t0 + t1) + t2); }
DEV float shfl_up_add(float x, int lane, int off) { const float t = shfl_(x, lane >= off ? lane - off : lane); return lane >= off ? x + t : x; }
DEV void gla_task(int l, int b, int h, int wave, int lane, LAS unsigned char* sm, unsigned char* ws, float* out, const float* gn, const float* w_gate, const float* b_gate) {
    constexpr int QS = 40, KS2 = 72;
    constexpr int RQ = 32, RG = 16, RV = 64, RAWB = 64 * RQ * 4 * 2 + 64 * RG * 4 + 64 * RV * 2 * 2;
    LAS bf16_t* QE = (LAS bf16_t*)sm; LAS bf16_t* KE = QE + 64 * QS; LAS bf16_t* KDT = KE + 64 * QS; LAS bf16_t* VT = KDT + 32 * KS2; LAS bf16_t* ST = VT + 64 * KS2; LAS float* DEC = (LAS float*)(ST + 2 * 64 * QS); LAS float* WG = DEC + 32;
    LAS bf16_t* OUTS = (LAS bf16_t*)(WG + 512);
    LAS unsigned char* RAW = (LAS unsigned char*)(OUTS + 2 * 64 * RV);
    static_assert((64 * QS * 2 * 2 + 32 * KS2 * 2 + 64 * KS2 * 2 + 2 * 64 * QS * 2 + 128 + 2048 + 2 * 64 * RV * 2 + 2 * RAWB) <= RING_BYTES, "GLA LDS");
    const float* QKF = (const float*)(ws + WS_QKF); const float* T2F = (const float*)(ws + WS_T2F);
    const bf16_t* GVB = (const bf16_t*)(ws + WS_GVB); const bf16_t* GRB = (const bf16_t*)(ws + WS_GRB); bf16_t* MIX = (bf16_t*)(ws + WS_MIX);
    const int fr = lane & 15, fq = lane >> 4, t = wave * 64 + lane, lrow = t >> 3, lpc = t & 7;
    __syncthreads();
    for (int i = t; i < 64 * QS / 2; i += 512) ((LAS unsigned*)ST)[i] = 0u;
    const f32x4 bg4 = *(const f32x4*)(b_gate + h * 32 + 4 * wave);
    f32x4 wg[16];
#pragma unroll
    for (int r = 0; r < 16; ++r) wg[r] = *(const f32x4*)(w_gate + (size_t)r * 128 + h * 32 + 4 * wave);
    f32x4 S0 = (f32x4){0.f, 0.f, 0.f, 0.f}, S1 = S0;
    const int x4 = wave - 4, sdt = (x4 >> 1) & 1, svt = 2 * (x4 & 1);
    float gg4[4];
#pragma unroll
    for (int vt = 0; vt < 4; ++vt) gg4[vt] = gn[l * 256 + h * 64 + 16 * vt + fr];
    f32x4 lq, lk, lg; u32x4 lv, lr;
#define GLA_LOAD(n_) do { const size_t r_ = (size_t)b * SEQ + (size_t)(n_) * 64 + lrow; lq = *(const f32x4*)(QKF + r_ * 256 + h * 32 + 4 * lpc); lk = *(const f32x4*)(QKF + r_ * 256 + 128 + h * 32 + 4 * lpc); \
        lv = *(const u32x4*)(GVB + r_ * 256 + h * 64 + 8 * lpc); lr = *(const u32x4*)(GRB + r_ * 256 + h * 64 + 8 * lpc); if (t < 256) lg = *(const f32x4*)(T2F + ((size_t)b * SEQ + (size_t)(n_) * 64 + (t >> 2)) * 256 + 160 + 4 * (t & 3)); } while (0)
#define GLA_STASH(buf_) do { LAS unsigned char* rw_ = RAW + (buf_) * RAWB; const int sw_ = lpc ^ ((lrow >> 1) & 7); *(LAS f32x4*)((LAS float*)rw_ + lrow * RQ + 4 * sw_) = lq; *(LAS f32x4*)((LAS float*)rw_ + 64 * RQ + lrow * RQ + 4 * sw_) = lk; \
        if (t < 256) *(LAS f32x4*)((LAS float*)rw_ + 2 * 64 * RQ + (t >> 2) * RG + 4 * ((t & 3) ^ ((t >> 4) & 3))) = lg; \
        LAS bf16_t* rb_ = (LAS bf16_t*)(rw_ + 2 * 64 * RQ * 4 + 64 * RG * 4); *(LAS u32x4*)(rb_ + lrow * RV + 8 * sw_) = lv; *(LAS u32x4*)(rb_ + 64 * RV + lrow * RV + 8 * sw_) = lr; } while (0)
    GLA_LOAD(0); GLA_STASH(0); GLA_LOAD(1);
    __syncthreads();
    for (int n = 0; n < SEQ / 64; ++n) {
        const LAS float* rq = (const LAS float*)(RAW + (n & 1) * RAWB); const LAS float* rk = rq + 64 * RQ; const LAS float* rg = rk + 64 * RQ;
        const LAS bf16_t* rv = (const LAS bf16_t*)(rg + 64 * RG); const LAS bf16_t* rr = rv + 64 * RV;
        { f32x4 bb = bg4;
#pragma unroll
            for (int r = 0; r < 4; ++r) { const f32x4 g4 = *(const LAS f32x4*)(rg + lane * RG + 4 * (r ^ ((lane >> 2) & 3)));
#pragma unroll
                for (int e = 0; e < 4; ++e) bb = bb + wg[4 * r + e] * g4[e]; }
#pragma unroll
            for (int e = 0; e < 4; ++e) bb[e] = log_sigmoid(bb[e]) * (1.f / 16.f);
#pragma unroll
            for (int e = 0; e < 4; ++e) bb[e] = wave_scan_incl(bb[e], fq);
            const int swl = wave ^ ((lane >> 1) & 7);
            const f32x4 q4 = *(const LAS f32x4*)(rq + lane * RQ + 4 * swl), k4 = *(const LAS f32x4*)(rk + lane * RQ + 4 * swl);
            f32x4 bl, qe, ke, kd;
#pragma unroll
            for (int e = 0; e < 4; ++e) { bl[e] = shfl_(bb[e], 63); const float eb = fexp(bb[e]); qe[e] = q4[e] * 0.17677669529663687f * eb; ke[e] = k4[e] * __builtin_amdgcn_rcpf(eb); kd[e] = k4[e] * fexp(bl[e] - bb[e]); }
            u32x2 w; w.x = pk2(qe[0], qe[1]); w.y = pk2(qe[2], qe[3]); *(LAS u32x2*)(QE + lane * QS + 4 * wave) = w;
            w.x = pk2(ke[0], ke[1]); w.y = pk2(ke[2], ke[3]); *(LAS u32x2*)(KE + lane * QS + 4 * wave) = w;
#pragma unroll
            for (int e = 0; e < 4; ++e) KDT[(4 * wave + e) * KS2 + lane] = f2bf(kd[e]);
            if (lane == 0) {
#pragma unroll
                for (int e = 0; e < 4; ++e) DEC[4 * wave + e] = fexp(bl[e]); }
            const u32x4 v8 = *(const LAS u32x4*)(rv + lane * RV + 8 * swl);
            const unsigned vw[4] = {v8.x, v8.y, v8.z, v8.w};
#pragma unroll
            for (int e = 0; e < 4; ++e) { VT[(8 * wave + 2 * e) * KS2 + lane] = (bf16_t)(vw[e] & 0xffffu); VT[(8 * wave + 2 * e + 1) * KS2 + lane] = (bf16_t)(vw[e] >> 16); }
        }
        lds_barrier();
        if (n + 1 < SEQ / 64) GLA_STASH((n + 1) & 1);
        if (n + 2 < SEQ / 64) GLA_LOAD(n + 2);
        if (n > 0) { const u32x4 ov = *(const LAS u32x4*)(OUTS + ((n - 1) & 1) * 64 * RV + lrow * RV + 8 * lpc); *(u32x4*)(MIX + ((size_t)b * SEQ + (size_t)(n - 1) * 64 + lrow) * DM + 768 + h * 64 + 8 * lpc) = ov; }
        const LAS bf16_t* STc = ST + (n & 1) * 64 * QS; LAS bf16_t* STn = ST + ((n + 1) & 1) * 64 * QS;
        if (wave < 4) {
            const int it = wave;
            const bf16x8 qf = *(const LAS bf16x8*)(QE + (16 * it + fr) * QS + 8 * fq);
            f32x4 at[4];
#pragma unroll
            for (int jt = 0; jt < 4; ++jt) { at[jt] = (f32x4){0.f, 0.f, 0.f, 0.f};
                if (jt <= it) { const bf16x8 kf = *(const LAS bf16x8*)(KE + (16 * jt + fr) * QS + 8 * fq);
                    at[jt] = __builtin_amdgcn_mfma_f32_16x16x32_bf16(kf, qf, at[jt], 0, 0, 0);
                    if (jt == it) {
#pragma unroll
                        for (int e = 0; e < 4; ++e) if (4 * fq + e > fr) at[jt][e] = 0.f; } } }
            u32x4 af[2];
#pragma unroll
            for (int s2 = 0; s2 < 2; ++s2) { af[s2].x = pk2(at[2 * s2][0], at[2 * s2][1]); af[s2].y = pk2(at[2 * s2][2], at[2 * s2][3]); af[s2].z = pk2(at[2 * s2 + 1][0], at[2 * s2 + 1][1]); af[s2].w = pk2(at[2 * s2 + 1][2], at[2 * s2 + 1][3]); }
            f32x4 o[4]; float ss[4] = {0.f, 0.f, 0.f, 0.f};
#pragma unroll
            for (int vt = 0; vt < 4; ++vt) { o[vt] = (f32x4){0.f, 0.f, 0.f, 0.f};
                const bf16x8 sf = *(const LAS bf16x8*)(STc + (16 * vt + fr) * QS + 8 * fq);
                o[vt] = __builtin_amdgcn_mfma_f32_16x16x32_bf16(qf, sf, o[vt], 0, 0, 0);
#pragma unroll
                for (int s2 = 0; s2 < 2; ++s2) if (2 * s2 <= it) {
                    const u32x2 v0 = *(const LAS u32x2*)(VT + (16 * vt + fr) * KS2 + 32 * s2 + 4 * fq), v1 = *(const LAS u32x2*)(VT + (16 * vt + fr) * KS2 + 32 * s2 + 16 + 4 * fq);
                    const u32x4 vf = {v0.x, v0.y, v1.x, v1.y};
                    o[vt] = __builtin_amdgcn_mfma_f32_16x16x32_bf16(__builtin_bit_cast(bf16x8, af[s2]), __builtin_bit_cast(bf16x8, vf), o[vt], 0, 0, 0); }
#pragma unroll
                for (int e = 0; e < 4; ++e) ss[e] += o[vt][e] * o[vt][e]; }
#pragma unroll
            for (int e = 0; e < 4; ++e) { float tt = ss[e]; tt += shfl_xor_(tt, 1); tt += shfl_xor_(tt, 2); tt += shfl_xor_(tt, 4); tt += shfl_xor_(tt, 8); ss[e] = rsqrtf(tt * (1.f / 64.f) + EPS); }
            LAS bf16_t* oo = OUTS + (n & 1) * 64 * RV;
            bf16_t grw[4][4];
#pragma unroll
            for (int vt = 0; vt < 4; ++vt)
#pragma unroll
                for (int e = 0; e < 4; ++e) { const int i2 = 16 * it + 4 * fq + e, v = 16 * vt + fr; grw[vt][e] = rr[i2 * RV + 8 * ((v >> 3) ^ ((i2 >> 1) & 7)) + (v & 7)]; }
#pragma unroll
            for (int vt = 0; vt < 4; ++vt) { const int v = 16 * vt + fr; const float gg = gg4[vt];
#pragma unroll
                for (int e = 0; e < 4; ++e) { const int i2 = 16 * it + 4 * fq + e; const float gr = bf2f(grw[vt][e]);
                    oo[i2 * RV + v] = f2bf(o[vt][e] * ss[e] * gg * gr * sigmoidf_(gr)); } }
        } else {
            f32x4 u0 = (f32x4){0.f, 0.f, 0.f, 0.f}, u1 = u0;
#pragma unroll
            for (int s2 = 0; s2 < 2; ++s2) { const bf16x8 kf = *(const LAS bf16x8*)(KDT + (16 * sdt + fr) * KS2 + 32 * s2 + 8 * fq);
                const bf16x8 va = *(const LAS bf16x8*)(VT + (16 * svt + fr) * KS2 + 32 * s2 + 8 * fq), vb2 = *(const LAS bf16x8*)(VT + (16 * (svt + 1) + fr) * KS2 + 32 * s2 + 8 * fq);
                u0 = __builtin_amdgcn_mfma_f32_16x16x32_bf16(kf, va, u0, 0, 0, 0); u1 = __builtin_amdgcn_mfma_f32_16x16x32_bf16(kf, vb2, u1, 0, 0, 0); }
            const f32x4 dc = *(const LAS f32x4*)(DEC + 16 * sdt + 4 * fq);
            S0 = dc * S0 + u0; S1 = dc * S1 + u1;
            u32x2 w; w.x = pk2(S0[0], S0[1]); w.y = pk2(S0[2], S0[3]); *(LAS u32x2*)(STn + (16 * svt + fr) * QS + 16 * sdt + 4 * fq) = w;
            w.x = pk2(S1[0], S1[1]); w.y = pk2(S1[2], S1[3]); *(LAS u32x2*)(STn + (16 * (svt + 1) + fr) * QS + 16 * sdt + 4 * fq) = w;
        }
        lds_barrier();
    }
#undef GLA_LOAD
#undef GLA_STASH
    { const u32x4 ov = *(const LAS u32x4*)(OUTS + ((SEQ / 64 - 1) & 1) * 64 * RV + lrow * RV + 8 * lpc); *(u32x4*)(MIX + ((size_t)b * SEQ + (size_t)(SEQ / 64 - 1) * 64 + lrow) * DM + 768 + h * 64 + 8 * lpc) = ov; }
    if (wave >= 4) { float* so = out + O_GLAP + (((size_t)l * NB + b) * GH + h) * GDK * GDV;
#pragma unroll
        for (int e = 0; e < 4; ++e) { so[(16 * sdt + 4 * fq + e) * GDV + 16 * svt + fr] = S0[e]; so[(16 * sdt + 4 * fq + e) * GDV + 16 * (svt + 1) + fr] = S1[e]; } }
}
template <bool F32A, bool PAIR, class Epi> DEV void sgemm_wg(const void* Aptr, int lda, const bf16_t* Bt, int ldb, int K, int n0, int n1, int wave, int lane, LAS float* red, Epi epi) {
    const int r32 = lane & 31, hi = lane >> 5, kper = K / 8, kb = wave * kper;
    f32x16 acc0, acc1;
#pragma unroll
    for (int r = 0; r < 16; ++r) { acc0[r] = 0.f; acc1[r] = 0.f; }
    float ss = 0.f;
    const bf16_t* bp0 = Bt + (size_t)(n0 + r32) * ldb + 8 * hi; const bf16_t* bp1 = Bt + (size_t)(n1 + r32) * ldb + 8 * hi;
    __syncthreads();
#pragma unroll 8
    for (int k = kb; k < kb + kper; k += 16) {
        bf16x8 a;
        if (F32A) { const float* ap = (const float*)Aptr + (size_t)r32 * lda + k + 8 * hi; const f32x4 x0 = *(const f32x4*)ap, x1 = *(const f32x4*)(ap + 4);
            ss += (x0.x * x0.x + x0.y * x0.y) + (x0.z * x0.z + x0.w * x0.w) + (x1.x * x1.x + x1.y * x1.y) + (x1.z * x1.z + x1.w * x1.w);
            u32x4 w; w.x = pk2(x0.x, x0.y); w.y = pk2(x0.z, x0.w); w.z = pk2(x1.x, x1.y); w.w = pk2(x1.z, x1.w); a = __builtin_bit_cast(bf16x8, w); }
        else a = *(const bf16x8*)((const bf16_t*)Aptr + (size_t)r32 * lda + k + 8 * hi);
        acc0 = __builtin_amdgcn_mfma_f32_32x32x16_bf16(a, *(const bf16x8*)(bp0 + k), acc0, 0, 0, 0);
        if (PAIR) acc1 = __builtin_amdgcn_mfma_f32_32x32x16_bf16(a, *(const bf16x8*)(bp1 + k), acc1, 0, 0, 0);
    }
    LAS float* ssw = red + 2 * 8 * 1024;
#pragma unroll
    for (int r = 0; r < 16; ++r) { red[(wave * 16 + r) * 64 + lane] = acc0[r]; if (PAIR) red[8 * 1024 + (wave * 16 + r) * 64 + lane] = acc1[r]; }
    if (F32A) { ss += shfl_xor_(ss, 32); if (lane < 32) ssw[wave * 32 + lane] = ss; }
    __syncthreads();
#pragma unroll
    for (int i = 0; i < 2; ++i) { const int e = wave * 64 + lane + 512 * i, r = e >> 6, ln = e & 63, row = crow(r, ln >> 5);
        float v0 = 0.f, v1 = 0.f, sq = 0.f;
#pragma unroll
        for (int w = 0; w < 8; ++w) { v0 += red[(w * 16 + r) * 64 + ln]; if (PAIR) v1 += red[8 * 1024 + (w * 16 + r) * 64 + ln]; if (F32A) sq += ssw[w * 32 + row]; }
        epi(row, ln & 31, v0, v1, sq); }
}
DEV void wg_wait(const unsigned* c0, unsigned n0, const unsigned* c1, unsigned n1, int wave_s) { if (wave_s == 0) { pg8::poll_ge(c0, n0); if (c1) pg8::poll_ge(c1, n1); pg8::acq_agent(); } __syncthreads(); }
DEV void wg_wait8(const unsigned* c, unsigned n, int wave_s) { if (wave_s == 0) {
#pragma unroll 1
        for (int i = 0; i < 8; ++i) pg8::poll_ge(c + 64 * i, n);
        pg8::acq_agent(); } __syncthreads(); }
DEV void wg_post(unsigned* c, int wave_s) { __syncthreads(); if (wave_s == 0 && lane_id() == 0) { __builtin_amdgcn_fence(__ATOMIC_RELEASE, "agent"); asm volatile("s_waitcnt vmcnt(0)" ::: "memory"); __hip_atomic_fetch_add(c, 1u, __ATOMIC_RELAXED, __HIP_MEMORY_SCOPE_AGENT); } }
struct SampleW { const float *s5_c_re, *s5_c_im, *s5_d, *s5_w_glu, *s5_b_glu, *q_norm_g, *w_qb, *kv_norm_g, *w_uk, *w_uv, *w_gate, *b_gate, *gla_norm_g, *state_s5, *state_gla; };
template <int K> DEV float dot_bf16row(const bf16_t* row, const LAS float* x) {
    float a = 0.f;
#pragma unroll 8
    for (int k = 0; k < K; k += 8) { const u32x4 w = *(const u32x4*)(row + k); const f32x4 x0 = *(const LAS f32x4*)(x + k), x1 = *(const LAS f32x4*)(x + k + 4);
        const f32x4 w0 = pg8::unpk_lo(w.x, w.y), w1 = pg8::unpk_lo(w.z, w.w);
        a += (w0[0] * x0[0] + w0[1] * x0[1]) + (w0[2] * x0[2] + w0[3] * x0[3]) + (w1[0] * x1[0] + w1[1] * x1[1]) + (w1[2] * x1[2] + w1[3] * x1[3]); }
    return a;
}
template <int K> DEV float dot_f32row(const float* row, const LAS float* x) {
    float a = 0.f;
#pragma unroll 8
    for (int k = 0; k < K; k += 4) { const f32x4 w = *(const f32x4*)(row + k), xx = *(const LAS f32x4*)(x + k); a += (w[0] * xx[0] + w[1] * xx[1]) + (w[2] * xx[2] + w[3] * xx[3]); }
    return a;
}
DEV void sample_prep_task(int l, int b, int t, LAS unsigned char* sm, unsigned char* ws, float* out, const SampleW& w, const bf16_t* wqb, const bf16_t* wglu) {
    LAS float* u = (LAS float*)sm; LAS float* ys = u + 256; LAS float* cqn = ys + 256; LAS float* qv = cqn + 256; LAS float* red = qv + 768; LAS float* gdec = red + 16; LAS float* hsr = gdec + 128; LAS float* hsi = hsr + 1024;
    const int lane = t & 63, wv = t >> 6; const bool act = t < 256;
    const float* ps = (const float*)(ws + WS_PS) + (size_t)b * DINP;
    bf16_t* mixs = (bf16_t*)(ws + WS_MIXS) + (size_t)b * DM;
    __syncthreads();
    float cq = 0.f, t2 = 0.f;
    if (act) { u[t] = ps[t]; cq = ps[256 + t]; t2 = ps[512 + t];
        const float s1 = wave_sum(cq * cq), s2 = wave_sum(t < 128 ? t2 * t2 : 0.f);
        if (lane == 0) { red[wv] = s1; red[4 + wv] = s2; } }
    __syncthreads();
    const float rq = rsqrtf(((red[0] + red[1]) + (red[2] + red[3])) * (1.f / 256.f) + EPS), rk = rsqrtf(((red[4] + red[5]) + (red[6] + red[7])) * (1.f / 128.f) + EPS);
    if (act) cqn[t] = cq * rq;
#pragma unroll
    for (int i = 0; i < 2; ++i) { const int s = t + 512 * i, g = s >> 6, p = s & 63, lg = l * 16 + g;
        const float2 a = ((const float2*)(ws + WS_S5 + (size_t)lg * S5_SIZE + S5_ABAR))[p];
        const f32x4* bb = (const f32x4*)((const float2*)(ws + WS_S5 + (size_t)lg * S5_SIZE + S5_BBAR) + p * 16);
        const float2 h0 = *(const float2*)(w.state_s5 + ((((size_t)l * SB + b) * S5G + g) * S5P + p) * 2);
        float hr = a.x * h0.x - a.y * h0.y, hi = a.x * h0.y + a.y * h0.x;
#pragma unroll
        for (int c = 0; c < 8; ++c) { const f32x4 b2 = bb[c]; const float u0 = u[g * 16 + 2 * c], u1 = u[g * 16 + 2 * c + 1]; hr += b2[0] * u0 + b2[2] * u1; hi += b2[1] * u0 + b2[3] * u1; }
        hsr[s] = hr; hsi[s] = hi;
        *(float2*)(out + O_S5S + ((((size_t)l * SB + b) * S5G + g) * S5P + p) * 2) = make_float2(hr, hi); }
    __syncthreads();
    qv[t] = dot_bf16row<256>(wqb + (size_t)t * 256, cqn);
    if (act) { const int g = t >> 4, c = t & 15; const float* cr = w.s5_c_re + (((size_t)l * 16 + g) * 16 + c) * 64; const float* ci = w.s5_c_im + (((size_t)l * 16 + g) * 16 + c) * 64;
        const float y = dot_f32row<64>(cr, hsr + g * 64) - dot_f32row<64>(ci, hsi + g * 64) + w.s5_d[l * 256 + t] * u[t]; ys[t] = gelu_tanh(y); }
    else qv[256 + t] = dot_bf16row<256>(wqb + (size_t)(256 + t) * 256, cqn);
    __syncthreads();
    float* qlat = (float*)(ws + WS_QLAT) + (size_t)b * MH * 160;
#pragma unroll
    for (int i = 0; i < 2; ++i) { const int idx = t + 512 * i, h = idx >> 7, lp = idx & 127;
        qlat[h * 160 + lp] = dot_f32row<64>(w.w_uk + (((size_t)l * 128 + lp) * 8 + h) * 64, qv + h * 64) * QSCALE; }
    if (act) { const float z = dot_bf16row<256>(wglu + (size_t)t * 256, ys) + w.s5_b_glu[l * 256 + t]; mixs[t] = f2bf(ys[t] * sigmoidf_(z));
        const float* cosS = (const float*)(ws + WS_COS) + SEQ * 16; const float* sinS = (const float*)(ws + WS_SIN) + SEQ * 16;
        { const int h = t >> 5, j = t & 31, i = j & 15; const float x1 = qv[512 + h * 32 + rope_phys(i)], x2 = qv[512 + h * 32 + rope_phys(i + 16)];
            qlat[h * 160 + 128 + j] = (j < 16 ? x1 * cosS[i] - x2 * sinS[i] : x1 * sinS[i] + x2 * cosS[i]) * QSCALE; }
        float* kvnew = (float*)(ws + WS_KVNEW) + (size_t)b * 160;
        if (t < 128) { const float v = t2 * rk * w.kv_norm_g[l * 128 + t]; kvnew[t] = v; out[O_CKVS + ((size_t)l * SB + b) * KVL + t] = v; }
        else if (t < 160) { const int j = t - 128, i = j & 15; const float x1 = ps[640 + i], x2 = ps[656 + i];
            const float v = j < 16 ? x1 * cosS[i] - x2 * sinS[i] : x1 * sinS[i] + x2 * cosS[i]; kvnew[t] = v; out[O_KRS + ((size_t)l * SB + b) * ROPE + j] = v; }
        if (t < 128) { float z2 = w.b_gate[l * 128 + t];
#pragma unroll
            for (int r = 0; r < 16; ++r) z2 += ps[672 + r] * w.w_gate[((size_t)l * 16 + r) * 128 + t];
            gdec[t] = fexp(log_sigmoid(z2) * (1.f / 16.f)); } }
    __syncthreads();
    if (act) { const int h = t >> 6, v = t & 63; const float vv = ps[1024 + t]; float o = 0.f;
        const float* s0 = w.state_gla + (((size_t)l * SB + b) * GH + h) * GDK * GDV; float* so = out + O_GLAS + (((size_t)l * SB + b) * GH + h) * GDK * GDV;
#pragma unroll 8
        for (int d = 0; d < 32; ++d) { const float sN = gdec[h * 32 + d] * s0[d * 64 + v] + ps[896 + h * 32 + d] * vv; so[d * 64 + v] = sN; o += ps[768 + h * 32 + d] * 0.17677669529663687f * sN; }
        const float r = rsqrtf(wave_sum(o * o) * (1.f / 64.f) + EPS); const float gr = ps[1280 + t];
        mixs[768 + t] = f2bf(o * r * w.gla_norm_g[l * 256 + t] * gr * sigmoidf_(gr)); }
    __syncthreads();
}
DEV void sample_attn_task(int l, int item, int t, LAS unsigned char* sm, unsigned char* ws, const float* cache_ckv, const float* cache_kr, const int* page_table, const float* w_uv) {
    constexpr int KST = 168;
    LAS bf16_t* KB = (LAS bf16_t*)sm; LAS float* WO = (LAS float*)sm;
    LAS bf16_t* QB = (LAS bf16_t*)(sm + 256 * KST * 2); LAS float* QS = (LAS float*)(QB + 32 * KST);     LAS float* OL = QS + 8 * 160; LAS float* WM = OL + 8 * 128; LAS unsigned* FLAG = (LAS unsigned*)(WM + 128);
    const int b = item / NSPLIT, sp = item % NSPLIT, lane = t & 63, h = t >> 6, wv = h, r32 = lane & 31, hi = lane >> 5;
    __syncthreads();
    for (int i = t; i < 8 * 160; i += 512) QS[i] = ((const float*)(ws + WS_QLAT))[(size_t)b * 1280 + i];
    for (int i = t; i < 32 * KST / 2; i += 512) { const int row = (2 * i) / KST, col = (2 * i) % KST; float x0 = 0.f, x1 = 0.f;
        if (row < 8 && col < 160) { const float* qp = (const float*)(ws + WS_QLAT) + (size_t)b * 1280 + row * 160 + col; x0 = qp[0]; x1 = qp[1]; }
        ((LAS unsigned*)QB)[i] = pk2(x0, x1); }
    float m = -INFINITY, lsum = 0.f; f32x16 O[4];
#pragma unroll
    for (int c = 0; c < 4; ++c)
#pragma unroll
        for (int r = 0; r < 16; ++r) O[c][r] = 0.f;
    const LAS bf16_t* vtb = KB + (32 * wv + 4 * hi + ((lane & 15) >> 2)) * KST + 16 * ((lane >> 4) & 1) + 4 * (lane & 3);
    f32x4 pk[16], pr[4];
#define LOAD_STEP(it_) do { _Pragma("unroll") for (int pg_ = 0; pg_ < 2; ++pg_) { const int phys_ = page_table[b * NPAGES + sp * (KPS / PAGE) + 2 * (it_) + pg_]; \
        const f32x4* s1_ = (const f32x4*)(cache_ckv + ((size_t)l * NPOOL + phys_) * PAGE * KVL) + t; const f32x4* s2_ = (const f32x4*)(cache_kr + ((size_t)l * NPOOL + phys_) * PAGE * ROPE) + t; \
        _Pragma("unroll") for (int i_ = 0; i_ < 8; ++i_) pk[8 * pg_ + i_] = __builtin_nontemporal_load(s1_ + 512 * i_); pr[2 * pg_] = __builtin_nontemporal_load(s2_); pr[2 * pg_ + 1] = __builtin_nontemporal_load(s2_ + 512); } } while (0)
    LOAD_STEP(0);
    for (int it = 0; it < KPS / 256; ++it) {
        lds_barrier();
#pragma unroll
        for (int pg = 0; pg < 2; ++pg) {
#pragma unroll
            for (int i = 0; i < 8; ++i) { const int e = t + 512 * i, key = e >> 5, c4 = e & 31; const f32x4 v = pk[8 * pg + i]; u32x2 w; w.x = pk2(v[0], v[1]); w.y = pk2(v[2], v[3]); *(LAS u32x2*)(KB + (128 * pg + key) * KST + 4 * c4) = w; }
#pragma unroll
            for (int i = 0; i < 2; ++i) { const int e = t + 512 * i, key = e >> 3, c4 = e & 7; const f32x4 v = pr[2 * pg + i]; u32x2 w; w.x = pk2(v[0], v[1]); w.y = pk2(v[2], v[3]); *(LAS u32x2*)(KB + (128 * pg + key) * KST + 128 + 4 * c4) = w; } }
        if (it + 1 < KPS / 256) LOAD_STEP(it + 1);
        lds_barrier();
        f32x16 S;
#pragma unroll
        for (int r = 0; r < 16; ++r) S[r] = 0.f;
        const LAS bf16_t* kr_ = KB + (32 * wv + r32) * KST + 8 * hi;
#pragma unroll
        for (int s2 = 0; s2 < 10; ++s2) S = __builtin_amdgcn_mfma_f32_32x32x16_bf16(*(const LAS bf16x8*)(kr_ + 16 * s2), *(const LAS bf16x8*)(QB + r32 * KST + 8 * hi + 16 * s2), S, 0, 0, 0);
        float mx = S[0];
#pragma unroll
        for (int r = 1; r < 16; ++r) mx = fmaxf(mx, S[r]);
        mx = fmaxf(mx, shfl_xor_(mx, 32));
        const float mn = fmaxf(m, mx), al_ = fexp2(m - mn); float psum = 0.f;
#pragma unroll
        for (int r = 0; r < 16; ++r) { S[r] = fexp2(S[r] - mn); psum += S[r]; }
        psum += shfl_xor_(psum, 32); lsum = lsum * al_ + psum; m = mn;
        u32x4 pb[2];
#pragma unroll
        for (int ks = 0; ks < 2; ++ks) { pb[ks].x = pk2(S[8 * ks + 0], S[8 * ks + 1]); pb[ks].y = pk2(S[8 * ks + 2], S[8 * ks + 3]); pb[ks].z = pk2(S[8 * ks + 4], S[8 * ks + 5]); pb[ks].w = pk2(S[8 * ks + 6], S[8 * ks + 7]); }
#pragma unroll
        for (int c = 0; c < 4; ++c) {
#pragma unroll
            for (int r = 0; r < 16; ++r) O[c][r] *= al_;
#pragma unroll
            for (int ks = 0; ks < 2; ++ks) {
                const attn_body::s16x4 lo = attn_body::vtr((attn_body::lds_cptr)(vtb + (16 * ks) * KST + 32 * c)), hi4 = attn_body::vtr((attn_body::lds_cptr)(vtb + (16 * ks + 8) * KST + 32 * c));
                const bf16x8 af = {lo[0], lo[1], lo[2], lo[3], hi4[0], hi4[1], hi4[2], hi4[3]};
                O[c] = __builtin_amdgcn_mfma_f32_32x32x16_bf16(af, __builtin_bit_cast(bf16x8, pb[ks]), O[c], 0, 0, 0); } }
    }
#undef LOAD_STEP
    __syncthreads();
    if (r32 < 8 && hi == 0) { WM[(wv * 8 + r32) * 2] = m; WM[(wv * 8 + r32) * 2 + 1] = lsum; }
#pragma unroll
    for (int c = 0; c < 4; ++c) if (r32 < 8) {
#pragma unroll
        for (int r = 0; r < 16; ++r) WO[(wv * 8 + r32) * 128 + 32 * c + crow(r, hi)] = O[c][r]; }
    __syncthreads();
    float o0 = 0.f, o1 = 0.f;
    { float mx = -INFINITY;
#pragma unroll
      for (int w2 = 0; w2 < 8; ++w2) mx = fmaxf(mx, WM[(w2 * 8 + h) * 2]);
      float L = 0.f;
#pragma unroll
      for (int w2 = 0; w2 < 8; ++w2) { const float f = fexp2(WM[(w2 * 8 + h) * 2] - mx); L += f * WM[(w2 * 8 + h) * 2 + 1]; o0 += f * WO[(w2 * 8 + h) * 128 + lane]; o1 += f * WO[(w2 * 8 + h) * 128 + 64 + lane]; }
      m = mx; lsum = L; }
    float* opl = (float*)(ws + WS_OP) + (size_t)l * SB * NSPLIT * MH * 128; float* mll = (float*)(ws + WS_ML) + (size_t)l * SB * NSPLIT * MH * 2;
    { float* op = opl + (((size_t)b * NSPLIT + sp) * MH + h) * 128;
      __hip_atomic_store(op + lane, o0, __ATOMIC_RELAXED, __HIP_MEMORY_SCOPE_AGENT); __hip_atomic_store(op + 64 + lane, o1, __ATOMIC_RELAXED, __HIP_MEMORY_SCOPE_AGENT);
      if (lane == 0) { float* ml = mll + (((size_t)b * NSPLIT + sp) * MH + h) * 2; __hip_atomic_store(ml, m, __ATOMIC_RELAXED, __HIP_MEMORY_SCOPE_AGENT); __hip_atomic_store(ml + 1, lsum, __ATOMIC_RELAXED, __HIP_MEMORY_SCOPE_AGENT); } }
    asm volatile("s_waitcnt vmcnt(0)" ::: "memory");
    __syncthreads();
    if (t == 0) { unsigned* cnt = (unsigned*)(ws + WS_CTL) + CW_CNT + (l * SB + b) * 64;
        const unsigned old = __hip_atomic_fetch_add(cnt, 1u, __ATOMIC_RELAXED, __HIP_MEMORY_SCOPE_AGENT);
        const unsigned last = old == (unsigned)(NSPLIT - 1) ? 1u : 0u;
        if (last) __builtin_amdgcn_fence(__ATOMIC_ACQUIRE, "agent");
        FLAG[0] = last; }
    __syncthreads();
    if (FLAG[0] != 0u) {
        const float* kn = (const float*)(ws + WS_KVNEW) + (size_t)b * 160;
        float sn = QS[h * 160 + lane] * kn[lane] + QS[h * 160 + 64 + lane] * kn[64 + lane] + (lane < 32 ? QS[h * 160 + 128 + lane] * kn[128 + lane] : 0.f);
        sn = wave_sum(sn);
        const float* ml = mll + ((size_t)b * NSPLIT * MH + h) * 2; const float* op = opl + ((size_t)b * NSPLIT * MH + h) * 128;
        float mx = sn;
        for (int s = 0; s < NSPLIT; ++s) mx = fmaxf(mx, ml[s * MH * 2]);
        const float wn = fexp2(sn - mx); float L = wn, a0 = wn * kn[lane], a1 = wn * kn[64 + lane];
#pragma unroll
        for (int s = 0; s < NSPLIT; ++s) { const float ws_ = fexp2(ml[s * MH * 2] - mx); L += ws_ * ml[s * MH * 2 + 1]; a0 += ws_ * op[s * MH * 128 + lane]; a1 += ws_ * op[s * MH * 128 + 64 + lane]; }
        const float inv = 1.f / L; OL[h * 128 + lane] = a0 * inv; OL[h * 128 + 64 + lane] = a1 * inv;
        asm volatile("s_waitcnt lgkmcnt(0)" ::: "memory");
        float a = 0.f; const float* uv = w_uv + (size_t)l * 128 * 512 + h * 64 + lane;
#pragma unroll 16
        for (int lp = 0; lp < 128; ++lp) a += OL[h * 128 + lp] * uv[(size_t)lp * 512];
        ((bf16_t*)(ws + WS_MIXS))[(size_t)b * DM + 256 + h * 64 + lane] = f2bf(a);
        wg_post((unsigned*)(ws + WS_CTL) + CW_DR + 64 * l, h);
    }
}
#ifndef MK_CUT
#define MK_CUT 0
#endif
__global__ void __launch_bounds__(512, 2) mk_fwd(MKArgs args) {
    extern __shared__ __attribute__((aligned(16))) unsigned char lds[];
    LAS unsigned char* ldsl = (LAS unsigned char*)lds;
    volatile LAS unsigned* MISC = (volatile LAS unsigned*)(ldsl + MISC_OFF);
    const int wave_s = __builtin_amdgcn_readfirstlane((int)threadIdx.x >> 6);
#define PHASE_IDS int tid = wave_s * 64 + lane_id(); asm volatile("" : "+v"(tid)); const int lane = tid & 63, wave = __builtin_amdgcn_readfirstlane(tid >> 6), gw = bx * 8 + wave, gtid = bx * 512 + tid; (void)lane; (void)gw; (void)gtid;
    { const int bx = blockIdx.x; PHASE_IDS
      for (int u = tid; u < (LDS_BYTES - LDSCTL_OFF) / 4; u += 512) ((LAS unsigned*)(ldsl + LDSCTL_OFF))[u] = 0u; }
    __syncthreads();
    XcdBarrier bar = xcd_barrier_post((unsigned*)(args.ws + WS_CTL) + CW_BAR + args.li * XCD_BAR_WORDS, MISC + 8, wave_s == 0 && lane_id() == 0);
    const int lo = args.ph_lo, hi = args.ph_hi; (void)lo; (void)hi;
#if MK_CUT
#define IN(k) (lo <= (k) && (k) < hi)
#else
#define IN(k) true
#endif
#define SEAM(k) do { if (IN(k) && IN((k) + 1)) xcd_barrier(bar, wave_s == 0 && lane_id() == 0); } while (0)
#define PHASE_PTRS const CAS unsigned long long* ap = (const CAS unsigned long long*)__builtin_amdgcn_kernarg_segment_ptr(); asm volatile("" : "+s"(ap)); unsigned char* ws = KPTR(unsigned char, ap, 36); float* out = KPTR(float, ap, 35); int G = (int)gridDim.x, bx = (int)blockIdx.x; unsigned ldsb_ = 0u; asm volatile("" : "+s"(G), "+s"(bx), "+s"(ldsb_)); \
    const int ngw = G * 8, gthreads = G * 512; LAS unsigned char* ldsl = (LAS unsigned char*)lds + ldsb_; (void)ngw; (void)gthreads; (void)ldsl; \
    bf16_t* XB = (bf16_t*)(ws + WS_XB); float* RSX = (float*)(ws + WS_RSX); float* xp = out + O_YP; float* xs = out + O_YS; \
    const float* x_prompt = KPTR(const float, ap, 0); const float* x_sample = KPTR(const float, ap, 1); (void)XB; (void)RSX; (void)xp; (void)xs; (void)x_prompt; (void)x_sample;

#define S5M_LAYER(L, T0, TS) do { const float *a_re_ = KPTR(const float, ap, 10), *a_im_ = KPTR(const float, ap, 11), *ldt_ = KPTR(const float, ap, 12), *c_re_ = KPTR(const float, ap, 15), *c_im_ = KPTR(const float, ap, 16); \
    for (int id = (T0); id < 16 * 63 * 32; id += (TS)) s5_mat_T(a_re_, a_im_, ldt_, c_re_, c_im_, ws, (L) * 16 * 63 * 32 + id); \
    for (int id = (T0); id < 16 * 128 * 32; id += (TS)) s5_mat_Q(a_re_, a_im_, ldt_, ws, (L) * 16 * 128 * 32 + id); \
    for (int id = (T0); id < 16 * 32 * 16 * 16; id += (TS)) s5_mat_P(a_re_, a_im_, ldt_, c_re_, c_im_, ws, (L) * 16 * 32 * 16 * 16 + id); \
    for (int id = (T0); id < 16 * 64; id += (TS)) { const int gi_ = (L) * 16 * 64 + id; ((float2*)(ws + WS_S5 + (size_t)(gi_ >> 6) * S5_SIZE + S5_AL))[gi_ & 63] = ((const float2*)(ws + WS_APOW))[((size_t)(gi_ >> 6) * 33 + 32) * 64 + (gi_ & 63)]; } } while (0)
#ifndef REP_P0
#define REP_P0 1
#endif
#ifndef REP_P2
#define REP_P2 1
#endif
#ifndef REP_P3
#define REP_P3 1
#endif
#ifndef REP_P1
#define REP_P1 1
#endif
#ifndef REP_P5
#define REP_P5 1
#endif
#ifndef REP_GLA
#define REP_GLA 1
#endif
#ifndef REP_S5
#define REP_S5 1
#endif
#ifndef REP_PREP
#define REP_PREP 1
#endif
#ifndef REP_MISC
#define REP_MISC 1
#endif
#ifndef REP_ATTN
#define REP_ATTN 1
#endif
#ifndef REP_DEC
#define REP_DEC 1
#endif
    for (int rep_ = 0; rep_ < REP_P0; ++rep_) {
    if (rep_) xcd_barrier(bar, wave_s == 0 && lane_id() == 0);
    if (IN(0)) { PHASE_PTRS PHASE_IDS
        cvt_layer_wg(0, bx, G, tid, ldsl + RING_OFF, ws, ap);
        for (int id = gtid; id < DEPTH * 16 * 64; id += gthreads) s5_pre_item(KPTR(const float, ap, 10), KPTR(const float, ap, 11), KPTR(const float, ap, 12), KPTR(const float, ap, 13), KPTR(const float, ap, 14), ws, id >> 6, id & 63);
        for (int id = gtid; id < (SEQ + 1) * 16; id += gthreads) rope_item(ws, id);
        for (int id = gtid; id < DEPTH * 16 * 33 * 64; id += gthreads) { const int p = id & 63, tau = (id >> 6) % 33, lg = id / (33 * 64);
            ((float2*)(ws + WS_APOW))[id] = cpow_(KPTR(const float, ap, 10)[lg * 64 + p], KPTR(const float, ap, 11)[lg * 64 + p], expf(KPTR(const float, ap, 12)[lg]), tau); }
        for (int row = gw; row < M; row += ngw) xprep_row(x_prompt, XB, RSX, row, lane);
    }
    SEAM(0);
    if (IN(1)) { PHASE_PTRS PHASE_IDS
        S5M_LAYER(0, gtid, gthreads);
    }
    }

    for (int l = 0; l < DEPTH; ++l) {
        const int pb = 2 + 7 * l;
#define LAYER_PTRS PHASE_PTRS unsigned char* wl = ws + WS_W + (size_t)l * WL_SIZE; const float* xin_s = l == 0 ? x_sample : xs; (void)wl; (void)xin_s;
        for (int rep_ = 0; rep_ < REP_P1; ++rep_) { if (rep_) xcd_barrier(bar, wave_s == 0 && lane_id() == 0);
        if (IN(pb + 0)) { LAYER_PTRS
            const bool rd = G == 256; unsigned* ctl = (unsigned*)(ws + WS_CTL);
            if (rd && l > 0) wg_wait(ctl + CW_WIN + 64 * l, 384u / CVT_CH, nullptr, 0u, wave_s);
            { pg8::Gemm g{XB, (const bf16_t*)(wl + WL_IN), M, DINP, DM}; pg8::Order1 S; S.init(M, DINP, G, bx); S.redeal = rd; S.x = bx & 7; S.r = bx >> 3; S.wv = wave_s;
              S.rdy = ctl + CW_P6 + (l > 0 ? l - 1 : 0) * 64 * 64; S.need = l > 0 ? 32u : 0u;
              pg8::EpiWin E{RSX, (bf16_t*)(ws + WS_U5), (bf16_t*)(ws + WS_CQB), (float*)(ws + WS_RSCQ), (float*)(ws + WS_T2F), (bf16_t*)(ws + WS_T2B), (float*)(ws + WS_RSKV), (float*)(ws + WS_QKF), (bf16_t*)(ws + WS_GVB), (bf16_t*)(ws + WS_GRB), (LAS float*)(ldsl + XCH_OFF) + 1024};
              pg8::gemm_phase<pg8::EpiWin, pg8::Order1, true, true>(ldsl + RING_OFF, g, S, E, wave_s); }
            { PHASE_IDS float* PS = (float*)(ws + WS_PS);
              const int k0_ = rd ? bx - 128 : G - 1 - bx;
              if (rd && l > 0 && k0_ >= 0 && k0_ < DINP / 32) wg_wait(ctl + CW_S6 + 64 * (l - 1), DM / 32, nullptr, 0u, wave_s);
              for (int k = k0_; k >= 0 && k < DINP / 32; k += G)
                sgemm_wg<true, false>(xin_s, DM, (const bf16_t*)(wl + WL_IN), DM, DM, 32 * k, 0, wave, lane, (LAS float*)(ldsl + RING_OFF), [&](int row, int c, float v, float, float ssq) { PS[(size_t)row * DINP + 32 * k + c] = v * rsqrtf(ssq * (1.f / DM) + EPS); }); }
        }
        }
        SEAM(pb + 0);
        for (int rep_ = 0; rep_ < REP_P2; ++rep_) { if (rep_) xcd_barrier(bar, wave_s == 0 && lane_id() == 0);
        if (IN(pb + 1)) { LAYER_PTRS
            constexpr int NGLA = NB * GH;
            if (bx < NGLA && G > NGLA) xcd_barrier<true>(bar, wave_s == 0 && lane_id() == 0);
            if (bx >= NGLA) { pg8::Gemm g{(const bf16_t*)(ws + WS_CQB), (const bf16_t*)(wl + WL_QB), M, 768, 256}; pg8::StaticOrder S; S.init(M, 768, G - NGLA, bx - NGLA);
              pg8::EpiQ E{(const float*)(ws + WS_RSCQ), (const float*)(ws + WS_COS), (const float*)(ws + WS_SIN), (bf16_t*)(ws + WS_QN), (bf16_t*)(ws + WS_QP)};
              pg8::gemm_phase<pg8::EpiQ, pg8::StaticOrder, true, true>(ldsl + RING_OFF, g, S, E, wave_s); }
            if (bx >= NGLA) { pg8::Gemm g{(const bf16_t*)(ws + WS_T2B), (const bf16_t*)(wl + WL_KV), M, 1024, 256}; pg8::StaticOrder S; S.init(M, 1024, G - NGLA, bx - NGLA);
              pg8::EpiKV E{(const float*)(ws + WS_RSKV), (bf16_t*)(ws + WS_KN), (bf16_t*)(ws + WS_VB)};
              pg8::gemm_phase<pg8::EpiKV, pg8::StaticOrder, true, true>(ldsl + RING_OFF, g, S, E, wave_s); }
            for (int r2_ = 0; r2_ < REP_GLA; ++r2_) { PHASE_IDS for (int k = bx; k < NB * GH; k += G) { gla_task(l, k >> 2, k & 3, wave, lane, ldsl + RING_OFF, ws, out, KPTR(const float, ap, 27), KPTR(const float, ap, 25) + (size_t)l * 16 * 128, KPTR(const float, ap, 26) + l * 128);
                wg_post((unsigned*)(ws + WS_CTL) + CW_GL + (l * NB + (k >> 2)) * 64, wave_s); } }
            for (int r2_ = 0; r2_ < REP_S5 + REP_PREP - 1; ++r2_) { PHASE_IDS if (r2_ == 0 || REP_S5 > 1) for (int k = (2 * G - 33 - bx) % G; k < NB * 16; k += G) s5_task(l, k >> 4, k & 15, wave, lane, ldsl + RING_OFF, ws, out, KPTR(const float, ap, 17));
            { const SampleW sw{KPTR(const float, ap, 15), KPTR(const float, ap, 16), KPTR(const float, ap, 17), KPTR(const float, ap, 18), KPTR(const float, ap, 19), KPTR(const float, ap, 20), KPTR(const float, ap, 21), KPTR(const float, ap, 22), KPTR(const float, ap, 23), KPTR(const float, ap, 24), KPTR(const float, ap, 25), KPTR(const float, ap, 26), KPTR(const float, ap, 27), KPTR(const float, ap, 5), KPTR(const float, ap, 6)};
              if (r2_ == 0 || REP_PREP > 1) for (int b = G - 1 - bx; b < SB; b += G) sample_prep_task(l, b, tid, ldsl + RING_OFF, ws, out, sw, (const bf16_t*)(wl + WL_QB), (const bf16_t*)(wl + WL_GLU)); } }
            if (bx >= NGLA) { volatile LAS unsigned* LQ = (volatile LAS unsigned*)(ldsl + LDSCTL_OFF + 512); unsigned* q2 = (unsigned*)(ws + WS_CTL) + CW_Q2 + 64 * l;
              for (;;) {
                  if (wave_s == 0 && lane_id() == 0) LQ[1] = __hip_atomic_fetch_add(q2, 1u, __ATOMIC_RELAXED, __HIP_MEMORY_SCOPE_AGENT);
                  __syncthreads(); const unsigned blk = LQ[1]; __syncthreads();
                  if (blk >= (unsigned)(M / 32)) break;
                  { PHASE_IDS
                    misc_rows4(l, (int)blk * 32 + wave * 4, lane, ws, out, KPTR(const float, ap, 22) + l * 128); } } }
            if ((bx >= NGLA || G <= NGLA) && IN(pb + 2)) xcd_barrier<true>(bar, wave_s == 0 && lane_id() == 0);
            if (l + 1 < DEPTH && bx >= NB * GH && G > NB * GH) { PHASE_IDS const int t0_ = gtid - NB * GH * 512, ts_ = (G - NB * GH) * 512;
              if (CVT_Q0 > 0) cvt_layer_wg(l + 1, bx - NB * GH, G - NB * GH, tid, ldsl + RING_OFF, ws, ap, 0, CVT_Q0);
              S5M_LAYER(l + 1, t0_, ts_); }
        }
        }
        if (IN(pb + 1) && IN(pb + 2)) xcd_barrier_wait(bar, wave_s == 0 && lane_id() == 0);
        for (int rep_ = 0; rep_ < REP_P3; ++rep_) { if (rep_) xcd_barrier(bar, wave_s == 0 && lane_id() == 0);
        if (IN(pb + 2)) { LAYER_PTRS
            { volatile LAS unsigned* LQ = (volatile LAS unsigned*)(ldsl + LDSCTL_OFF + 512);
              unsigned* qd = (unsigned*)(ws + WS_CTL) + CW_Q3 + 128 * l; unsigned* qa = qd + 64;
              const bool dclass = ((bx >> 3) % 5) == 4;
              constexpr unsigned ND = SB * NSPLIT, NA = NB * MH * 8 + M / 256;
              for (;;) {
                  if (wave_s == 0 && lane_id() == 0) { unsigned kind = 2u, idx = 0u;
                      if (dclass) { idx = __hip_atomic_fetch_add(qd, 1u, __ATOMIC_RELAXED, __HIP_MEMORY_SCOPE_AGENT); if (idx < ND) kind = 0u; else { idx = __hip_atomic_fetch_add(qa, 1u, __ATOMIC_RELAXED, __HIP_MEMORY_SCOPE_AGENT); if (idx < NA) kind = 1u; } }
                      else { idx = __hip_atomic_fetch_add(qa, 1u, __ATOMIC_RELAXED, __HIP_MEMORY_SCOPE_AGENT); if (idx < NA) kind = 1u; else { idx = __hip_atomic_fetch_add(qd, 1u, __ATOMIC_RELAXED, __HIP_MEMORY_SCOPE_AGENT); if (idx < ND) kind = 0u; } }
                      LQ[0] = kind; LQ[1] = idx; }
                  __syncthreads();
                  const unsigned kind = LQ[0], idx = LQ[1];
                  __syncthreads();
                  if (kind == 2u) break;
                  if (kind == 0u) { PHASE_IDS sample_attn_task(l, (int)idx, tid, ldsl + RING_OFF, ws, KPTR(const float, ap, 2), KPTR(const float, ap, 3), (const int*)KPTR(const float, ap, 4), KPTR(const float, ap, 24)); }
                  else if (idx < (unsigned)(M / 256)) {
                      pg8::Gemm g{(const bf16_t*)(ws + WS_Y5), (const bf16_t*)(wl + WL_GLU), M, 256, 256}; const pg8::OneUnitPub S{(int)idx, 0, (unsigned*)(ws + WS_CTL) + CW_MX + (l * 64 + (int)idx) * 64};
                      pg8::EpiGlu E{(const bf16_t*)(ws + WS_Y5), KPTR(const float, ap, 19) + l * 256, (bf16_t*)(ws + WS_MIX)};
                      pg8::gemm_phase<pg8::EpiGlu, pg8::OneUnitPub, true, true>(ldsl + RING_OFF, g, S, E, wave_s); }
                  else { const int ia = (int)idx - M / 256, qb = 7 - (ia >> 6), bh = ia & 63;
                      attn_body::attn_unit<8>(wave_s, bh / attn_body::NHEAD, bh % attn_body::NHEAD, qb, (const attn_body::bf16*)(ws + WS_QN), (const attn_body::bf16*)(ws + WS_QP), (const attn_body::bf16*)(ws + WS_KN), (const attn_body::bf16*)(ws + WS_KP), (const attn_body::bf16*)(ws + WS_VB), (attn_body::bf16*)(ws + WS_MIX), (char*)lds + RING_OFF);
                      pg8::pub_wave((unsigned*)(ws + WS_CTL) + CW_MX + (l * 64 + (bh / attn_body::NHEAD) * 8 + qb) * 64); }
              } }
        }
        }
        if ((int)gridDim.x != 256) SEAM(pb + 2);
        if (IN(pb + 3)) { LAYER_PTRS
            const bool mrg = G == 256; unsigned* ctl = (unsigned*)(ws + WS_CTL);
            const int pm4 = 8 * (bx & 7) + 7 - (bx >> 5), pn4 = (bx >> 3) & 3;
            if (mrg) wg_wait(ctl + CW_MX + (l * 64 + pm4) * 64, 9u * 8u, ctl + CW_GL + (l * NB + (bx & 7)) * 64, (unsigned)GH, wave_s);
            { pg8::Gemm g{(const bf16_t*)(ws + WS_MIX), (const bf16_t*)(wl + WL_OUT), M, DM, DM}; pg8::Order6 S; S.init(M, DM, G, bx); S.redeal = mrg; S.pm0 = pm4; S.pn0 = pn4; S.cnt = ctl + CW_P4 + l * 64 * 64;
              pg8::EpiResidT<true> E{l == 0 ? x_prompt : nullptr, XB, RSX};
              pg8::gemm_phase<pg8::EpiResidT<true>, pg8::Order6, true, true>(ldsl + RING_OFF, g, S, E, wave_s); }
            if (l + 1 < DEPTH) { volatile LAS unsigned* LQ = (volatile LAS unsigned*)(ldsl + LDSCTL_OFF + 512); unsigned* qc = ctl + CW_Q3 + 128 * l + 32;
              constexpr unsigned NC = (CVT_TILES_PER_LAYER - CVT_Q0 + CVT_CH - 1) / CVT_CH;
              for (;;) {
                  if (wave_s == 0 && lane_id() == 0) LQ[1] = __hip_atomic_fetch_add(qc, 1u, __ATOMIC_RELAXED, __HIP_MEMORY_SCOPE_AGENT);
                  __syncthreads(); const unsigned idx = LQ[1]; __syncthreads();
                  if (idx >= NC) break;
                  { PHASE_IDS const int tb_ = CVT_Q0 + CVT_CH * (int)idx; cvt_layer_wg(l + 1, 0, 1, tid, ldsl + RING_OFF, ws, ap, tb_, tb_ + CVT_CH < CVT_TILES_PER_LAYER ? tb_ + CVT_CH : CVT_TILES_PER_LAYER); }
                  if (mrg && CVT_CH * (idx + 1) <= 384u) wg_post(ctl + CW_WIN + 64 * (l + 1), wave_s); } }
            if (mrg && G - 1 - bx < DM / 32) wg_wait(ctl + CW_DR + 64 * l, (unsigned)SB, nullptr, 0u, wave_s);
            { PHASE_IDS for (int k = G - 1 - bx; k < DM / 32; k += G) {
                sgemm_wg<false, false>(ws + WS_MIXS, DM, (const bf16_t*)(wl + WL_OUT), DM, DM, 32 * k, 0, wave, lane, (LAS float*)(ldsl + RING_OFF), [&](int row, int c, float v, float, float) { const size_t o = (size_t)row * DM + 32 * k + c; xs[o] = xin_s[o] + v; });
                if (mrg) wg_post(ctl + CW_S4 + 64 * l, wave_s); } }
        }
        if ((int)gridDim.x != 256) SEAM(pb + 3);
        for (int rep_ = 0; rep_ < REP_P5; ++rep_) { if (rep_) xcd_barrier(bar, wave_s == 0 && lane_id() == 0);
        if (IN(pb + 4)) { LAYER_PTRS
            const bool rd = G == 256; unsigned* ctl = (unsigned*)(ws + WS_CTL);
            if (rd) wg_wait8(ctl + CW_P4 + (l * 64 + 8 * (bx & 7)) * 64, 4u * 8u, wave_s);
            { pg8::Gemm g{XB, (const bf16_t*)(wl + WL_FFI), M, DFF2, DM}; pg8::Order5 S; S.init(M, DFF2, G, bx); S.redeal = rd; S.x = bx & 7; S.r = bx >> 3; S.grp = ctl + CW_G5 + l * 16 * 64;
              pg8::EpiFfi E{RSX, KPTR(const float, ap, 31) + (size_t)l * 3 * DFF, KPTR(const float, ap, 32) + (size_t)l * DFF, (bf16_t*)(ws + WS_H), (float*)(ws + WS_FV), (float*)(ws + WS_FG), (float*)(ws + WS_LG), out + O_CONVP + (size_t)l * NB * 2 * DFF, (LAS float*)(ldsl + XCH_OFF)};
              pg8::gemm_phase<pg8::EpiFfi, pg8::Order5, true, true>(ldsl + RING_OFF, g, S, E, wave_s); }
            { PHASE_IDS const float* cw = KPTR(const float, ap, 31) + (size_t)l * 3 * DFF; const float* cbs = KPTR(const float, ap, 32) + (size_t)l * DFF; const float* stc = KPTR(const float, ap, 7) + (size_t)l * SB * 2 * DFF;
              bf16_t* HS = (bf16_t*)(ws + WS_HS); float* oc = out + O_CONVS + (size_t)l * SB * 2 * DFF;
              if (rd && G - 1 - bx < DFF / 32) wg_wait(ctl + CW_S4 + 64 * l, DM / 32, nullptr, 0u, wave_s);
              for (int k = G - 1 - bx; k < DFF / 32; k += G) { const int pv = 256 * (k >> 2) + 32 * (k & 3);
                sgemm_wg<true, true>(xs, DM, (const bf16_t*)(wl + WL_FFI), DM, DM, pv, pv + 128, wave, lane, (LAS float*)(ldsl + RING_OFF), [&](int row, int cc, float v, float gt, float ssq) {
                    const float r = rsqrtf(ssq * (1.f / DM) + EPS); const int c = 32 * k + cc; const float g0 = gt * r, b0 = stc[((size_t)row * 2 + 0) * DFF + c], b1 = stc[((size_t)row * 2 + 1) * DFF + c];
                    const float conv = cbs[c] + cw[c] * b0 + cw[DFF + c] * b1 + cw[2 * DFF + c] * g0;
                    HS[(size_t)row * DFF + c] = f2bf(gelu_tanh(conv) * v * r); oc[((size_t)row * 2 + 0) * DFF + c] = b1; oc[((size_t)row * 2 + 1) * DFF + c] = g0; });
                if (rd) wg_post(ctl + CW_S5 + 64 * l, wave_s); } }
        }
        }
        if ((int)gridDim.x != 256) SEAM(pb + 4);
        if (IN(pb + 6)) { LAYER_PTRS
            const bool rd = G == 256; unsigned* ctl = (unsigned*)(ws + WS_CTL);
            const int r6_ = bx >> 3, g6_ = r6_ >= 16 ? 0 : 1, j6_ = r6_ & 15, pm6 = 8 * (bx & 7) + 4 * g6_ + (j6_ & 3), pn6 = j6_ >> 2;
            if (rd) wg_wait(ctl + CW_G5 + (l * 16 + 2 * (bx & 7) + g6_) * 64, 88u * 8u, g6_ ? ctl + CW_G5 + (l * 16 + 2 * (bx & 7)) * 64 : nullptr, 88u * 8u, wave_s);
            { PHASE_IDS const float* cw = KPTR(const float, ap, 31) + (size_t)l * 3 * DFF; const float* cbs = KPTR(const float, ap, 32) + (size_t)l * DFF;
              const float* FV = (const float*)(ws + WS_FV); const float* FG = (const float*)(ws + WS_FG); const float* LG = (const float*)(ws + WS_LG); bf16_t* H = (bf16_t*)(ws + WS_H);
#pragma unroll 1
              for (int i = 0;; ++i) { const int pm = __builtin_amdgcn_readfirstlane(rd ? (i == 0 ? pm6 : -1) : pg8::static_pm(M, DM, G, bx, i)); if (pm < 0) break; const bool first = (pm & 7) == 0;
#pragma unroll
                  for (int k = 0; k < 2 * DFF / 512; ++k) { const int id = tid + 512 * k, rr = id >= DFF ? 1 : 0, c = id - rr * DFF;
                      const float g0 = FG[((size_t)pm * 2 + rr) * DFF + c], lg1 = first ? 0.f : LG[((size_t)(pm - 1) * 2 + 1) * DFF + c], lg0 = first ? 0.f : LG[((size_t)(pm - 1) * 2 + 0) * DFF + c];
                      const float gm1 = rr == 1 ? FG[((size_t)pm * 2 + 0) * DFF + c] : lg1, gm2 = rr == 1 ? lg1 : lg0;
                      const float conv = cbs[c] + cw[c] * gm2 + cw[DFF + c] * gm1 + cw[2 * DFF + c] * g0;
                      H[((size_t)pm * 256 + rr) * DFF + c] = f2bf(gelu_tanh(conv) * FV[((size_t)pm * 2 + rr) * DFF + c]); } }
              __syncthreads(); }
            { pg8::Gemm g{(const bf16_t*)(ws + WS_H), (const bf16_t*)(wl + WL_FFO), M, DM, DFF}; pg8::Order6 S; S.init(M, DM, G, bx); S.redeal = rd; S.pm0 = pm6; S.pn0 = pn6; S.cnt = ctl + CW_P6 + l * 64 * 64;
              pg8::EpiResidT<true> E{nullptr, XB, RSX};
              pg8::gemm_phase<pg8::EpiResidT<true>, pg8::Order6, true, true>(ldsl + RING_OFF, g, S, E, wave_s); }
            { PHASE_IDS const int k0_ = rd ? bx - 128 : G - 1 - bx;
              if (rd && k0_ >= 0 && k0_ < DM / 32) wg_wait(ctl + CW_S5 + 64 * l, DFF / 32, nullptr, 0u, wave_s);
              for (int k = k0_; k >= 0 && k < DM / 32; k += G) {
                sgemm_wg<false, false>(ws + WS_HS, DFF, (const bf16_t*)(wl + WL_FFO), DFF, DFF, 32 * k, 0, wave, lane, (LAS float*)(ldsl + RING_OFF), [&](int row, int c, float v, float, float) { xs[(size_t)row * DM + 32 * k + c] += v; });
                if (rd) wg_post(ctl + CW_S6 + 64 * l, wave_s); } }
        }
        if ((int)gridDim.x != 256) SEAM(pb + 6);
    }
    if (IN(N_PHASES - 1)) { PHASE_PTRS PHASE_IDS
        const float* g = KPTR(const float, ap, 34);
        const bool mrg = G == 256; unsigned* ctl = (unsigned*)(ws + WS_CTL);
        const int r6_ = bx >> 3, g6_ = r6_ >= 16 ? 0 : 1, j6_ = r6_ & 15, rb_ = 256 * (8 * (bx & 7) + 4 * g6_ + (j6_ & 3)) + 64 * (j6_ >> 2) + 8 * wave;
        if (mrg) wg_wait(ctl + CW_P6 + ((DEPTH - 1) * 64 + (rb_ >> 8)) * 64, 4u * 8u, bx < 4 ? ctl + CW_S6 + 64 * (DEPTH - 1) : nullptr, DM / 32, wave_s);
        const int nit_ = mrg ? (bx < 4 ? 5 : 4) : (M + SB - gw + 2 * ngw - 1) / (2 * ngw);
#pragma unroll 1
        for (int it_ = 0; it_ < nit_; ++it_) {
            f32x4 v[2][4]; float s2[2] = {0.f, 0.f};
            const int rowA_ = mrg ? (it_ < 4 ? rb_ + 2 * it_ : M + 8 * bx + wave) : gw + 2 * it_ * ngw, rowB_ = mrg ? (it_ < 4 ? rowA_ + 1 : M + SB) : rowA_ + ngw;
#pragma unroll
            for (int q = 0; q < 2; ++q) { const int row = q ? rowB_ : rowA_;
                if (row < M) {
#pragma unroll
                    for (int j2 = 0; j2 < 4; ++j2) { const u32x2 w = *(const u32x2*)(XB + (size_t)row * DM + 256 * j2 + 4 * lane); v[q][j2] = pg8::unpk_lo(w.x, w.y); }
                } else if (row < M + SB) {
#pragma unroll
                    for (int j2 = 0; j2 < 4; ++j2) v[q][j2] = *(const f32x4*)(xs + (size_t)(row - M) * DM + 256 * j2 + 4 * lane);
                } else {
#pragma unroll
                    for (int j2 = 0; j2 < 4; ++j2) v[q][j2] = (f32x4){0.f, 0.f, 0.f, 0.f}; } }
#pragma unroll
            for (int q = 0; q < 2; ++q) { const int row = q ? rowB_ : rowA_;
#pragma unroll
                for (int j2 = 0; j2 < 4; ++j2) s2[q] += (v[q][j2].x * v[q][j2].x + v[q][j2].y * v[q][j2].y) + (v[q][j2].z * v[q][j2].z + v[q][j2].w * v[q][j2].w);
                const float r = rsqrtf(wave_sum(s2[q]) * (1.f / DM) + EPS);
                if (row < M + SB) { float* yo = row < M ? xp + (size_t)row * DM : xs + (size_t)(row - M) * DM;
#pragma unroll
                    for (int j2 = 0; j2 < 4; ++j2) { const f32x4 gg = *(const f32x4*)(g + 256 * j2 + 4 * lane); *(f32x4*)(yo + 256 * j2 + 4 * lane) = v[q][j2] * r * gg; } } }
        }
    }
#undef IN
#undef SEAM
}

#include <string.h>
extern "C" void kernel_launch(void* const* d_in, const int* in_sizes, int n_in, void* d_out, int out_size, void* d_ws, size_t ws_size, hipStream_t stream) {
    static int grid = 0;
    if (grid == 0) {
        if (n_in != 35 || (size_t)out_size != O_END || ws_size < WS_END) { fprintf(stderr, "kernel_launch: unexpected sizes n_in %d out %d ws %zu (need %zu)\n", n_in, out_size, ws_size, (size_t)WS_END); grid = -1; return; }
        int dev = 0, cus = 0, per_cu = 0;
        if (hipGetDevice(&dev) != hipSuccess || hipDeviceGetAttribute(&cus, hipDeviceAttributeMultiprocessorCount, dev) != hipSuccess) { grid = -1; return; }
        if (hipFuncSetAttribute((const void*)mk_fwd, hipFuncAttributeMaxDynamicSharedMemorySize, LDS_BYTES) != hipSuccess) { fprintf(stderr, "kernel_launch: hipFuncSetAttribute failed\n"); grid = -1; return; }
        if (hipOccupancyMaxActiveBlocksPerMultiprocessor(&per_cu, (const void*)mk_fwd, 512, LDS_BYTES) != hipSuccess || per_cu < 1) fprintf(stderr, "kernel_launch: occupancy query reports %d\n", per_cu);
        (void)hipGetLastError();
        grid = cus;
    }
    if (grid < 0) return;
    if (hipMemsetAsync((char*)d_ws + WS_CTL, 0, CTL_BYTES, stream) != hipSuccess) { fprintf(stderr, "kernel_launch: memset failed\n"); return; }
    MKArgs a; memset(&a, 0, sizeof a);
    for (int i = 0; i < 35; ++i) a.in[i] = (const float*)d_in[i];
    a.out = (float*)d_out; a.ws = (unsigned char*)d_ws;
    const int nl = MK_CUT ? N_PHASES : 1;
    for (int li = 0; li < nl; ++li) {
        a.ph_lo = MK_CUT ? li : 0; a.ph_hi = MK_CUT ? li + 1 : N_PHASES; a.li = li;
        hipLaunchKernelGGL(mk_fwd, dim3(grid), dim3(512), LDS_BYTES, stream, a);
        const hipError_t le = hipPeekAtLastError();
        if (le != hipSuccess) { fprintf(stderr, "kernel_launch: launch %d failed: %s\n", li, hipGetErrorName(le)); break; }
    }
}
```

```cpp
#include <hip/hip_runtime.h>
#include <stdint.h>
#include <stddef.h>
#include <stdio.h>
#include <math.h>

#define DEV __device__ __forceinline__
typedef unsigned short bf16_t;
typedef short bf16x8 __attribute__((ext_vector_type(8)));
typedef float f32x4 __attribute__((ext_vector_type(4)));
typedef float f32x16 __attribute__((ext_vector_type(16)));
typedef unsigned u32x4 __attribute__((ext_vector_type(4)));
typedef unsigned u32x2 __attribute__((ext_vector_type(2)));

constexpr int DM = 1024, NB = 8, SEQ = 2048, M = NB * SEQ, DEPTH = 4, SB = 32, PAST = 16384, PAGE = 128, NPAGES = 128, NPOOL = 5120;
constexpr int DIN = 1456, DINP = 1536;
constexpr int S5G = 16, S5P = 64;
constexpr int MH = 8, QL = 256, KVL = 128, ROPE = 32;
constexpr int GH = 4, GDK = 32, GDV = 64;
constexpr int DFF = 2816, DFF2 = 5632;
constexpr float EPS = 1e-6f;
constexpr float QSCALE = 0.10206207261596575f * 1.4426950408889634f;
constexpr int NSPLIT = 8, KPS = PAST / NSPLIT;

constexpr size_t O_YP = 0, O_YS = O_YP + (size_t)M * DM, O_CKVP = O_YS + (size_t)SB * DM, O_KRP = O_CKVP + (size_t)DEPTH * M * KVL,
    O_S5P = O_KRP + (size_t)DEPTH * M * ROPE, O_GLAP = O_S5P + (size_t)DEPTH * NB * S5G * S5P * 2, O_CONVP = O_GLAP + (size_t)DEPTH * NB * GH * GDK * GDV,
    O_CKVS = O_CONVP + (size_t)DEPTH * NB * 2 * DFF, O_KRS = O_CKVS + (size_t)DEPTH * SB * KVL, O_S5S = O_KRS + (size_t)DEPTH * SB * ROPE,
    O_GLAS = O_S5S + (size_t)DEPTH * SB * S5G * S5P * 2, O_CONVS = O_GLAS + (size_t)DEPTH * SB * GH * GDK * GDV, O_END = O_CONVS + (size_t)DEPTH * SB * 2 * DFF;

constexpr size_t al(size_t x) { return (x + 255) & ~(size_t)255; }
constexpr size_t WS_CTL = 0, CTL_BYTES = 1 << 20;
constexpr size_t WL_IN = 0, WL_QB = WL_IN + (size_t)DINP * DM * 2, WL_KV = WL_QB + (size_t)768 * 256 * 2, WL_GLU = WL_KV + (size_t)1024 * 256 * 2,
    WL_OUT = WL_GLU + (size_t)256 * 256 * 2, WL_FFI = WL_OUT + (size_t)DM * DM * 2, WL_FFO = WL_FFI + (size_t)DFF2 * DM * 2, WL_SIZE = WL_FFO + (size_t)DM * DFF * 2;
constexpr size_t WS_W = WS_CTL + CTL_BYTES;
constexpr size_t S5_ABAR = 0, S5_BBAR = 512, S5_AL = 8704, S5_TQ = 9216, S5_P = S5_TQ + (size_t)640 * 512 * 2, S5_SIZE = S5_P + (size_t)512 * 128 * 2;
constexpr size_t WS_S5 = al(WS_W + DEPTH * WL_SIZE);
constexpr size_t WS_COS = al(WS_S5 + (size_t)DEPTH * S5G * S5_SIZE), WS_SIN = WS_COS + (size_t)(SEQ + 1) * 16 * 4;
constexpr size_t WS_APOW = al(WS_SIN + (size_t)(SEQ + 1) * 16 * 4);
constexpr size_t WS_XB = al(WS_APOW + (size_t)DEPTH * 16 * 33 * 64 * 8);
constexpr size_t WS_RSX = al(WS_XB + (size_t)M * DM * 2);
constexpr size_t WS_U5 = al(WS_RSX + (size_t)M * 64);
constexpr size_t WS_CQB = al(WS_U5 + (size_t)M * 256 * 2);
constexpr size_t WS_RSCQ = al(WS_CQB + (size_t)M * 256 * 2);
constexpr size_t WS_T2B = al(WS_RSCQ + (size_t)M * 16);
constexpr size_t WS_RSKV = al(WS_T2B + (size_t)M * 256 * 2);
constexpr size_t WS_QKF = al(WS_RSKV + (size_t)M * 16);
constexpr size_t WS_GLG = al(WS_QKF + (size_t)M * 256 * 4);
constexpr size_t WS_GVB = al(WS_GLG + (size_t)M * 128 * 4);
constexpr size_t WS_GRB = al(WS_GVB + (size_t)M * 256 * 2);
constexpr size_t WS_QN = al(WS_GRB + (size_t)M * 256 * 2);
constexpr size_t WS_QP = al(WS_QN + (size_t)M * 512 * 2);
constexpr size_t WS_KN = al(WS_QP + (size_t)M * 256 * 2);
constexpr size_t WS_KP = al(WS_KN + (size_t)M * 512 * 2);
constexpr size_t WS_VB = al(WS_KP + (size_t)M * 32 * 2);
constexpr size_t WS_Y5 = al(WS_VB + (size_t)M * 512 * 2);
constexpr size_t WS_MIX = al(WS_Y5 + (size_t)M * 256 * 2);
constexpr size_t WS_H = al(WS_MIX + (size_t)M * DM * 2);
constexpr size_t WS_XSB = al(WS_H + (size_t)M * DFF * 2);
constexpr size_t WS_RSXS = al(WS_XSB + (size_t)SB * DM * 2);
constexpr size_t WS_PS = al(WS_RSXS + (size_t)SB * 16);
constexpr size_t WS_QLAT = al(WS_PS + (size_t)SB * DINP * 4);
constexpr size_t WS_KVNEW = al(WS_QLAT + (size_t)SB * MH * 160 * 4);
constexpr size_t WS_MIXS = al(WS_KVNEW + (size_t)SB * 160 * 4);
constexpr size_t WS_OP = al(WS_MIXS + (size_t)SB * DM * 2);
constexpr size_t WS_ML = al(WS_OP + (size_t)DEPTH * SB * NSPLIT * MH * 128 * 4);
constexpr size_t WS_HVS = al(WS_ML + (size_t)DEPTH * SB * NSPLIT * MH * 2 * 4);
constexpr size_t WS_HS = al(WS_HVS + (size_t)SB * DFF2 * 4);
constexpr size_t WS_T2F = al(WS_HS + (size_t)SB * DFF * 2);
constexpr size_t WS_HB = al(WS_T2F + (size_t)M * 256 * 4);
constexpr size_t WS_HV = al(WS_HB + (size_t)M * 1024 * 8);
constexpr size_t WS_FV = WS_HV, WS_FG = WS_HV + (2u << 20), WS_LG = WS_HV + (4u << 20);
constexpr size_t WS_END = al(WS_HV + (size_t)M * DFF2 * 4);

DEV bf16_t f2bf(float f) { unsigned u = __float_as_uint(f); u += 0x7fffu + ((u >> 16) & 1u); return (bf16_t)(u >> 16); }
DEV float bf2f(bf16_t h) { return __uint_as_float((unsigned)h << 16); }
DEV unsigned pk2(float lo, float hi) { return (unsigned)f2bf(lo) | ((unsigned)f2bf(hi) << 16); }
DEV int lane_id() { int l; asm volatile("v_mbcnt_lo_u32_b32 %0, -1, 0\n\tv_mbcnt_hi_u32_b32 %0, -1, %0" : "=v"(l)); return l; }
DEV float shfl_xor_(float v, int m) { return __builtin_bit_cast(float, __builtin_amdgcn_ds_bpermute((lane_id() ^ m) << 2, __builtin_bit_cast(int, v))); }
DEV float shfl_(float v, int src) { return __builtin_bit_cast(float, __builtin_amdgcn_ds_bpermute(src << 2, __builtin_bit_cast(int, v))); }
DEV float wave_sum(float v) {
#pragma unroll
    for (int o = 1; o < 64; o <<= 1) v += shfl_xor_(v, o);
    return v;
}
DEV float wave_max(float v) {
#pragma unroll
    for (int o = 1; o < 64; o <<= 1) v = fmaxf(v, shfl_xor_(v, o));
    return v;
}
DEV float fexp2(float x) { return __builtin_amdgcn_exp2f(x); }
DEV float fexp(float x) { return __builtin_amdgcn_exp2f(1.4426950408889634f * x); }
DEV float sigmoidf_(float x) { return __builtin_amdgcn_rcpf(1.f + fexp(-x)); }
DEV float gelu_tanh(float x) { const float u = 0.7978845608028654f * (x + 0.044715f * x * x * x); return x * sigmoidf_(2.f * u); }
DEV float log_sigmoid(float x) { return fminf(x, 0.f) - 0.6931471805599453f * __builtin_amdgcn_logf(1.f + fexp(-fabsf(x))); }
DEV void lds_barrier() { asm volatile("s_waitcnt lgkmcnt(0)" ::: "memory"); __builtin_amdgcn_s_barrier(); asm volatile("" ::: "memory"); }
DEV int crow(int r, int hi) { return (r & 3) + 8 * (r >> 2) + 4 * hi; }
DEV float rs4(const float* p, float inv_n) { const f32x4 v = *(const f32x4*)p; return rsqrtf(((v.x + v.y) + (v.z + v.w)) * inv_n + EPS); }

DEV int colmap_win(int n) {
    const int t = n >> 8, c = n & 255;
    switch (t) {
        case 0: return c;
        case 1: return 256 + c;
        case 2: return c < 128 ? 512 + c : (c < 160 ? 640 + (c - 128) : (c < 176 ? 1184 + (c - 160) : -1));
        case 3: return c < 128 ? 672 + c : 800 + (c - 128);
        case 4: return 928 + c;
        default: return 1200 + c;
    }
}
DEV int rope_logical(int j) { return ((j >> 2) & 1) * 16 + 4 * (j >> 3) + (j & 3); }
DEV int rope_phys(int lg) { const int nn = lg >> 4, i = lg & 15; return 8 * (i >> 2) + 4 * nn + (i & 3); }
DEV int colmap_qb(int n) {
    if (n < 512) return (n >> 6) * 96 + (n & 63);
    const int c = n - 512, h = c >> 5, j = c & 31; return h * 96 + 64 + rope_logical(j);
}
DEV int colmap_ffi(int n) { const int j = n >> 8, r = n & 255; return r < 128 ? 128 * j + r : DFF + 128 * j + (r - 128); }


namespace pg8 {
#define PG8_LAS __attribute__((address_space(3)))
typedef unsigned short bf16_t;
typedef short bf16x8 __attribute__((ext_vector_type(8)));
typedef float f32x4 __attribute__((ext_vector_type(4)));
typedef unsigned u32x4 __attribute__((ext_vector_type(4)));
constexpr int BM = 256, BK = 64, HALF = 128, HTB = HALF * BK * 2  , STAGE_BYTES = 8 * HTB, NXCD = 8, WGM = 8;

__host__ __device__ __forceinline__ int lds_byte(int r, int c) { const int st = (r >> 4) * 2 + (c >> 5), rr = r & 15, cc = c & 31, ob = rr * 64 + cc * 2; return st * 1024 + (ob ^ (((ob >> 9) & 1) << 5)); }
__host__ __device__ __forceinline__ void stage_rc(int b, int& R, int& C) { const int st = b / 1024, sb = b % 1024, swz = sb ^ (((sb >> 9) & 1) << 5); R = (st >> 1) * 16 + swz / 64; C = (st & 1) * 32 + (swz % 64) / 2; }
__host__ __device__ __forceinline__ int perm32(int rho) { const int n = rho >> 4, i = rho & 15; return 8 * (i >> 2) + 4 * n + (i & 3); }

struct Unit { int pm, pn; };
struct Gemm { const bf16_t* A; const bf16_t* Bt; int M, N, K; };

struct StaticOrder {
    int nM, nN, nwg, G, c;
    __host__ __device__ void init(int M, int N, int G_, int c_) { nM = M / BM; nN = N / BM; nwg = nM * nN; G = G_; c = c_; }
    __host__ __device__ bool next(int i, Unit& u) const {
        const long L = (long)i * G + c; if (L >= nwg) return false;
        int wgid = (int)L; { const int q = nwg / NXCD, r = nwg % NXCD, xcd = wgid % NXCD, off = wgid / NXCD; wgid = (xcd < r ? xcd * (q + 1) : r * (q + 1) + (xcd - r) * q) + off; }
        const int nig = WGM * nN, gid = wgid / nig, fm = gid * WGM, gsz = (nM - fm) < WGM ? (nM - fm) : WGM;
        u.pm = fm + ((wgid % nig) % gsz); u.pn = (wgid % nig) / gsz; return true;
    }
    __device__ __forceinline__ void a_ready(const Unit&) const {}
    __device__ __forceinline__ void done(const Unit&) const {}
};

__device__ __forceinline__ int static_pm(int M, int N, int G, int c, int i) {
    const int nM = M / BM, nN = N / BM, nwg = nM * nN; const long L = (long)i * G + c; if (L >= nwg) return -1;
    int wgid = (int)L; { const int q = nwg / NXCD, r = nwg % NXCD, xcd = wgid % NXCD, off = wgid / NXCD; wgid = (xcd < r ? xcd * (q + 1) : r * (q + 1) + (xcd - r) * q) + off; }
    const int nig = WGM * nN, gid = wgid / nig, fm = gid * WGM, gsz = (nM - fm) < WGM ? (nM - fm) : WGM;
    return fm + ((wgid % nig) % gsz);
}
__device__ __forceinline__ void st16_wt(void* p, u32x4 v) { asm volatile("global_store_dwordx4 %0, %1, off sc1\n\ts_nop 1" :: "v"(p), "v"(v) : "memory"); }
__device__ __forceinline__ void st16_wt(void* p, f32x4 v) { asm volatile("global_store_dwordx4 %0, %1, off sc1\n\ts_nop 1" :: "v"(p), "v"(v) : "memory"); }
__device__ __forceinline__ void st4_wt(float* p, float v) { asm volatile("global_store_dword %0, %1, off sc1\n\ts_nop 1" :: "v"(p), "v"(v) : "memory"); }
__device__ __forceinline__ void pub_wave(unsigned* cnt) { asm volatile("s_waitcnt vmcnt(0)" ::: "memory"); if (lane_id() == 0) __hip_atomic_fetch_add(cnt, 1u, __ATOMIC_RELAXED, __HIP_MEMORY_SCOPE_AGENT); }
__device__ __forceinline__ void poll_ge(const unsigned* cnt, unsigned need) {
    unsigned sp = 0;
    while ((unsigned)__builtin_amdgcn_readfirstlane((int)__hip_atomic_load((unsigned*)cnt, __ATOMIC_RELAXED, __HIP_MEMORY_SCOPE_AGENT)) < need) { __builtin_amdgcn_s_sleep(2); if (++sp > (1u << 22)) break; }
}
__device__ __forceinline__ void acq_agent() { __builtin_amdgcn_fence(__ATOMIC_ACQUIRE, "agent"); asm volatile("s_waitcnt vmcnt(0)" ::: "memory"); }
struct Order5 : StaticOrder { int redeal, x, r; unsigned* grp;
    __device__ __forceinline__ bool next(int i, Unit& u) const { if (!redeal) return StaticOrder::next(i, u);
        const int E = r + 32 * i; if (E >= 176) return false; const int g = E >= 88 ? 1 : 0, e = E - 88 * g; u.pm = 8 * x + 4 * g + (e & 3); u.pn = e >> 2; return true; }
    __device__ __forceinline__ void a_ready(const Unit&) const {}
    __device__ __forceinline__ void done(const Unit& u) const { if (redeal) pub_wave(grp + (u.pm >> 2) * 64); }
};
struct Order6 : StaticOrder { int redeal, pm0, pn0; unsigned* cnt;
    __device__ __forceinline__ bool next(int i, Unit& u) const { if (!redeal) return StaticOrder::next(i, u); if (i != 0) return false; u.pm = pm0; u.pn = pn0; return true; }
    __device__ __forceinline__ void a_ready(const Unit&) const {}
    __device__ __forceinline__ void done(const Unit& u) const { if (redeal && cnt) pub_wave(cnt + u.pm * 64); }
};
struct Order1 : StaticOrder { int redeal, x, r, wv; const unsigned* rdy; unsigned need;
    __device__ __forceinline__ bool next(int i, Unit& u) const { if (!redeal) return StaticOrder::next(i, u);
        int g, j;
        if (r >= 24) { if (i == 0) { g = 0; j = r - 8; } else if (i == 1) { g = 1; j = r - 24; } else return false; }
        else if (r >= 16) { if (i > 1) return false; g = 0; j = r - 16 + 8 * i; }
        else { if (i > 0) return false; g = 1; j = 8 + r; }
        u.pm = 8 * x + 4 * g + (j & 3); u.pn = j >> 2; return true; }
    __device__ __forceinline__ void a_ready(const Unit& u) const {
        if (redeal) { if (wv == 0 && need) { poll_ge(rdy + u.pm * 64, need); acq_agent(); }
            asm volatile("" ::: "memory"); __builtin_amdgcn_s_barrier(); asm volatile("" ::: "memory"); } }
    __device__ __forceinline__ void done(const Unit&) const {}
};

__device__ __forceinline__ unsigned cvt_pk_bf16(float lo, float hi) { unsigned r; asm volatile("v_cvt_pk_bf16_f32 %0, %1, %2" : "=v"(r) : "v"(lo), "v"(hi)); return r; }
typedef float f32x2 __attribute__((ext_vector_type(2)));

template <class Epi, class Sched, bool ALIGN_EPI = false, bool SP2 = false>
__device__ __forceinline__ void gemm_phase(PG8_LAS unsigned char* lds, const Gemm g, const Sched& S, const Epi& E, const int wave_id  ) {
    int tid_l = wave_id * 64 + lane_id(); asm volatile("" : "+v"(tid_l));
    const int tid = tid_l, wid = __builtin_amdgcn_readfirstlane(tid >> 6), lane = tid & 63, wr = wid >> 2, wc = wid & 3, fr = lane & 15, fq = lane >> 4;
    const int K = g.K, nt = K / BK;
    unsigned voffA[2], voffB[2];
#pragma unroll
    for (int i = 0; i < 2; ++i) { int R, C; stage_rc(tid * 16 + i * 8192, R, C); const int Rb = Epi::PERM ? ((R & ~31) + perm32(R & 31)) : R;
        voffA[i] = (unsigned)(R * K + C) * 2u; voffB[i] = (unsigned)(Rb * K + C) * 2u; }
    const size_t kstep = (size_t)(BK * 2);
    const size_t hstep = (size_t)HALF * K * 2;
    const size_t tstep = 2 * hstep;
    const unsigned ldsw = (unsigned)wid * 1024u;
    const int aoff = lds_byte(wr * 64 + fr, fq * 8), boff = lds_byte(wc * 32 + fr, fq * 8);
#define PG8_SA(b, h) (((b) * 2 + (h)) * HTB)
#define PG8_SB(b, h) ((4 + (b) * 2 + (h)) * HTB)
#define PG8_STAGE(bufoff, gbase, voff) do { _Pragma("unroll") for (int _i = 0; _i < 2; ++_i) \
        __builtin_amdgcn_global_load_lds((const unsigned*)((const char*)(gbase) + (voff)[_i]), (PG8_LAS unsigned*)(lds + (bufoff) + ldsw + _i * 8192), 16, 0, 0); } while (0)
#define PG8_LDA(dst, b, h) do { _Pragma("unroll") for (int m = 0; m < 4; ++m) _Pragma("unroll") for (int k = 0; k < 2; ++k) dst[m][k] = *(const PG8_LAS bf16x8*)(lds + PG8_SA(b, h) + aoff + m * 2048 + k * 1024); } while (0)
#define PG8_LDB(dst, b, h) do { _Pragma("unroll") for (int n = 0; n < 2; ++n) _Pragma("unroll") for (int k = 0; k < 2; ++k) dst[n][k] = *(const PG8_LAS bf16x8*)(lds + PG8_SB(b, h) + boff + n * 2048 + k * 1024); } while (0)
#define PG8_MMA(ai, bj, At, Bt) do { __builtin_amdgcn_s_setprio(1); _Pragma("unroll") for (int m = 0; m < 4; ++m) _Pragma("unroll") for (int n = 0; n < 2; ++n) _Pragma("unroll") for (int k = 0; k < 2; ++k) \
        acc[ai][bj][m][n] = __builtin_amdgcn_mfma_f32_16x16x32_bf16(Bt[n][k], At[m][k], acc[ai][bj][m][n], 0, 0, 0); __builtin_amdgcn_s_setprio(0); } while (0)
#define PG8_WAIT_V(n) asm volatile("s_waitcnt vmcnt(" #n ")" ::: "memory")
#define PG8_WAIT_L(n) asm volatile("s_waitcnt lgkmcnt(" #n ")" ::: "memory")
#define PG8_BAR __builtin_amdgcn_s_barrier()
#define PG8_SCHED __builtin_amdgcn_sched_barrier(0)
    Unit cur, nxt; int ui = 0;
    if (!S.next(0, cur)) return;
    f32x4 acc[2][2][4][2];
#pragma unroll
    for (int a = 0; a < 2; ++a)
#pragma unroll
        for (int b = 0; b < 2; ++b)
#pragma unroll
            for (int m = 0; m < 4; ++m)
#pragma unroll
                for (int n = 0; n < 2; ++n) acc[a][b][m][n] = (f32x4){0.f, 0.f, 0.f, 0.f};
    bf16x8 At[4][2], B0[2][2], B1[2][2];
    const char* cA = (const char*)g.A + (size_t)cur.pm * tstep; const char* cB = (const char*)g.Bt + (size_t)cur.pn * tstep;
    S.a_ready(cur);
    if constexpr (SP2) {
        PG8_STAGE(PG8_SB(0, 0), cB, voffB); PG8_STAGE(PG8_SB(0, 1), cB + hstep, voffB); PG8_STAGE(PG8_SA(0, 0), cA, voffA); PG8_STAGE(PG8_SA(0, 1), cA + hstep, voffA);
        if (wr == 1) PG8_BAR;
        PG8_WAIT_V(2); PG8_BAR;
        PG8_STAGE(PG8_SB(1, 0), cB + kstep, voffB); PG8_STAGE(PG8_SA(1, 0), cA + kstep, voffA); PG8_STAGE(PG8_SB(1, 1), cB + hstep + kstep, voffB);
        PG8_WAIT_V(6); PG8_BAR;
    } else {
        PG8_STAGE(PG8_SB(0, 0), cB, voffB); PG8_STAGE(PG8_SA(0, 0), cA, voffA); PG8_STAGE(PG8_SB(0, 1), cB + hstep, voffB); PG8_STAGE(PG8_SA(0, 1), cA + hstep, voffA);
        if (wr == 1) PG8_BAR;
        PG8_WAIT_V(4); PG8_BAR;
        PG8_STAGE(PG8_SB(1, 0), cB + kstep, voffB); PG8_STAGE(PG8_SA(1, 0), cA + kstep, voffA); PG8_STAGE(PG8_SB(1, 1), cB + hstep + kstep, voffB);
        PG8_WAIT_V(6); PG8_BAR;
    }
    for (;;) {
        const bool has_next = S.next(ui + 1, nxt);
        const char* nA = has_next ? (const char*)g.A + (size_t)nxt.pm * tstep : cA; const char* nB = has_next ? (const char*)g.Bt + (size_t)nxt.pn * tstep : cB;
        for (int t = 0; t < nt; t += 2) {
            const bool last = (t == nt - 2);
            const char* a1 = cA + (size_t)(t + 1) * kstep;
            const char* a2 = last ? nA : cA + (size_t)(t + 2) * kstep; const char* b2 = last ? nB : cB + (size_t)(t + 2) * kstep;
            const char* a3 = a2 + kstep; const char* b3 = b2 + kstep;
            if (last && has_next) S.a_ready(nxt);
            if constexpr (SP2) {
            PG8_LDB(B0, 0, 0); PG8_LDB(B1, 0, 1); PG8_SCHED; PG8_LDA(At, 0, 0); PG8_STAGE(PG8_SA(1, 1), a1 + hstep, voffA);
            PG8_WAIT_V(8); PG8_WAIT_L(0); PG8_BAR; PG8_MMA(0, 0, At, B0); PG8_MMA(0, 1, At, B1); PG8_BAR; PG8_SCHED;
            PG8_LDA(At, 0, 1); PG8_STAGE(PG8_SB(0, 0), b2, voffB); PG8_STAGE(PG8_SB(0, 1), b2 + hstep, voffB); PG8_STAGE(PG8_SA(0, 0), a2, voffA);
            PG8_WAIT_V(8); PG8_WAIT_L(0); PG8_BAR; PG8_MMA(1, 0, At, B0); PG8_MMA(1, 1, At, B1); PG8_BAR; PG8_SCHED;
            PG8_LDB(B0, 1, 0); PG8_LDB(B1, 1, 1); PG8_SCHED; PG8_LDA(At, 1, 0); PG8_STAGE(PG8_SA(0, 1), a2 + hstep, voffA);
            PG8_WAIT_V(8); PG8_WAIT_L(0); PG8_BAR; PG8_MMA(0, 0, At, B0); PG8_MMA(0, 1, At, B1); PG8_BAR; PG8_SCHED;
            PG8_LDA(At, 1, 1); PG8_STAGE(PG8_SB(1, 0), b3, voffB); PG8_STAGE(PG8_SB(1, 1), b3 + hstep, voffB); PG8_STAGE(PG8_SA(1, 0), a3, voffA);
            PG8_WAIT_V(8); PG8_WAIT_L(0); PG8_BAR; PG8_MMA(1, 0, At, B0); PG8_MMA(1, 1, At, B1); PG8_BAR; PG8_SCHED;
            } else {
            PG8_LDB(B0, 0, 0); PG8_SCHED; PG8_LDA(At, 0, 0); PG8_STAGE(PG8_SA(1, 1), a1 + hstep, voffA);
            PG8_WAIT_L(8); PG8_BAR; PG8_WAIT_L(0); PG8_MMA(0, 0, At, B0); PG8_BAR; PG8_SCHED;
            PG8_LDB(B1, 0, 1); PG8_STAGE(PG8_SB(0, 0), b2, voffB);
            PG8_BAR; PG8_WAIT_L(0); PG8_MMA(0, 1, At, B1); PG8_BAR;
            PG8_LDA(At, 0, 1); PG8_STAGE(PG8_SA(0, 0), a2, voffA);
            PG8_BAR; PG8_WAIT_L(0); PG8_MMA(1, 0, At, B0); PG8_BAR; PG8_SCHED;
            PG8_STAGE(PG8_SB(0, 1), b2 + hstep, voffB);
            PG8_WAIT_V(6); PG8_BAR; PG8_MMA(1, 1, At, B1); PG8_BAR;
            PG8_LDB(B0, 1, 0); PG8_SCHED; PG8_LDA(At, 1, 0); PG8_STAGE(PG8_SA(0, 1), a2 + hstep, voffA);
            PG8_WAIT_L(8); PG8_BAR; PG8_WAIT_L(0); PG8_MMA(0, 0, At, B0); PG8_BAR; PG8_SCHED;
            PG8_LDB(B1, 1, 1); PG8_STAGE(PG8_SB(1, 0), b3, voffB);
            PG8_BAR; PG8_WAIT_L(0); PG8_MMA(0, 1, At, B1); PG8_BAR;
            PG8_LDA(At, 1, 1); PG8_STAGE(PG8_SA(1, 0), a3, voffA);
            PG8_BAR; PG8_WAIT_L(0); PG8_MMA(1, 0, At, B0); PG8_BAR; PG8_SCHED;
            PG8_STAGE(PG8_SB(1, 1), b3 + hstep, voffB);
            PG8_WAIT_V(6); PG8_BAR; PG8_MMA(1, 1, At, B1); PG8_BAR;
            }
        }
        if constexpr (ALIGN_EPI) { if (wr == 0) PG8_BAR; }
        if constexpr (!Epi::AFTER_DRAIN) { E(acc, cur, wr, wc, fr, fq); S.done(cur); }
        if (!has_next) break;
#pragma unroll
        for (int a = 0; a < 2; ++a)
#pragma unroll
            for (int b = 0; b < 2; ++b)
#pragma unroll
                for (int m = 0; m < 4; ++m)
#pragma unroll
                    for (int n = 0; n < 2; ++n) acc[a][b][m][n] = (f32x4){0.f, 0.f, 0.f, 0.f};
        cur = nxt; cA = nA; cB = nB; ++ui;
        if constexpr (ALIGN_EPI) { if (wr == 1) PG8_BAR; }
    }
    PG8_WAIT_V(0);
    if constexpr (!ALIGN_EPI) { if (wr == 0) PG8_BAR; }
    PG8_BAR;
    if constexpr (Epi::AFTER_DRAIN) { E.fused(acc, cur, wr, wc, fr, fq, lds, wid, lane); S.done(cur); }
#undef PG8_SA
#undef PG8_SB
#undef PG8_STAGE
#undef PG8_LDA
#undef PG8_LDB
#undef PG8_MMA
#undef PG8_WAIT_V
#undef PG8_WAIT_L
#undef PG8_BAR
#undef PG8_SCHED
}
}

namespace pg8 { struct OneUnit { int pm, pn;
    __device__ __forceinline__ bool next(int i, Unit& u) const { if (i != 0) return false; u.pm = pm; u.pn = pn; return true; }
    __device__ __forceinline__ void a_ready(const Unit&) const {}
    __device__ __forceinline__ void done(const Unit&) const {} }; }
namespace pg8 { struct OneUnitPub { int pm, pn; unsigned* cnt;
    __device__ __forceinline__ bool next(int i, Unit& u) const { if (i != 0) return false; u.pm = pm; u.pn = pn; return true; }
    __device__ __forceinline__ void a_ready(const Unit&) const {}
    __device__ __forceinline__ void done(const Unit&) const { pub_wave(cnt); } }; }
namespace pg8 {
__device__ __forceinline__ u32x4 pack8(const f32x4& a, const f32x4& b) { u32x4 w; w.x = cvt_pk_bf16(a[0], a[1]); w.y = cvt_pk_bf16(a[2], a[3]); w.z = cvt_pk_bf16(b[0], b[1]); w.w = cvt_pk_bf16(b[2], b[3]); return w; }
__device__ __forceinline__ float hsum4(const f32x4& v) { return (v[0] + v[1]) + (v[2] + v[3]); }
__device__ __forceinline__ float hsq4(const f32x4& v) { return (v[0] * v[0] + v[1] * v[1]) + (v[2] * v[2] + v[3] * v[3]); }
__device__ __forceinline__ float rstd16(const float* rs, int row, float inv_n) { const f32x4* p = (const f32x4*)(rs + 16 * (size_t)row); const f32x4 a = p[0], b = p[1], c = p[2], d = p[3];
    return rsqrtf(((hsum4(a) + hsum4(b)) + (hsum4(c) + hsum4(d))) * inv_n + EPS); }
__device__ __forceinline__ float rstd4(const float* rs, int row, float inv_n) { const f32x4 a = *(const f32x4*)(rs + 4 * (size_t)row); return rsqrtf(hsum4(a) * inv_n + EPS); }
__device__ __forceinline__ float red_fq(float s) { s += shfl_xor_(s, 16); s += shfl_xor_(s, 32); return s; }
__device__ __forceinline__ float fsigmoid(float x) { return __builtin_amdgcn_rcpf(1.f + __builtin_amdgcn_exp2f(-1.4426950408889634f * x)); }
__device__ __forceinline__ f32x4 unpk_lo(unsigned a, unsigned b) { return (f32x4){__uint_as_float(a << 16), __uint_as_float(a & 0xffff0000u), __uint_as_float(b << 16), __uint_as_float(b & 0xffff0000u)}; }
#define EPI_LAUNDER { const int ln_ = lane_id(); fr = ln_ & 15; fq = ln_ >> 4; }
#define EPI_ROWS_BEGIN _Pragma("unroll") for (int ai = 0; ai < 2; ++ai) _Pragma("unroll") for (int m = 0; m < 4; ++m) { const int row = u.pm * BM + ai * HALF + wr * 64 + m * 16 + fr;
#define EPI_ROWS_END asm volatile("" ::: "memory"); }

struct EpiWin { static constexpr bool PERM = true, AFTER_DRAIN = false;
    const float* rsx; bf16_t* u5; bf16_t* cqb; float* rscq; float* t2f; bf16_t* t2b; float* rskv; float* qkf; bf16_t* gvb; bf16_t* grb; PG8_LAS float* rst;
    __device__ __forceinline__ void operator()(const f32x4 (&acc)[2][2][4][2], const Unit& u, int wr, int wc, int fr, int fq) const {
        EPI_LAUNDER const int cb = wc * 32 + 8 * fq, tid = (wr * 4 + wc) * 64 + fq * 16 + fr;
        if (tid < 256) rst[tid] = rstd16(rsx, u.pm * BM + tid, 1.f / 1024.f);
        asm volatile("s_waitcnt lgkmcnt(0)" ::: "memory"); __builtin_amdgcn_s_barrier(); asm volatile("" ::: "memory");
        EPI_ROWS_BEGIN
            const float r = rst[ai * HALF + wr * 64 + m * 16 + fr];
            f32x4 v[2][2];
#pragma unroll
            for (int bj = 0; bj < 2; ++bj) { v[bj][0] = acc[ai][bj][m][0] * r; v[bj][1] = acc[ai][bj][m][1] * r; }
            if (u.pn == 0) {
#pragma unroll
                for (int bj = 0; bj < 2; ++bj) { const int c = bj * HALF + cb; *(u32x4*)(u5 + ((size_t)(c >> 4) * ::M + row) * 16 + (c & 15)) = pack8(v[bj][0], v[bj][1]); }
            } else if (u.pn == 1) { float s = 0.f;
#pragma unroll
                for (int bj = 0; bj < 2; ++bj) { *(u32x4*)(cqb + (size_t)row * 256 + bj * HALF + cb) = pack8(v[bj][0], v[bj][1]); s += hsq4(v[bj][0]) + hsq4(v[bj][1]); }
                s = red_fq(s); if (fq == 0) rscq[(size_t)row * 4 + wc] = s;
            } else if (u.pn == 2) {
#pragma unroll
                for (int bj = 0; bj < 2; ++bj) { float* p = t2f + (size_t)row * 256 + bj * HALF + cb; *(f32x4*)p = v[bj][0]; *(f32x4*)(p + 4) = v[bj][1];
                    *(u32x4*)(t2b + (size_t)row * 256 + bj * HALF + cb) = pack8(v[bj][0], v[bj][1]); }
                const float s = red_fq(hsq4(v[0][0]) + hsq4(v[0][1])); if (fq == 0) rskv[(size_t)row * 4 + wc] = s;
            } else if (u.pn == 3) {
#pragma unroll
                for (int bj = 0; bj < 2; ++bj) { float* p = qkf + (size_t)row * 256 + bj * HALF + cb; *(f32x4*)p = v[bj][0]; *(f32x4*)(p + 4) = v[bj][1]; }
            } else { bf16_t* dst = u.pn == 4 ? gvb : grb;
#pragma unroll
                for (int bj = 0; bj < 2; ++bj) *(u32x4*)(dst + (size_t)row * 256 + bj * HALF + cb) = pack8(v[bj][0], v[bj][1]);
            }
        EPI_ROWS_END
    }
};
struct EpiQ { static constexpr bool PERM = true, AFTER_DRAIN = false;
    const float* rscq; const float* cosT; const float* sinT; bf16_t* qn; bf16_t* qp;
    __device__ __forceinline__ void operator()(const f32x4 (&acc)[2][2][4][2], const Unit& u, int wr, int wc, int fr, int fq) const {
        EPI_LAUNDER const int cb = wc * 32 + 8 * fq;
        f32x4 rnx = *(const f32x4*)(rscq + 4 * (size_t)(u.pm * BM + wr * 64 + fr));
        EPI_ROWS_BEGIN
            const float r = rsqrtf(hsum4(rnx) * (1.f / 256.f) + EPS) * QSCALE;
            { const int nx_ = ai * 4 + m + 1; if (nx_ < 8) rnx = *(const f32x4*)(rscq + 4 * (size_t)(u.pm * BM + (nx_ >> 2) * HALF + wr * 64 + (nx_ & 3) * 16 + fr)); }
            if (u.pn < 2) {
#pragma unroll
                for (int bj = 0; bj < 2; ++bj) *(u32x4*)(qn + (size_t)row * 512 + u.pn * 256 + bj * HALF + cb) = pack8(acc[ai][bj][m][0] * r, acc[ai][bj][m][1] * r);
            } else { const int pos = row & (SEQ - 1); const f32x4 cs = *(const f32x4*)(cosT + pos * 16 + 4 * fq), sn = *(const f32x4*)(sinT + pos * 16 + 4 * fq);
#pragma unroll
                for (int bj = 0; bj < 2; ++bj) { const f32x4 x1 = acc[ai][bj][m][0] * r, x2 = acc[ai][bj][m][1] * r;
                    *(u32x4*)(qp + (size_t)row * 256 + bj * HALF + cb) = pack8(x1 * cs - x2 * sn, x1 * sn + x2 * cs); }
            }
        EPI_ROWS_END
    }
};
struct EpiKV { static constexpr bool PERM = true, AFTER_DRAIN = false;
    const float* rskv; bf16_t* kn; bf16_t* vb;
    __device__ __forceinline__ void operator()(const f32x4 (&acc)[2][2][4][2], const Unit& u, int wr, int wc, int fr, int fq) const {
        EPI_LAUNDER const int cb = wc * 32 + 8 * fq; bf16_t* dst = (u.pn < 2 ? kn : vb) + (u.pn & 1) * 256;
        f32x4 rnx = *(const f32x4*)(rskv + 4 * (size_t)(u.pm * BM + wr * 64 + fr));
        EPI_ROWS_BEGIN
            const float r = rsqrtf(hsum4(rnx) * (1.f / 128.f) + EPS);
            { const int nx_ = ai * 4 + m + 1; if (nx_ < 8) rnx = *(const f32x4*)(rskv + 4 * (size_t)(u.pm * BM + (nx_ >> 2) * HALF + wr * 64 + (nx_ & 3) * 16 + fr)); }
#pragma unroll
            for (int bj = 0; bj < 2; ++bj) *(u32x4*)(dst + (size_t)row * 512 + bj * HALF + cb) = pack8(acc[ai][bj][m][0] * r, acc[ai][bj][m][1] * r);
        EPI_ROWS_END
    }
};
struct EpiGlu { static constexpr bool PERM = true, AFTER_DRAIN = false;
    const bf16_t* y5; const float* bias; bf16_t* mix;
    __device__ __forceinline__ void operator()(const f32x4 (&acc)[2][2][4][2], const Unit& u, int wr, int wc, int fr, int fq) const {
        EPI_LAUNDER const int cb = wc * 32 + 8 * fq;
#pragma unroll
        for (int ai = 0; ai < 2; ++ai) {
            u32x4 yy[4][2];
#pragma unroll
            for (int m = 0; m < 4; ++m)
#pragma unroll
                for (int bj = 0; bj < 2; ++bj) yy[m][bj] = *(const u32x4*)(y5 + (size_t)(u.pm * BM + ai * HALF + wr * 64 + m * 16 + fr) * 256 + bj * HALF + cb);
#pragma unroll
            for (int m = 0; m < 4; ++m) { const int row = u.pm * BM + ai * HALF + wr * 64 + m * 16 + fr;
#pragma unroll
                for (int bj = 0; bj < 2; ++bj) { const int c = bj * HALF + cb; const u32x4 yw = yy[m][bj];
                    const f32x4 y0 = unpk_lo(yw.x, yw.y), y1 = unpk_lo(yw.z, yw.w), b0 = *(const f32x4*)(bias + c), b1 = *(const f32x4*)(bias + c + 4);
                    f32x4 o0, o1;
#pragma unroll
                    for (int e = 0; e < 4; ++e) { o0[e] = y0[e] * fsigmoid(acc[ai][bj][m][0][e] + b0[e]); o1[e] = y1[e] * fsigmoid(acc[ai][bj][m][1][e] + b1[e]); }
                    st16_wt(mix + (size_t)row * DM + c, pack8(o0, o1)); }
                asm volatile("" ::: "memory"); } }
    }
};
template <bool WT> struct EpiResidT { static constexpr bool PERM = true, AFTER_DRAIN = false;
    const float* xin_f32; bf16_t* xb; float* rsx;
    __device__ __forceinline__ void operator()(const f32x4 (&acc)[2][2][4][2], const Unit& u, int wr, int wc, int fr, int fq) const {
        EPI_LAUNDER const int cb = wc * 32 + 8 * fq;
#pragma unroll
        for (int ai = 0; ai < 2; ++ai) {
            u32x4 rw[4][2];
            if (!xin_f32) {
#pragma unroll
                for (int m = 0; m < 4; ++m)
#pragma unroll
                    for (int bj = 0; bj < 2; ++bj) rw[m][bj] = *(const u32x4*)(xb + (size_t)(u.pm * BM + ai * HALF + wr * 64 + m * 16 + fr) * DM + u.pn * 256 + bj * HALF + cb); }
#pragma unroll
            for (int m = 0; m < 4; ++m) { const int row = u.pm * BM + ai * HALF + wr * 64 + m * 16 + fr;
                float s = 0.f;
#pragma unroll
                for (int bj = 0; bj < 2; ++bj) { const size_t o = (size_t)row * DM + u.pn * 256 + bj * HALF + cb;
                    f32x4 a0, a1;
                    if (xin_f32) { a0 = *(const f32x4*)(xin_f32 + o); a1 = *(const f32x4*)(xin_f32 + o + 4); }
                    else { const u32x4 w = rw[m][bj]; a0 = unpk_lo(w.x, w.y); a1 = unpk_lo(w.z, w.w); }
                    a0 = a0 + acc[ai][bj][m][0]; a1 = a1 + acc[ai][bj][m][1];
                    if (WT) st16_wt(xb + o, pack8(a0, a1)); else *(u32x4*)(xb + o) = pack8(a0, a1); s += hsq4(a0) + hsq4(a1); }
                s = red_fq(s); if (fq == 0) { if (WT) st4_wt(rsx + (size_t)row * 16 + u.pn * 4 + wc, s); else rsx[(size_t)row * 16 + u.pn * 4 + wc] = s; }
                asm volatile("" ::: "memory"); } }
    }
};
using EpiResid = EpiResidT<false>;
template <int CTRL> __device__ __forceinline__ float dpp_mov(float x) { return __builtin_bit_cast(float, __builtin_amdgcn_update_dpp(0, __builtin_bit_cast(int, x), CTRL, 0xf, 0xf, false)); }
__device__ __forceinline__ float fgelu(float x) { const float t = x * x; const float u = x * (1.5957691216057308f + 0.07135481627159432f * t);
    return x * __builtin_amdgcn_rcpf(1.f + __builtin_amdgcn_exp2f(-1.4426950408889634f * u)); }
struct EpiFfi { static constexpr bool PERM = true, AFTER_DRAIN = false;
    const float* rsx; const float* cw; const float* cbias; bf16_t* h; float* fv; float* fg; float* lg; float* convout; PG8_LAS float* xch;
    __device__ __forceinline__ void operator()(const f32x4 (&acc)[2][2][4][2], const Unit& u, int wr, int wc, int fr, int fq) const {
        EPI_LAUNDER const int cb = wc * 32 + 8 * fq, c0 = u.pn * HALF + cb, tid = (wr * 4 + wc) * 64 + fq * 16 + fr;
        PG8_LAS float* RST = xch + 1024;
        if (tid < 256) RST[tid] = rstd16(rsx, u.pm * BM + tid, 1.f / 1024.f);
#pragma unroll
        for (int ai = 0; ai < 2; ++ai) if (fr >= 14) { PG8_LAS float* p = xch + ((2 * ai + wr) * 2 + (fr - 14)) * 128 + cb; *(PG8_LAS f32x4*)p = acc[ai][1][3][0]; *(PG8_LAS f32x4*)(p + 4) = acc[ai][1][3][1]; }
        f32x4 w0[2], w1[2], w2[2], bb[2];
#pragma unroll
        for (int n = 0; n < 2; ++n) { w0[n] = *(const f32x4*)(cw + c0 + 4 * n); w1[n] = *(const f32x4*)(cw + DFF + c0 + 4 * n); w2[n] = *(const f32x4*)(cw + 2 * DFF + c0 + 4 * n); bb[n] = *(const f32x4*)(cbias + c0 + 4 * n); }
        asm volatile("s_waitcnt lgkmcnt(0)" ::: "memory"); __builtin_amdgcn_s_barrier(); asm volatile("" ::: "memory");
#pragma unroll
        for (int ai = 0; ai < 2; ++ai) { const int bnd = 2 * ai + wr;
            f32x4 hp0[2], hp1[2], gp[2];
            { const int pb_ = bnd > 0 ? bnd - 1 : 0; const float r0 = bnd > 0 ? RST[64 * bnd - 2] : 0.f, r1 = bnd > 0 ? RST[64 * bnd - 1] : 0.f;
#pragma unroll
              for (int n = 0; n < 2; ++n) { hp0[n] = *(const PG8_LAS f32x4*)(xch + (pb_ * 2 + 0) * 128 + cb + 4 * n) * r0; hp1[n] = *(const PG8_LAS f32x4*)(xch + (pb_ * 2 + 1) * 128 + cb + 4 * n) * r1; gp[n] = hp0[n]; } }
#pragma unroll
            for (int m = 0; m < 4; ++m) { const int rit = ai * HALF + wr * 64 + m * 16 + fr, row = u.pm * BM + rit; const float r = RST[rit];
                f32x4 g[2], vv[2], hv[2];
#pragma unroll
                for (int n = 0; n < 2; ++n) { g[n] = acc[ai][1][m][n] * r; vv[n] = acc[ai][0][m][n] * r;
#pragma unroll
                    for (int e = 0; e < 4; ++e) { const float a1 = dpp_mov<0x121>(g[n][e]), a2 = dpp_mov<0x122>(g[n][e]);
                        const float b1 = m == 0 ? hp1[n][e] : dpp_mov<0x121>(gp[n][e]), b2 = m == 0 ? (fr == 1 ? hp1[n][e] : hp0[n][e]) : dpp_mov<0x122>(gp[n][e]);
                        const float p1 = fr >= 1 ? a1 : b1, p2 = fr >= 2 ? a2 : b2;
                        const float cv = bb[n][e] + w0[n][e] * p2 + w1[n][e] * p1 + w2[n][e] * g[n][e];
                        hv[n][e] = fgelu(cv) * vv[n][e]; } }
                if (m == 0 && bnd == 0 && fr < 2) { float* p = fv + ((size_t)u.pm * 2 + fr) * DFF + c0; st16_wt(p, vv[0]); st16_wt(p + 4, vv[1]); float* q = fg + ((size_t)u.pm * 2 + fr) * DFF + c0; st16_wt(q, g[0]); st16_wt(q + 4, g[1]); }
                else st16_wt(h + (size_t)row * DFF + c0, pack8(hv[0], hv[1]));
                if (m == 3 && bnd == 3 && fr >= 14) { float* p = lg + ((size_t)u.pm * 2 + (fr - 14)) * DFF + c0; st16_wt(p, g[0]); st16_wt(p + 4, g[1]);
                    if ((u.pm & 7) == 7) { float* q = convout + ((size_t)(u.pm >> 3) * 2 + (fr - 14)) * DFF + c0; *(f32x4*)q = g[0]; *(f32x4*)(q + 4) = g[1]; } }
                gp[0] = g[0]; gp[1] = g[1];
                asm volatile("" ::: "memory"); }
        }
    }
};
}

#include <hip/hip_bf16.h>
#include <cmath>
namespace attn_body {
using bf16=__hip_bfloat16;
using bf16x8=__attribute__((ext_vector_type(8)))short;
using s16x4=__attribute__((ext_vector_type(4)))short;
using f32x16=__attribute__((ext_vector_type(16)))float;
using u32x4=__attribute__((ext_vector_type(4)))unsigned;
constexpr int BATCH=8,NHEAD=8,SEQ=2048,D=64,DR=32;
constexpr int QNP=512,QPP=256,KNP=512,KPP=32,VP=512,OP=1024,OCOL=256;
constexpr int NW=8,QBLK=32,QB=QBLK*NW,KVBLK=64,NQB=SEQ/QB;
constexpr int ATTN_UNIT_ROWS=QB;
__device__ __forceinline__ int crow(int r,int hi){return (r&3)+8*(r>>2)+4*hi;}
#define SBAR() __builtin_amdgcn_sched_barrier(0)
__device__ __forceinline__ void cmask(f32x16&p0,f32x16&p1,int jb,int qrel,int hi){
  const float NEG=-INFINITY; int kb=64*jb+4*hi;
  #pragma unroll
  for(int r=0;r<16;++r){int kv=kb+(r&3)+8*(r>>2); if(kv>qrel)p0[r]=NEG; if(kv+32>qrel)p1[r]=NEG;}
}

constexpr int NSLOT=3, SLOTB=8192, KSLOTB=12288;
constexpr int LDS_K=0, LDS_V=NSLOT*KSLOTB, LDS_WS=LDS_V+NSLOT*SLOTB, LDS_OST=LDS_WS+NW*64*4, LDS_BYTES=LDS_OST+NW*4096;
constexpr float C2=0.10206207261596575f*1.4426950408889634f;
__device__ __forceinline__ void glds16(const void*gsrc,unsigned lds_dst){unsigned keep;
  asm volatile("s_mov_b32 %0, m0\n\ts_mov_b32 m0, %2\n\ts_nop 0\n\tglobal_load_lds_dwordx4 %1, off\n\ts_mov_b32 m0, %0":"=&s"(keep):"v"(gsrc),"s"(lds_dst):"memory");}
__device__ __forceinline__ float max3f(float a,float b,float c){float r;asm("v_max3_f32 %0, %1, %2, %3":"=v"(r):"v"(a),"v"(b),"v"(c));return r;}
__device__ __forceinline__ float max2f(float a,float b){float r;asm("v_max_f32_e32 %0, %1, %2":"=v"(r):"v"(a),"v"(b));return r;}
__device__ __forceinline__ float fadd_s(float a,float b){float r;asm("v_add_f32_e32 %0, %1, %2":"=v"(r):"v"(a),"v"(b));return r;}
__device__ __forceinline__ float fsub_s(float a,float b){float r;asm("v_sub_f32_e32 %0, %1, %2":"=v"(r):"v"(a),"v"(b));return r;}
typedef float f32x2_t __attribute__((ext_vector_type(2))); typedef __bf16 bf16x2_t __attribute__((ext_vector_type(2)));
__device__ __forceinline__ unsigned cvtpk_s(float lo,float hi){f32x2_t v={lo,hi};bf16x2_t b=__builtin_convertvector(v,bf16x2_t);return __builtin_bit_cast(unsigned,b);}
#define WAIT_BAR(N) asm volatile("s_waitcnt vmcnt(" #N ") lgkmcnt(0)\n\ts_barrier":::"memory")

__device__ __forceinline__ void qkt(f32x16&p0,f32x16&p1,const char*Kslot,const bf16x8*qr,const f32x16&negm,int r32,int hi){
  const char*kb=Kslot+hi*1024+r32*16;
  #pragma unroll
  for(int d0=0;d0<6;++d0){
    const bf16x8 b0=*reinterpret_cast<const bf16x8*>(kb+d0*2048);
    const bf16x8 b1=*reinterpret_cast<const bf16x8*>(kb+d0*2048+512);
    if(d0==0){p0=__builtin_amdgcn_mfma_f32_32x32x16_bf16(b0,qr[0],negm,0,0,0);p1=__builtin_amdgcn_mfma_f32_32x32x16_bf16(b1,qr[0],negm,0,0,0);}
    else{p0=__builtin_amdgcn_mfma_f32_32x32x16_bf16(b0,qr[d0],p0,0,0,0);p1=__builtin_amdgcn_mfma_f32_32x32x16_bf16(b1,qr[d0],p1,0,0,0);}}
}
typedef __attribute__((address_space(3))) const char* lds_cptr;
typedef short v4i16_t __attribute__((ext_vector_type(4)));
__device__ __forceinline__ void kload8(bf16x8*kf,lds_cptr kp){
  kf[0]=*(const __attribute__((address_space(3))) bf16x8*)(kp);      kf[1]=*(const __attribute__((address_space(3))) bf16x8*)(kp+512);
  kf[2]=*(const __attribute__((address_space(3))) bf16x8*)(kp+2048); kf[3]=*(const __attribute__((address_space(3))) bf16x8*)(kp+2560);
  kf[4]=*(const __attribute__((address_space(3))) bf16x8*)(kp+4096); kf[5]=*(const __attribute__((address_space(3))) bf16x8*)(kp+4608);
  kf[6]=*(const __attribute__((address_space(3))) bf16x8*)(kp+6144); kf[7]=*(const __attribute__((address_space(3))) bf16x8*)(kp+6656);
  kf[8]=*(const __attribute__((address_space(3))) bf16x8*)(kp+8192); kf[9]=*(const __attribute__((address_space(3))) bf16x8*)(kp+8704);
  kf[10]=*(const __attribute__((address_space(3))) bf16x8*)(kp+10240); kf[11]=*(const __attribute__((address_space(3))) bf16x8*)(kp+10752);
}
__device__ __forceinline__ void kload2(bf16x8*kf,lds_cptr kp,int j){ kf[2*j]=*(const __attribute__((address_space(3))) bf16x8*)(kp+j*2048); kf[2*j+1]=*(const __attribute__((address_space(3))) bf16x8*)(kp+j*2048+512); }
__device__ __forceinline__ s16x4 vtr(lds_cptr p){ return __builtin_bit_cast(s16x4,__builtin_amdgcn_ds_read_tr16_b64_v4i16((__attribute__((address_space(3))) v4i16_t*)p)); }
__device__ __forceinline__ float rowmax(const f32x16&p0,const f32x16&p1){
  float a=max3f(p0[0],p0[1],p1[0]),b=max3f(p0[2],p0[3],p1[1]);a=max3f(a,p1[2],p1[3]);
  #pragma unroll
  for(int r=4;r<16;r+=4){a=max3f(a,p0[r],p0[r+1]);b=max3f(b,p0[r+2],p0[r+3]);a=max3f(a,p1[r],p1[r+1]);b=max3f(b,p1[r+2],p1[r+3]);}
  const float m=max2f(a,b);
  auto rr=__builtin_amdgcn_permlane32_swap(__float_as_uint(m),__float_as_uint(m),false,false);
  return max2f(__uint_as_float(rr[0]),__uint_as_float(rr[1]));
}
__device__ __forceinline__ void pv(f32x16*o,int vb,bf16x8 pa0,bf16x8 pa1,bf16x8 pa2,bf16x8 pa3){
  #pragma unroll
  for(int d0=0;d0<2;++d0){s16x4 lo[4],hi[4];
    #pragma unroll
    for(int ks=0;ks<4;++ks){
      asm volatile("ds_read_b64_tr_b16 %0,%1 offset:%c2":"=&v"(lo[ks]):"v"(vb),"i"(d0*4096+ks*1024):"memory");
      asm volatile("ds_read_b64_tr_b16 %0,%1 offset:%c2":"=&v"(hi[ks]):"v"(vb),"i"(d0*4096+ks*1024+512):"memory");}
    asm volatile("s_waitcnt lgkmcnt(0)":::"memory");SBAR();
    #define PK(k) (bf16x8){lo[k][0],lo[k][1],lo[k][2],lo[k][3],hi[k][0],hi[k][1],hi[k][2],hi[k][3]}
    o[d0]=__builtin_amdgcn_mfma_f32_32x32x16_bf16(pa0,PK(0),o[d0],0,0,0);
    o[d0]=__builtin_amdgcn_mfma_f32_32x32x16_bf16(pa1,PK(1),o[d0],0,0,0);
    o[d0]=__builtin_amdgcn_mfma_f32_32x32x16_bf16(pa2,PK(2),o[d0],0,0,0);
    o[d0]=__builtin_amdgcn_mfma_f32_32x32x16_bf16(pa3,PK(3),o[d0],0,0,0);
    #undef PK
  }
}

#ifndef ATTN_STORE16
#define ATTN_STORE16(p,v) pg8::st16_wt((void*)(p),(v))
#endif
template<int THRL> __device__ __forceinline__ void attn_unit(const int wave_id,int b,int h,int qb,const bf16*QN,const bf16*QP,const bf16*__restrict__ KN,const bf16*__restrict__ KP,const bf16*__restrict__ V,bf16*O,char*shm){
  int tid_=wave_id*64+lane_id(); asm volatile("":"+v"(tid_)); const int tid=tid_,lane=tid&63,r32=lane&31,hi=lane>>5; const int wid=__builtin_amdgcn_readfirstlane(tid>>6);
  const long rowbase=(long)b*SEQ; const int q0=qb*QB;
  const bf16*Qwn=QN+(rowbase+q0+wid*QBLK)*QNP+h*D,*Qwp=QP+(rowbase+q0+wid*QBLK)*QPP+h*DR;
  const bf16*Kh=KN+rowbase*KNP+h*D,*Kr=KP+rowbase*KPP,*Vh=V+rowbase*VP+h*D;
  const unsigned lds0=(unsigned)(uintptr_t)shm;
  float*wsf=(float*)(shm+LDS_WS)+wid*64;
  const bf16*ksrc=Kh+(long)lane*KNP+wid*8;
  const bf16*ksrc2=Kr+(long)lane*KPP+(wid&3)*8;
  const bf16*vsrc=Vh+(long)(16*(wid&3)+(lane>>2))*VP+(wid>>2)*32+(lane&3)*8;
  const unsigned kdst=lds0+LDS_K+wid*1024, kdst2=lds0+LDS_K+(8+(wid&3))*1024, vdst=lds0+LDS_V+wid*1024;
  #define KS_(slot) ((slot)+((slot)>>1))
  #define DMA_K(t,slot) do{ glds16(ksrc+(long)(t)*KVBLK*KNP,(unsigned)__builtin_amdgcn_readfirstlane(kdst+KS_(slot))); glds16(ksrc2+(long)(t)*KVBLK*KPP,(unsigned)__builtin_amdgcn_readfirstlane(kdst2+KS_(slot))); }while(0)
  #define DMA_V(t,slot) glds16(vsrc+(long)(t)*KVBLK*VP,(unsigned)__builtin_amdgcn_readfirstlane(vdst+(slot)))
  const int vb0=(int)(lds0+LDS_V)+((lane>>4)&1)*32+(lane&3)*8+(4*hi+((lane&15)>>2))*64;
  const char*Kbase=shm+LDS_K; bf16x8 kf[12];
  const lds_cptr shm3=(lds_cptr)shm; const lds_cptr kp0=shm3+LDS_K+hi*1024+r32*16; const lds_cptr vp0=shm3+LDS_V+((lane>>4)&1)*32+(lane&3)*8+(4*hi+((lane&15)>>2))*64;
  const int NT=(q0+QB)/KVBLK;
  DMA_K(0,0);DMA_V(0,0);DMA_K(1,SLOTB);
  bf16x8 qr[6];
  #pragma unroll
  for(int d0=0;d0<4;++d0)qr[d0]=*reinterpret_cast<const bf16x8*>(&Qwn[(long)r32*QNP+d0*16+hi*8]);
  #pragma unroll
  for(int d0=0;d0<2;++d0)qr[4+d0]=*reinterpret_cast<const bf16x8*>(&Qwp[(long)r32*QPP+d0*16+hi*8]);
  float mhat=0.f,l_reg=0.f;f32x16 o[2];o[0]=f32x16{};o[1]=f32x16{};const f32x16 zero16=f32x16{};
  const int qrel=wid*QBLK+r32;
  #define CMASK(P0,P1,t) do{int jb_=(t)-(NT-4); if(jb_>=0)cmask(P0,P1,jb_,qrel,hi);}while(0)
  bool resc=false;
  #define START(P0,P1) do{ const float rm=rowmax(P0,P1); resc=false; \
    { const float dl=rm; mhat=fadd_s(mhat,dl); \
      _Pragma("unroll") for(int r=0;r<16;++r){P0[r]=fsub_s(P0[r],dl);P1[r]=fsub_s(P1[r],dl);} } \
    _Pragma("unroll") for(int r=0;r<16;++r)P0[r]=__builtin_amdgcn_exp2f(P0[r]); }while(0)
  #define RESC() do{ if(resc){ asm volatile("s_waitcnt lgkmcnt(0)":::"memory"); \
      _Pragma("unroll") for(int d_=0;d_<2;++d_) _Pragma("unroll") for(int r=0;r<16;++r)o[d_][r]*=wsf[crow(r,hi)]; } }while(0)
  f32x16 pA0,pA1,pB0,pB1;
  int sl_prev=0,sl_cur=0,sl_next=SLOTB;
  #define ROT() do{sl_prev=sl_cur;sl_cur=sl_next;sl_next=(sl_next==(NSLOT-1)*SLOTB)?0:sl_next+SLOTB;}while(0)
  DMA_K(2,2*SLOTB);
  WAIT_BAR(5);
  qkt(pA0,pA1,Kbase,qr,zero16,r32,hi);asm volatile("s_nop 15\n\ts_nop 7":"+v"(pA0),"+v"(pA1));CMASK(pA0,pA1,0);
  START(pA0,pA1);
  _Pragma("unroll") for(int r=0;r<16;++r)pA1[r]=__builtin_amdgcn_exp2f(pA1[r]);
  WAIT_BAR(0);
  DMA_K(3,0);DMA_V(1,SLOTB);
  ROT();
  kload8(kf,kp0+KS_(sl_cur));
  WAIT_BAR(3);
  s16x4 vlo[8],vhi[8]; u32x4 pw0,pw1,pw2,pw3;
  #define PKW(P,B) cvtpk_s(P[B],P[B+1])
  #define PAF(k) __builtin_bit_cast(bf16x8,pw##k)
  #define VFR(i) (bf16x8){vlo[i][0],vlo[i][1],vlo[i][2],vlo[i][3],vhi[i][0],vhi[i][1],vhi[i][2],vhi[i][3]}
  #define PIN(x) asm volatile("":"+v"(x))
  #define MX3(a,b,c) __builtin_fmaxf(__builtin_fmaxf((a),(b)),(c))
  #define GAPA(MF,A0,A1,A2,A3,W0,W1,PW) do{ MF; sacc+=A0; sacc+=A1; sacc+=A2; sacc+=A3; PIN(sacc); W0; W1; PIN(PW); SBAR(); }while(0)
  #define EX(v) __builtin_amdgcn_exp2f(v)
  #define GAPB(MF,X,B) do{ MF; X[B]=EX(X[B]); X[B+1]=EX(X[B+1]); X[B+2]=EX(X[B+2]); X[B+3]=EX(X[B+3]); PIN(X); SBAR(); }while(0)
  #define VRD(i) do{ vlo[i]=vtr(vp_+(((i)>>2)*4096+((i)&3)*1024)); vhi[i]=vtr(vp_+(((i)>>2)*4096+((i)&3)*1024+512)); }while(0)
  #define KRD(G,j) do{ if(G){ kload2(kf,kp0+KS_(sl_next),j); SBAR(); } }while(0)
  #define STEP(C0,C1,P0,P1,t,GK,GV,GL) do{ SBAR(); \
    const lds_cptr vp_=vp0+sl_prev; \
    VRD(0); SBAR(); float sacc=(P0[0]+P0[1]); \
    GAPA(C0=__builtin_amdgcn_mfma_f32_32x32x16_bf16(kf[0],qr[0],zero16,0,0,0), P0[2],P0[3],P0[4],P0[5],     pw0[0]=PKW(P0,0), pw0[1]=PKW(P0,2), pw0); \
    VRD(4); SBAR(); GAPA(C1=__builtin_amdgcn_mfma_f32_32x32x16_bf16(kf[1],qr[0],zero16,0,0,0), P0[6],P0[7],P0[8],P0[9],     pw0[2]=PKW(P0,4), pw0[3]=PKW(P0,6), pw0); \
    VRD(1); SBAR(); GAPA(C0=__builtin_amdgcn_mfma_f32_32x32x16_bf16(kf[2],qr[1],C0,0,0,0),   P0[10],P0[11],P0[12],P0[13], pw1[0]=PKW(P0,8), pw1[1]=PKW(P0,10), pw1); \
    VRD(5); SBAR(); GAPA(C1=__builtin_amdgcn_mfma_f32_32x32x16_bf16(kf[3],qr[1],C1,0,0,0),   P0[14],P0[15],P1[0],P1[1],   pw1[2]=PKW(P0,12),pw1[3]=PKW(P0,14), pw1); \
    VRD(2); SBAR(); GAPA(C0=__builtin_amdgcn_mfma_f32_32x32x16_bf16(kf[4],qr[2],C0,0,0,0),   P1[2],P1[3],P1[4],P1[5],     pw2[0]=PKW(P1,0), pw2[1]=PKW(P1,2), pw2); \
    VRD(6); SBAR(); GAPA(C1=__builtin_amdgcn_mfma_f32_32x32x16_bf16(kf[5],qr[2],C1,0,0,0),   P1[6],P1[7],P1[8],P1[9],     pw2[2]=PKW(P1,4), pw2[3]=PKW(P1,6), pw2); \
    VRD(3); SBAR(); GAPA(C0=__builtin_amdgcn_mfma_f32_32x32x16_bf16(kf[6],qr[3],C0,0,0,0),   P1[10],P1[11],P1[12],P1[13], pw3[0]=PKW(P1,8), pw3[1]=PKW(P1,10), pw3); \
    VRD(7); SBAR(); GAPA(C1=__builtin_amdgcn_mfma_f32_32x32x16_bf16(kf[7],qr[3],C1,0,0,0),   P1[14],P1[15],0.f,0.f,       pw3[2]=PKW(P1,12),pw3[3]=PKW(P1,14), pw3); \
    C0=__builtin_amdgcn_mfma_f32_32x32x16_bf16(kf[8],qr[4],C0,0,0,0); C1=__builtin_amdgcn_mfma_f32_32x32x16_bf16(kf[9],qr[4],C1,0,0,0); \
    C0=__builtin_amdgcn_mfma_f32_32x32x16_bf16(kf[10],qr[5],C0,0,0,0); C1=__builtin_amdgcn_mfma_f32_32x32x16_bf16(kf[11],qr[5],C1,0,0,0); SBAR(); \
    _Pragma("unroll") for(int r=0;r<16;++r){C0[r]-=mhat;C1[r]-=mhat;} \
    l_reg+=sacc; \
    if(GK){DMA_K((t)+3,sl_cur);} if(GV){DMA_V((t)+1,sl_next);} \
    CMASK(C0,C1,t); \
    { float a=MX3(C0[0],C0[1],C1[0]),b=MX3(C0[2],C0[3],C1[1]); a=MX3(a,C1[2],C1[3]); \
      _Pragma("unroll") for(int r=4;r<16;r+=4){a=MX3(a,C0[r],C0[r+1]);b=MX3(b,C0[r+2],C0[r+3]);a=MX3(a,C1[r],C1[r+1]);b=MX3(b,C1[r+2],C1[r+3]);} \
      float rm=__builtin_fmaxf(a,b); { auto rr=__builtin_amdgcn_permlane32_swap(__float_as_uint(rm),__float_as_uint(rm),false,false); rm=__builtin_fmaxf(__uint_as_float(rr[0]),__uint_as_float(rr[1])); } \
      resc=false; \
      if(__builtin_expect(__any(rm>(float)THRL),0)){ const float dl=__builtin_fmaxf(rm,0.f); mhat+=dl; \
        _Pragma("unroll") for(int r=0;r<16;++r){C0[r]-=dl;C1[r]-=dl;} \
        const float f=__builtin_amdgcn_exp2f(-dl); l_reg*=f; if(hi==0)wsf[r32]=f; resc=true; } } \
    SBAR(); \
    GAPB(o[0]=__builtin_amdgcn_mfma_f32_32x32x16_bf16(PAF(0),VFR(0),o[0],0,0,0), C0,0); \
    GAPB(o[1]=__builtin_amdgcn_mfma_f32_32x32x16_bf16(PAF(0),VFR(4),o[1],0,0,0), C0,4); \
    KRD(GL,0); GAPB(o[0]=__builtin_amdgcn_mfma_f32_32x32x16_bf16(PAF(1),VFR(1),o[0],0,0,0), C0,8); \
    KRD(GL,1); GAPB(o[1]=__builtin_amdgcn_mfma_f32_32x32x16_bf16(PAF(1),VFR(5),o[1],0,0,0), C0,12); \
    KRD(GL,2); GAPB(o[0]=__builtin_amdgcn_mfma_f32_32x32x16_bf16(PAF(2),VFR(2),o[0],0,0,0), C1,0); \
    KRD(GL,3); GAPB(o[1]=__builtin_amdgcn_mfma_f32_32x32x16_bf16(PAF(2),VFR(6),o[1],0,0,0), C1,4); \
    KRD(GL,4); GAPB(o[0]=__builtin_amdgcn_mfma_f32_32x32x16_bf16(PAF(3),VFR(3),o[0],0,0,0), C1,8); \
    KRD(GL,5); GAPB(o[1]=__builtin_amdgcn_mfma_f32_32x32x16_bf16(PAF(3),VFR(7),o[1],0,0,0), C1,12); \
    }while(0)
  int t=1;
  #undef CMASK
  #define CMASK(P0,P1,t) do{}while(0)
  for(;t+5<NT;t+=2){
    STEP(pB0,pB1,pA0,pA1,t,true,true,true);     WAIT_BAR(3); RESC(); ROT();
    STEP(pA0,pA1,pB0,pB1,t+1,true,true,true);   WAIT_BAR(3); RESC(); ROT();
  }
  #undef CMASK
  #define CMASK(P0,P1,t) do{int jb_=(t)-(NT-4); if(jb_>=0)cmask(P0,P1,jb_,qrel,hi);}while(0)
  #define ENDW(tt) do{ if((tt)+3<NT){WAIT_BAR(3);} else if((tt)+2<NT){WAIT_BAR(1);} else {WAIT_BAR(0);} }while(0)
  for(;t+1<NT;t+=2){
    STEP(pB0,pB1,pA0,pA1,t,(t+3<NT),(t+1<NT),(t+1<NT));       ENDW(t);   RESC(); ROT();
    STEP(pA0,pA1,pB0,pB1,t+1,(t+4<NT),(t+2<NT),(t+2<NT));     ENDW(t+1); RESC(); ROT();
  }
  STEP(pB0,pB1,pA0,pA1,NT-1,false,false,false); RESC();
  { float sacc=pB0[0]+pB0[1]; _Pragma("unroll") for(int r=2;r<16;++r)sacc+=pB0[r]; _Pragma("unroll") for(int r=0;r<16;++r)sacc+=pB1[r]; l_reg+=sacc;
    pw0=(u32x4){PKW(pB0,0),PKW(pB0,2),PKW(pB0,4),PKW(pB0,6)};pw1=(u32x4){PKW(pB0,8),PKW(pB0,10),PKW(pB0,12),PKW(pB0,14)};pw2=(u32x4){PKW(pB1,0),PKW(pB1,2),PKW(pB1,4),PKW(pB1,6)};pw3=(u32x4){PKW(pB1,8),PKW(pB1,10),PKW(pB1,12),PKW(pB1,14)};
    SBAR(); pv(o,vb0+sl_cur,PAF(0),PAF(1),PAF(2),PAF(3)); }
  #undef PKW
  #undef PAF
  #undef VFR
  #undef PIN
  #undef MX3
  #undef GAPA
  #undef GAPB
  #undef EX
  #undef VRD
  #undef KRD
  #undef STEP
  #undef ENDW
  {auto rr=__builtin_amdgcn_permlane32_swap(__float_as_uint(l_reg),__float_as_uint(l_reg),false,false);l_reg=__uint_as_float(rr[0])+__uint_as_float(rr[1]);}
  if(hi==0)wsf[32+r32]=l_reg;asm volatile("s_waitcnt lgkmcnt(0)":::"memory");
  float rli[16];
  #pragma unroll
  for(int r=0;r<16;++r)rli[r]=__builtin_amdgcn_rcpf(wsf[32+crow(r,hi)]);
  bf16*Ow=O+(rowbase+q0+wid*QBLK)*OP+OCOL+h*D;
  { bf16*stg=(bf16*)(shm+LDS_OST)+wid*2048;
    #pragma unroll
    for(int r=0;r<16;++r){const int orow=crow(r,hi);
      #pragma unroll
      for(int d0=0;d0<2;++d0)stg[orow*64+d0*32+r32]=__float2bfloat16(o[d0][r]*rli[r]);}
    asm volatile("s_waitcnt lgkmcnt(0)":::"memory");
    #pragma unroll
    for(int i=0;i<4;++i){const int row=i*8+(lane>>3),ch=lane&7; const u32x4 v=*(const u32x4*)(stg+row*64+ch*8); ATTN_STORE16(Ow+(long)row*OP+ch*8,v);} }
  asm volatile("s_waitcnt lgkmcnt(0)\n\ts_barrier":::"memory");
  #undef DMA_K
  #undef DMA_V
  #undef KS_
  #undef CMASK
  #undef START
  #undef RESC
  #undef ROT
}
constexpr int ATTN_LDS_BYTES=LDS_BYTES;
struct AttnTensors { const bf16* QN; const bf16* QP; const bf16* KN; const bf16* KP; const bf16* V; bf16* O; };
struct AttnUnit { int bh; int qb; };
struct StaticOrder {
  int vcu, G;
  __device__ __forceinline__ explicit StaticOrder(int grid,int block):vcu((grid%8==0)?(block%8)*(grid/8)+block/8:block),G(grid){}
  __device__ __forceinline__ bool next(int i,AttnUnit&u)const{ const int idx=vcu+(i>>1)*G; if(idx>=BATCH*NHEAD*(NQB/2))return false; const int s=idx&3; u.bh=idx>>2; u.qb=(i&1)?7-s:s; return true; }
  __device__ __forceinline__ void a_ready(const AttnUnit&)const{}
  __device__ __forceinline__ void done(const AttnUnit&)const{}
};
template<class Sched,int THRL=8> __device__ __forceinline__ void attn_phase(char*lds,const AttnTensors&T,const Sched&S,const int wave_id){
  AttnUnit u;
  for(int i=0;S.next(i,u);++i){ S.a_ready(u); attn_unit<THRL>(wave_id,u.bh/NHEAD,u.bh%NHEAD,u.qb,T.QN,T.QP,T.KN,T.KP,T.V,T.O,lds); S.done(u); }
}
#undef SBAR
#undef WAIT_BAR
}

#define LAS __attribute__((address_space(3)))
#define CAS __attribute__((address_space(4)))
#define KPTR(T, ap64, i) ((T*)(__attribute__((address_space(1))) T*)(ap64)[i])
constexpr int RING_OFF = 0, RING_BYTES = 131072, LDSCTL_OFF = RING_BYTES, MISC_OFF = LDSCTL_OFF + 320, XCH_OFF = LDSCTL_OFF + 1024  , LDS_BYTES = 147456;
constexpr int N_PHASES = 3 + 7 * DEPTH;
constexpr int CW_P4 = 213760  , CW_WIN = 230144  , CW_S4 = 230400  ;
constexpr int CW_MX = 193024  , CW_GL = 209408  , CW_DR = 211456  ;
constexpr int CW_G5 = 172032  , CW_P6 = 176128  , CW_S5 = 192512, CW_S6 = 192768  ;
constexpr int CW_BAR = 4096, CW_CNT = 160000, CW_Q3 = 170000, CW_Q2 = 171000;
#define XB_TMO      128
#define XB_XCNT(j)  (256  + 64 * (j))
#define XB_XSUB(j)  (1280 + 64 * (j))
#define XB_XGEN(j)  (2304 + 64 * (j))
#define XB_TOP      3328
#define XB_TOPGEN   3392
#define XCD_BAR_WORDS 3456
#define XB_SPIN_CAP (1u << 18)

__device__ __forceinline__ unsigned xb_ld(unsigned* p)              { return __hip_atomic_load(p, __ATOMIC_RELAXED, __HIP_MEMORY_SCOPE_AGENT); }
__device__ __forceinline__ unsigned xb_add(unsigned* p, unsigned v) { return __hip_atomic_fetch_add(p, v, __ATOMIC_RELAXED, __HIP_MEMORY_SCOPE_AGENT); }
__device__ __forceinline__ unsigned xb_xcc_id() { return (unsigned)__builtin_amdgcn_s_getreg((3 << 11) | 20) & 0xFu; }
#define XB_SPIN(cond, bar) do { unsigned _sp = 0; while (cond) { __builtin_amdgcn_s_sleep(1); \
    if ((++_sp & 255u) == 0u) { if (xb_ld(&(bar)[XB_TMO])) break; if (_sp > XB_SPIN_CAP) { atomicAdd(&(bar)[XB_TMO], 1u); break; } } } } while (0)

struct XcdBarrier {
    unsigned* bar; unsigned x;
    volatile LAS unsigned* st;
};

__device__ __forceinline__ XcdBarrier xcd_barrier_post(unsigned* bar, volatile LAS unsigned* st, const bool t0  ) {
    XcdBarrier b; b.bar = bar; b.x = xb_xcc_id(); b.st = st;
    if (t0) (void)xb_add(&bar[XB_XCNT(b.x)], 1u);
    return b;
}
__device__ __forceinline__ void xcd_barrier_complete(unsigned* bar, unsigned x, unsigned& nloc, unsigned& nx) {
    const unsigned G = gridDim.x * gridDim.y * gridDim.z;
    unsigned sum, cnt, mine, sp = 0u;
    for (;;) {
        sum = 0u; cnt = 0u; mine = 0u;
#pragma unroll
        for (unsigned j = 0; j < 16; ++j) { const unsigned c = xb_ld(&bar[XB_XCNT(j)]); sum += c; cnt += (c > 0u) ? 1u : 0u; mine = (j == x) ? c : mine; }
        if (sum == G) break;
        __builtin_amdgcn_s_sleep(1);
        if ((++sp & 255u) == 0u) { if (xb_ld(&bar[XB_TMO])) break; if (sp > XB_SPIN_CAP) { atomicAdd(&bar[XB_TMO], 1u); break; } }
    }
    nloc = mine > 0u ? mine : 1u; nx = cnt > 0u ? cnt : 1u;
}

template <bool ARRIVE_ONLY = false>
__device__ __forceinline__ void xcd_barrier(const XcdBarrier& b, const bool t0) {
    asm volatile("s_waitcnt vmcnt(0)" ::: "memory");
    __syncthreads();
    if (t0) {
        unsigned* bar = b.bar; unsigned bx_ = b.x; asm volatile("" : "+s"(bx_));
        __builtin_amdgcn_s_waitcnt(0);
        unsigned nloc = b.st[0], nx = b.st[1];
        if (nloc == 0u) { xcd_barrier_complete(bar, bx_, nloc, nx); b.st[0] = nloc; b.st[1] = nx; }
        const unsigned old = xb_add(&bar[XB_XSUB(bx_)], 1u);
        const unsigned gen = old / nloc;
        if (old + 1u == (gen + 1u) * nloc) {
            __builtin_amdgcn_fence(__ATOMIC_RELEASE, "agent");
            asm volatile("s_waitcnt vmcnt(0)" ::: "memory");
            const unsigned og = xb_add(&bar[XB_TOP], 1u);
            const unsigned tg = og / nx;
            if (og + 1u == (tg + 1u) * nx) xb_add(&bar[XB_TOPGEN], 1u);
            else XB_SPIN(xb_ld(&bar[XB_TOPGEN]) == tg, bar);
            __builtin_amdgcn_fence(__ATOMIC_ACQUIRE, "agent");
            xb_add(&bar[XB_XGEN(bx_)], 1u);
            asm volatile("s_waitcnt vmcnt(0)" ::: "memory");
            if constexpr (ARRIVE_ONLY) b.st[2] = 0xFFFFFFFFu;
        } else if constexpr (ARRIVE_ONLY) { b.st[2] = gen;
        } else {
            XB_SPIN(xb_ld(&bar[XB_XGEN(bx_)]) == gen, bar);
            __builtin_amdgcn_fence(__ATOMIC_ACQUIRE, "agent");
            asm volatile("s_waitcnt vmcnt(0)" ::: "memory");
        }
    }
    __syncthreads();
}
__device__ __forceinline__ void xcd_barrier_wait(const XcdBarrier& b, const bool t0) {
    if (t0) { unsigned* bar = b.bar; unsigned bx_ = b.x; asm volatile("" : "+s"(bx_)); const unsigned gen = b.st[2];
        if (gen != 0xFFFFFFFFu) { XB_SPIN(xb_ld(&bar[XB_XGEN(bx_)]) == gen, bar); __builtin_amdgcn_fence(__ATOMIC_ACQUIRE, "agent"); asm volatile("s_waitcnt vmcnt(0)" ::: "memory"); } }
    __syncthreads();
}

struct MKArgs { const float* in[35]; float* out; unsigned char* ws; int ph_lo, ph_hi, li, pad; };
static_assert(sizeof(MKArgs) == 37 * 8 + 16 && offsetof(MKArgs, out) == 35 * 8 && offsetof(MKArgs, ws) == 36 * 8, "MKArgs has no padding; KPTR indices");
static_assert((CW_BAR + 32 * XCD_BAR_WORDS) <= CW_CNT && (CW_CNT + DEPTH * SB * 64) <= CW_Q3 && (CW_Q3 + DEPTH * 128) * 4 <= (int)CTL_BYTES, "control words");

enum { CV_WIN = 0, CV_WQB, CV_WKV, CV_T, CV_WFFI };
DEV f32x4 cvt_src4(int kind, const float* src, const float* src2, const float* gain, int ld, int k, int n) {
    f32x4 v = (f32x4){0.f, 0.f, 0.f, 0.f}; float g = 1.f;
    if (kind == CV_WIN) { const int c = colmap_win(n); if (c >= 0) { v = *(const f32x4*)(src + (size_t)k * DIN + c); g = gain[k]; } }
    else if (kind == CV_WQB) { v = *(const f32x4*)(src + (size_t)k * 768 + colmap_qb(n)); g = gain[k]; }
    else if (kind == CV_WKV) { if (k < 128) { const int nn = n & 511; v = *(const f32x4*)((n < 512 ? src : src2) + ((size_t)k * 8 + (nn >> 6)) * 64 + (nn & 63)); g = gain[k]; } }
    else if (kind == CV_T) v = *(const f32x4*)(src + (size_t)k * ld + n);
    else { v = *(const f32x4*)(src + (size_t)k * DFF2 + colmap_ffi(n)); g = gain[k]; }
    return v * g;
}
struct CvtMat { const float* src; const float* src2; const float* gain; bf16_t* dst; int kind, N, K, ld, tm; };
#define CVT_TILES_PER_LAYER 2880
#ifndef CVT_Q0
#define CVT_Q0 0
#endif
#ifndef CVT_CH
#define CVT_CH 4
#endif
#ifndef CVT_CUT_A
#define CVT_CUT_A 1088
#endif
#ifndef CVT_CUT_B
#define CVT_CUT_B 1760
#endif
template <class AP> DEV CvtMat cvt_mat_of(int L, int t, unsigned char* ws, AP ap) {
    unsigned char* wl = ws + WS_W + (size_t)L * WL_SIZE; CvtMat m;
    if (t < 384) { m = CvtMat{KPTR(const float, ap, 9) + (size_t)L * DM * DIN, nullptr, KPTR(const float, ap, 8) + L * DM, (bf16_t*)(wl + WL_IN), CV_WIN, DINP, DM, 0, t}; }
    else if (t < 432) { m = CvtMat{KPTR(const float, ap, 21) + (size_t)L * 256 * 768, nullptr, KPTR(const float, ap, 20) + L * 256, (bf16_t*)(wl + WL_QB), CV_WQB, 768, 256, 0, t - 384}; }
    else if (t < 496) { m = CvtMat{KPTR(const float, ap, 23) + (size_t)L * 128 * 512, KPTR(const float, ap, 24) + (size_t)L * 128 * 512, KPTR(const float, ap, 22) + L * 128, (bf16_t*)(wl + WL_KV), CV_WKV, 1024, 256, 0, t - 432}; }
    else if (t < 512) { m = CvtMat{KPTR(const float, ap, 18) + (size_t)L * 65536, nullptr, nullptr, (bf16_t*)(wl + WL_GLU), CV_T, 256, 256, 256, t - 496}; }
    else if (t < 768) { m = CvtMat{KPTR(const float, ap, 28) + (size_t)L * DM * DM, nullptr, nullptr, (bf16_t*)(wl + WL_OUT), CV_T, DM, DM, DM, t - 512}; }
    else if (t < 2176) { m = CvtMat{KPTR(const float, ap, 30) + (size_t)L * DM * DFF2, nullptr, KPTR(const float, ap, 29) + L * DM, (bf16_t*)(wl + WL_FFI), CV_WFFI, DFF2, DM, 0, t - 768}; }
    else { m = CvtMat{KPTR(const float, ap, 33) + (size_t)L * DFF * DM, nullptr, nullptr, (bf16_t*)(wl + WL_FFO), CV_T, DM, DFF, DM, t - 2176}; }
    return m;
}
template <class AP> DEV void cvt_layer_wg(int L, int wgi, int nwg, int tid, LAS unsigned char* sm, unsigned char* ws, AP ap, int t_begin = 0, int t_end = CVT_TILES_PER_LAYER) {
    LAS bf16_t* T = (LAS bf16_t*)sm;
    const int kk = tid >> 3, nq = tid & 7;
    f32x4 c0 = (f32x4){0.f, 0.f, 0.f, 0.f}, c1 = c0;
    int t = t_begin + wgi;
    if (t < t_end) { const CvtMat m = cvt_mat_of(L, t, ws, ap); const int nb = m.N / 64, k0 = 64 * (m.tm / nb), n0 = 64 * (m.tm % nb);
        c0 = cvt_src4(m.kind, m.src, m.src2, m.gain, m.ld, k0 + kk, n0 + 8 * nq); c1 = cvt_src4(m.kind, m.src, m.src2, m.gain, m.ld, k0 + kk, n0 + 8 * nq + 4); }
    for (; t < t_end; t += nwg) {
        const CvtMat m = cvt_mat_of(L, t, ws, ap); const int nb = m.N / 64, k0 = 64 * (m.tm / nb), n0 = 64 * (m.tm % nb);
        lds_barrier();
#pragma unroll
        for (int e = 0; e < 4; ++e) { T[(8 * nq + e) * 72 + kk] = f2bf(c0[e]); T[(8 * nq + 4 + e) * 72 + kk] = f2bf(c1[e]); }
        if (t + nwg < t_end) { const CvtMat m2 = cvt_mat_of(L, t + nwg, ws, ap); const int nb2 = m2.N / 64, k2 = 64 * (m2.tm / nb2), n2 = 64 * (m2.tm % nb2);
            c0 = cvt_src4(m2.kind, m2.src, m2.src2, m2.gain, m2.ld, k2 + kk, n2 + 8 * nq); c1 = cvt_src4(m2.kind, m2.src, m2.src2, m2.gain, m2.ld, k2 + kk, n2 + 8 * nq + 4); }
        lds_barrier();
        { const int nl = tid >> 3, kc = tid & 7; *(u32x4*)(m.dst + (size_t)(n0 + nl) * m.K + k0 + 8 * kc) = *(const LAS u32x4*)(T + nl * 72 + 8 * kc); }
    }
    lds_barrier();
}
DEV void s5_pre_item(const float* a_re, const float* a_im, const float* log_dt, const float* b_re, const float* b_im, unsigned char* ws, int lg, int p) {
    const float dt = expf(log_dt[lg]);
    const double lr = a_re[lg * 64 + p], li = a_im[lg * 64 + p];
    const double er = exp(lr * dt), ar = er * cos(li * dt), ai = er * sin(li * dt);
    const double nr = ar - 1.0, ni = ai, den = lr * lr + li * li;
    const double cr = (nr * lr + ni * li) / den, ci = (ni * lr - nr * li) / den;
    float2* abar = (float2*)(ws + WS_S5 + (size_t)lg * S5_SIZE + S5_ABAR);
    float2* bbar = (float2*)(ws + WS_S5 + (size_t)lg * S5_SIZE + S5_BBAR);
    abar[p] = make_float2((float)ar, (float)ai);
    for (int c = 0; c < 16; ++c) { const double br = b_re[((size_t)lg * 64 + p) * 16 + c], bi = b_im[((size_t)lg * 64 + p) * 16 + c];
        bbar[p * 16 + c] = make_float2((float)(cr * br - ci * bi), (float)(cr * bi + ci * br)); }
}
DEV void rope_item(unsigned char* ws, int id) {
    const int pr = id >> 4, i = id & 15; const double pos = pr < SEQ ? (double)pr : (double)PAST;
    const float inv = (float)pow(10000.0, -(double)i / 16.0);
    const double ang = pos * (double)inv;
    ((float*)(ws + WS_COS))[id] = (float)cos(ang); ((float*)(ws + WS_SIN))[id] = (float)sin(ang);
}
DEV void xprep_row(const float* x, bf16_t* xb, float* rs, int row, int lane) {
    const f32x4* xr = (const f32x4*)(x + (size_t)row * DM) + lane;
    float part[4];
#pragma unroll
    for (int j = 0; j < 4; ++j) { const f32x4 v = xr[64 * j]; part[j] = wave_sum((v.x * v.x + v.y * v.y) + (v.z * v.z + v.w * v.w));
        u32x2 o; o.x = pk2(v.x, v.y); o.y = pk2(v.z, v.w); *(u32x2*)(xb + (size_t)row * DM + 256 * j + 4 * lane) = o; }
    if (lane < 16) rs[(size_t)row * 16 + lane] = (lane & 3) ? 0.f : (lane == 0 ? part[0] : lane == 4 ? part[1] : lane == 8 ? part[2] : part[3]);
}

DEV float2 cpow_(float lr, float li, float dt, int tau) {
    const float mag = expf((float)tau * lr * dt), ang = li * dt * (float)tau;
    float sn, cs; sincosf(ang, &sn, &cs); return make_float2(mag * cs, mag * sn);
}
DEV void s5_mat_T(const float* a_re, const float* a_im, const float* log_dt, const float* c_re, const float* c_im, unsigned char* ws, int id) {
    const int cg = id & 1, c = (id >> 1) & 15, dj = ((id >> 5) % 63) - 31, lg = id / (32 * 63);
    float kk[8];
#pragma unroll
    for (int i = 0; i < 8; ++i) kk[i] = 0.f;
    if (dj >= 0) { const float2* bb = (const float2*)(ws + WS_S5 + (size_t)lg * S5_SIZE + S5_BBAR); const float2* apw = (const float2*)(ws + WS_APOW) + ((size_t)lg * 33 + dj) * 64;
        for (int p = 0; p < 64; ++p) { const float2 ap = apw[p];
            const float cr = c_re[((size_t)lg * 16 + c) * 64 + p], ci = c_im[((size_t)lg * 16 + c) * 64 + p];
            const float br = cr * ap.x - ci * ap.y, bi = cr * ap.y + ci * ap.x;
#pragma unroll
            for (int i = 0; i < 8; ++i) { const float2 b = bb[p * 16 + cg * 8 + i]; kk[i] += br * b.x - bi * b.y; } } }
    u32x4 o; o.x = pk2(kk[0], kk[1]); o.y = pk2(kk[2], kk[3]); o.z = pk2(kk[4], kk[5]); o.w = pk2(kk[6], kk[7]);
    bf16_t* T = (bf16_t*)(ws + WS_S5 + (size_t)lg * S5_SIZE + S5_TQ);
    const int j0 = dj >= 0 ? dj : 0, j1 = dj >= 0 ? 31 : 31 + dj;
    for (int j = j0; j <= j1; ++j) *(u32x4*)(T + (size_t)(j * 16 + c) * 512 + (j - dj) * 16 + cg * 8) = o;
}
DEV void s5_mat_Q(const float* a_re, const float* a_im, const float* log_dt, unsigned char* ws, int id) {
    const int jp = id & 31, sidx = (id >> 5) & 127, lg = id >> 12, p = sidx & 63;
    const float2 ap = ((const float2*)(ws + WS_APOW))[((size_t)lg * 33 + (31 - jp)) * 64 + p];
    const float2* bb = (const float2*)(ws + WS_S5 + (size_t)lg * S5_SIZE + S5_BBAR) + p * 16;
    float v[16];
#pragma unroll
    for (int c = 0; c < 16; ++c) { const float2 b = bb[c]; v[c] = sidx < 64 ? ap.x * b.x - ap.y * b.y : ap.x * b.y + ap.y * b.x; }
    bf16_t* Q = (bf16_t*)(ws + WS_S5 + (size_t)lg * S5_SIZE + S5_TQ) + (size_t)(512 + sidx) * 512 + jp * 16;
    u32x4 o; o.x = pk2(v[0], v[1]); o.y = pk2(v[2], v[3]); o.z = pk2(v[4], v[5]); o.w = pk2(v[6], v[7]); *(u32x4*)Q = o;
    o.x = pk2(v[8], v[9]); o.y = pk2(v[10], v[11]); o.z = pk2(v[12], v[13]); o.w = pk2(v[14], v[15]); *(u32x4*)(Q + 8) = o;
}
DEV void s5_mat_P(const float* a_re, const float* a_im, const float* log_dt, const float* c_re, const float* c_im, unsigned char* ws, int id) {
    const int sg = id & 15, c = (id >> 4) & 15, j = (id >> 8) & 31, lg = id >> 13;
    float v[8];
#pragma unroll
    for (int i = 0; i < 8; ++i) { const int sidx = sg * 8 + i, p = sidx & 63; const float2 ap = ((const float2*)(ws + WS_APOW))[((size_t)lg * 33 + (j + 1)) * 64 + p];
        const float cr = c_re[((size_t)lg * 16 + c) * 64 + p], ci = c_im[((size_t)lg * 16 + c) * 64 + p];
        v[i] = sidx < 64 ? cr * ap.x - ci * ap.y : -(cr * ap.y + ci * ap.x); }
    u32x4 o; o.x = pk2(v[0], v[1]); o.y = pk2(v[2], v[3]); o.z = pk2(v[4], v[5]); o.w = pk2(v[6], v[7]);
    *(u32x4*)((bf16_t*)(ws + WS_S5 + (size_t)lg * S5_SIZE + S5_P) + (size_t)(j * 16 + c) * 128 + sg * 8) = o;
}
DEV void s5_task(int l, int b, int g, int wave, int lane, LAS unsigned char* sm, unsigned char* ws, float* out, const float* dskip) {
    const int lg = l * 16 + g, fr = lane & 15, fq = lane >> 4;
    const bf16_t* TQ = (const bf16_t*)(ws + WS_S5 + (size_t)lg * S5_SIZE + S5_TQ); const bf16_t* PM = (const bf16_t*)(ws + WS_S5 + (size_t)lg * S5_SIZE + S5_P);
    const bf16_t* U = (const bf16_t*)(ws + WS_U5) + ((size_t)g * M + (size_t)b * SEQ) * 16;
    LAS float* Hloc = (LAS float*)sm; LAS bf16_t* Hin = (LAS bf16_t*)(sm + 32768);
    f32x4 acc[5][4];
#pragma unroll
    for (int i = 0; i < 5; ++i)
#pragma unroll
        for (int nt = 0; nt < 4; ++nt) acc[i][nt] = (f32x4){0.f, 0.f, 0.f, 0.f};
    __syncthreads();
#pragma unroll 4
    for (int s = 0; s < 16; ++s) { const int k0 = 32 * s + 8 * fq;
        bf16x8 bfr[4];
#pragma unroll
        for (int nt = 0; nt < 4; ++nt) bfr[nt] = *(const bf16x8*)(U + (size_t)(nt * 16 + fr) * 512 + k0);
#pragma unroll
        for (int i = 0; i < 4; ++i) { const int rt = wave + 8 * i;
            if (2 * s <= rt) { const bf16x8 a = *(const bf16x8*)(TQ + (size_t)(rt * 16 + fr) * 512 + k0);
#pragma unroll
                for (int nt = 0; nt < 4; ++nt) acc[i][nt] = __builtin_amdgcn_mfma_f32_16x16x32_bf16(a, bfr[nt], acc[i][nt], 0, 0, 0); } }
        { const bf16x8 a = *(const bf16x8*)(TQ + (size_t)((32 + wave) * 16 + fr) * 512 + k0);
#pragma unroll
            for (int nt = 0; nt < 4; ++nt) acc[4][nt] = __builtin_amdgcn_mfma_f32_16x16x32_bf16(a, bfr[nt], acc[4][nt], 0, 0, 0); }
    }
#pragma unroll
    for (int nt = 0; nt < 4; ++nt) *(LAS f32x4*)(Hloc + (nt * 16 + fr) * 128 + 16 * wave + 4 * fq) = acc[4][nt];
    __syncthreads();
    if (wave == 0) { const float2 aL = ((const float2*)(ws + WS_S5 + (size_t)lg * S5_SIZE + S5_AL))[lane]; float hr = 0.f, hi = 0.f;
        for (int n = 0; n < 64; ++n) { Hin[n * 128 + lane] = f2bf(hr); Hin[n * 128 + 64 + lane] = f2bf(hi);
            const float lr = Hloc[n * 128 + lane], li = Hloc[n * 128 + 64 + lane];
            const float nr = aL.x * hr - aL.y * hi + lr, ni = aL.x * hi + aL.y * hr + li; hr = nr; hi = ni; }
        float* o = out + O_S5P + ((((size_t)l * NB + b) * S5G + g) * S5P + lane) * 2; o[0] = hr; o[1] = hi; }
    __syncthreads();
#pragma unroll
    for (int s = 0; s < 4; ++s) { const int k0 = 32 * s + 8 * fq;
        bf16x8 bfr[4];
#pragma unroll
        for (int nt = 0; nt < 4; ++nt) bfr[nt] = *(const LAS bf16x8*)(Hin + (nt * 16 + fr) * 128 + k0);
#pragma unroll
        for (int i = 0; i < 4; ++i) { const int rt = wave + 8 * i; const bf16x8 a = *(const bf16x8*)(PM + (size_t)(rt * 16 + fr) * 128 + k0);
#pragma unroll
            for (int nt = 0; nt < 4; ++nt) acc[i][nt] = __builtin_amdgcn_mfma_f32_16x16x32_bf16(a, bfr[nt], acc[i][nt], 0, 0, 0); } }
    const f32x4 dd = *(const f32x4*)(dskip + l * 256 + g * 16 + 4 * fq);
#pragma unroll
    for (int i = 0; i < 4; ++i) { const int rt = wave + 8 * i;
#pragma unroll
        for (int nt = 0; nt < 4; ++nt) { const int n = nt * 16 + fr; const size_t row = (size_t)b * SEQ + 32 * n + rt;
            const u32x2 uw = *(const u32x2*)((const bf16_t*)(ws + WS_U5) + ((size_t)g * M + row) * 16 + 4 * fq);
            const f32x4 uu = pg8::unpk_lo(uw.x, uw.y); f32x4 y = acc[i][nt] + dd * uu;
            u32x2 o; o.x = pk2(gelu_tanh(y[0]), gelu_tanh(y[1])); o.y = pk2(gelu_tanh(y[2]), gelu_tanh(y[3]));
            *(u32x2*)((bf16_t*)(ws + WS_Y5) + row * 256 + g * 16 + 4 * fq) = o; } }
}
DEV void misc_row(int l, int row, int lane, unsigned char* ws, float* out, const float* g_kv, const float* w_gate, const float* b_gate) {
    const float* t2 = (const float*)(ws + WS_T2F) + (size_t)row * 256;
    f32x4 v = (f32x4){0.f, 0.f, 0.f, 0.f}; if (lane < 44) v = *(const f32x4*)(t2 + 4 * lane);
    const float rk = pg8::rstd4((const float*)(ws + WS_RSKV), row, 1.f / 128.f);
    if (lane < 32) { const f32x4 g = *(const f32x4*)(g_kv + 4 * lane); *(f32x4*)(out + O_CKVP + ((size_t)l * M + row) * KVL + 4 * lane) = v * rk * g; }
    const int pos = row & (SEQ - 1);
    f32x4 pt;
#pragma unroll
    for (int e = 0; e < 4; ++e) pt[e] = shfl_xor_(v[e], 4);
    if (lane >= 32 && lane < 40) { const int q = lane - 32, qi = q & 3;
        const f32x4 cs = *(const f32x4*)((const float*)(ws + WS_COS) + pos * 16 + 4 * qi), sn = *(const f32x4*)((const float*)(ws + WS_SIN) + pos * 16 + 4 * qi);
        const f32x4 o = q < 4 ? v * cs - pt * sn : pt * sn + v * cs;
        *(f32x4*)(out + O_KRP + ((size_t)l * M + row) * ROPE + 4 * q) = o;
        u32x2 w; w.x = pk2(o[0], o[1]); w.y = pk2(o[2], o[3]); *(u32x2*)((bf16_t*)(ws + WS_KP) + (size_t)row * 32 + 8 * qi + 4 * (q >> 2)) = w; }
}
DEV void misc_rows4(int l, int row0, int lane, unsigned char* ws, float* out, const float* g_kv) {
    f32x4 v[4], cs[4], sn[4]; float rk[4];
    const int q = lane - 32, qi = q & 3; const bool rp = lane >= 32 && lane < 40;
#pragma unroll
    for (int r = 0; r < 4; ++r) { const int row = row0 + r; const float* t2 = (const float*)(ws + WS_T2F) + (size_t)row * 256;
        v[r] = (f32x4){0.f, 0.f, 0.f, 0.f}; if (lane < 44) v[r] = *(const f32x4*)(t2 + 4 * lane);
        rk[r] = pg8::rstd4((const float*)(ws + WS_RSKV), row, 1.f / 128.f);
        cs[r] = v[r]; sn[r] = v[r];
        if (rp) { const int pos = row & (SEQ - 1); cs[r] = *(const f32x4*)((const float*)(ws + WS_COS) + pos * 16 + 4 * qi); sn[r] = *(const f32x4*)((const float*)(ws + WS_SIN) + pos * 16 + 4 * qi); } }
    f32x4 g = (f32x4){0.f, 0.f, 0.f, 0.f}; if (lane < 32) g = *(const f32x4*)(g_kv + 4 * lane);
#pragma unroll
    for (int r = 0; r < 4; ++r) { const int row = row0 + r;
        if (lane < 32) *(f32x4*)(out + O_CKVP + ((size_t)l * M + row) * KVL + 4 * lane) = v[r] * rk[r] * g;
        f32x4 pt;
#pragma unroll
        for (int e = 0; e < 4; ++e) pt[e] = shfl_xor_(v[r][e], 4);
        if (rp) { const f32x4 o = q < 4 ? v[r] * cs[r] - pt * sn[r] : pt * sn[r] + v[r] * cs[r];
            *(f32x4*)(out + O_KRP + ((size_t)l * M + row) * ROPE + 4 * q) = o;
            u32x2 w; w.x = pk2(o[0], o[1]); w.y = pk2(o[2], o[3]); *(u32x2*)((bf16_t*)(ws + WS_KP) + (size_t)row * 32 + 8 * qi + 4 * (q >> 2)) = w; } }
}
template <int CTRL, int RMASK> DEV float dpp0(float x) { return __builtin_bit_cast(float, __builtin_amdgcn_update_dpp(0, __builtin_bit_cast(int, x), CTRL, RMASK, 0xf, false)); }
DEV float wave_scan_incl(float x, int row16  ) { x += dpp0<0x111, 0xf>(x); x += dpp0<0x112, 0xf>(x); x += dpp0<0x114, 0xf>(x); x += dpp0<0x118, 0xf>(x);
    const float t0 = shfl_(x, 15), t1 = shfl_(x, 31), t2 = shfl_(x, 47);
    return x + (row16 == 0 ? 0.f : row16 == 1 ? t0 : row16 == 2 ? t0 + t1 : (t0 + t1) + t2); }
DEV float shfl_up_add(float x, int lane, int off) { const float t = shfl_(x, lane >= off ? lane - off : lane); return lane >= off ? x + t : x; }
DEV void gla_task(int l, int b, int h, int wave, int lane, LAS unsigned char* sm, unsigned char* ws, float* out, const float* gn, const float* w_gate, const float* b_gate) {
    constexpr int QS = 40, KS2 = 72;
    constexpr int RQ = 32, RG = 16, RV = 64, RAWB = 64 * RQ * 4 * 2 + 64 * RG * 4 + 64 * RV * 2 * 2;
    LAS bf16_t* QE = (LAS bf16_t*)sm; LAS bf16_t* KE = QE + 64 * QS; LAS bf16_t* KDT = KE + 64 * QS; LAS bf16_t* VT = KDT + 32 * KS2; LAS bf16_t* ST = VT + 64 * KS2; LAS float* DEC = (LAS float*)(ST + 2 * 64 * QS); LAS float* WG = DEC + 32;
    LAS bf16_t* OUTS = (LAS bf16_t*)(WG + 512);
    LAS unsigned char* RAW = (LAS unsigned char*)(OUTS + 2 * 64 * RV);
    static_assert((64 * QS * 2 * 2 + 32 * KS2 * 2 + 64 * KS2 * 2 + 2 * 64 * QS * 2 + 128 + 2048 + 2 * 64 * RV * 2 + 2 * RAWB) <= RING_BYTES, "GLA LDS");
    const float* QKF = (const float*)(ws + WS_QKF); const float* T2F = (const float*)(ws + WS_T2F);
    const bf16_t* GVB = (const bf16_t*)(ws + WS_GVB); const bf16_t* GRB = (const bf16_t*)(ws + WS_GRB); bf16_t* MIX = (bf16_t*)(ws + WS_MIX);
    const int fr = lane & 15, fq = lane >> 4, t = wave * 64 + lane, lrow = t >> 3, lpc = t & 7;
    __syncthreads();
    for (int i = t; i < 64 * QS / 2; i += 512) ((LAS unsigned*)ST)[i] = 0u;
    const f32x4 bg4 = *(const f32x4*)(b_gate + h * 32 + 4 * wave);
    f32x4 wg[16];
#pragma unroll
    for (int r = 0; r < 16; ++r) wg[r] = *(const f32x4*)(w_gate + (size_t)r * 128 + h * 32 + 4 * wave);
    f32x4 S0 = (f32x4){0.f, 0.f, 0.f, 0.f}, S1 = S0;
    const int x4 = wave - 4, sdt = (x4 >> 1) & 1, svt = 2 * (x4 & 1);
    float gg4[4];
#pragma unroll
    for (int vt = 0; vt < 4; ++vt) gg4[vt] = gn[l * 256 + h * 64 + 16 * vt + fr];
    f32x4 lq, lk, lg; u32x4 lv, lr;
#define GLA_LOAD(n_) do { const size_t r_ = (size_t)b * SEQ + (size_t)(n_) * 64 + lrow; lq = *(const f32x4*)(QKF + r_ * 256 + h * 32 + 4 * lpc); lk = *(const f32x4*)(QKF + r_ * 256 + 128 + h * 32 + 4 * lpc); \
        lv = *(const u32x4*)(GVB + r_ * 256 + h * 64 + 8 * lpc); lr = *(const u32x4*)(GRB + r_ * 256 + h * 64 + 8 * lpc); if (t < 256) lg = *(const f32x4*)(T2F + ((size_t)b * SEQ + (size_t)(n_) * 64 + (t >> 2)) * 256 + 160 + 4 * (t & 3)); } while (0)
#define GLA_STASH(buf_) do { LAS unsigned char* rw_ = RAW + (buf_) * RAWB; const int sw_ = lpc ^ ((lrow >> 1) & 7); *(LAS f32x4*)((LAS float*)rw_ + lrow * RQ + 4 * sw_) = lq; *(LAS f32x4*)((LAS float*)rw_ + 64 * RQ + lrow * RQ + 4 * sw_) = lk; \
        if (t < 256) *(LAS f32x4*)((LAS float*)rw_ + 2 * 64 * RQ + (t >> 2) * RG + 4 * ((t & 3) ^ ((t >> 4) & 3))) = lg; \
        LAS bf16_t* rb_ = (LAS bf16_t*)(rw_ + 2 * 64 * RQ * 4 + 64 * RG * 4); *(LAS u32x4*)(rb_ + lrow * RV + 8 * sw_) = lv; *(LAS u32x4*)(rb_ + 64 * RV + lrow * RV + 8 * sw_) = lr; } while (0)
    GLA_LOAD(0); GLA_STASH(0); GLA_LOAD(1);
    __syncthreads();
    for (int n = 0; n < SEQ / 64; ++n) {
        const LAS float* rq = (const LAS float*)(RAW + (n & 1) * RAWB); const LAS float* rk = rq + 64 * RQ; const LAS float* rg = rk + 64 * RQ;
        const LAS bf16_t* rv = (const LAS bf16_t*)(rg + 64 * RG); const LAS bf16_t* rr = rv + 64 * RV;
        { f32x4 bb = bg4;
#pragma unroll
            for (int r = 0; r < 4; ++r) { const f32x4 g4 = *(const LAS f32x4*)(rg + lane * RG + 4 * (r ^ ((lane >> 2) & 3)));
#pragma unroll
                for (int e = 0; e < 4; ++e) bb = bb + wg[4 * r + e] * g4[e]; }
#pragma unroll
            for (int e = 0; e < 4; ++e) bb[e] = log_sigmoid(bb[e]) * (1.f / 16.f);
#pragma unroll
            for (int e = 0; e < 4; ++e) bb[e] = wave_scan_incl(bb[e], fq);
            const int swl = wave ^ ((lane >> 1) & 7);
            const f32x4 q4 = *(const LAS f32x4*)(rq + lane * RQ + 4 * swl), k4 = *(const LAS f32x4*)(rk + lane * RQ + 4 * swl);
            f32x4 bl, qe, ke, kd;
#pragma unroll
            for (int e = 0; e < 4; ++e) { bl[e] = shfl_(bb[e], 63); const float eb = fexp(bb[e]); qe[e] = q4[e] * 0.17677669529663687f * eb; ke[e] = k4[e] * __builtin_amdgcn_rcpf(eb); kd[e] = k4[e] * fexp(bl[e] - bb[e]); }
            u32x2 w; w.x = pk2(qe[0], qe[1]); w.y = pk2(qe[2], qe[3]); *(LAS u32x2*)(QE + lane * QS + 4 * wave) = w;
            w.x = pk2(ke[0], ke[1]); w.y = pk2(ke[2], ke[3]); *(LAS u32x2*)(KE + lane * QS + 4 * wave) = w;
#pragma unroll
            for (int e = 0; e < 4; ++e) KDT[(4 * wave + e) * KS2 + lane] = f2bf(kd[e]);
            if (lane == 0) {
#pragma unroll
                for (int e = 0; e < 4; ++e) DEC[4 * wave + e] = fexp(bl[e]); }
            const u32x4 v8 = *(const LAS u32x4*)(rv + lane * RV + 8 * swl);
            const unsigned vw[4] = {v8.x, v8.y, v8.z, v8.w};
#pragma unroll
            for (int e = 0; e < 4; ++e) { VT[(8 * wave + 2 * e) * KS2 + lane] = (bf16_t)(vw[e] & 0xffffu); VT[(8 * wave + 2 * e + 1) * KS2 + lane] = (bf16_t)(vw[e] >> 16); }
        }
        lds_barrier();
        if (n + 1 < SEQ / 64) GLA_STASH((n + 1) & 1);
        if (n + 2 < SEQ / 64) GLA_LOAD(n + 2);
        if (n > 0) { const u32x4 ov = *(const LAS u32x4*)(OUTS + ((n - 1) & 1) * 64 * RV + lrow * RV + 8 * lpc); *(u32x4*)(MIX + ((size_t)b * SEQ + (size_t)(n - 1) * 64 + lrow) * DM + 768 + h * 64 + 8 * lpc) = ov; }
        const LAS bf16_t* STc = ST + (n & 1) * 64 * QS; LAS bf16_t* STn = ST + ((n + 1) & 1) * 64 * QS;
        if (wave < 4) {
            const int it = wave;
            const bf16x8 qf = *(const LAS bf16x8*)(QE + (16 * it + fr) * QS + 8 * fq);
            f32x4 at[4];
#pragma unroll
            for (int jt = 0; jt < 4; ++jt) { at[jt] = (f32x4){0.f, 0.f, 0.f, 0.f};
                if (jt <= it) { const bf16x8 kf = *(const LAS bf16x8*)(KE + (16 * jt + fr) * QS + 8 * fq);
                    at[jt] = __builtin_amdgcn_mfma_f32_16x16x32_bf16(kf, qf, at[jt], 0, 0, 0);
                    if (jt == it) {
#pragma unroll
                        for (int e = 0; e < 4; ++e) if (4 * fq + e > fr) at[jt][e] = 0.f; } } }
            u32x4 af[2];
#pragma unroll
            for (int s2 = 0; s2 < 2; ++s2) { af[s2].x = pk2(at[2 * s2][0], at[2 * s2][1]); af[s2].y = pk2(at[2 * s2][2], at[2 * s2][3]); af[s2].z = pk2(at[2 * s2 + 1][0], at[2 * s2 + 1][1]); af[s2].w = pk2(at[2 * s2 + 1][2], at[2 * s2 + 1][3]); }
            f32x4 o[4]; float ss[4] = {0.f, 0.f, 0.f, 0.f};
#pragma unroll
            for (int vt = 0; vt < 4; ++vt) { o[vt] = (f32x4){0.f, 0.f, 0.f, 0.f};
                const bf16x8 sf = *(const LAS bf16x8*)(STc + (16 * vt + fr) * QS + 8 * fq);
                o[vt] = __builtin_amdgcn_mfma_f32_16x16x32_bf16(qf, sf, o[vt], 0, 0, 0);
#pragma unroll
                for (int s2 = 0; s2 < 2; ++s2) if (2 * s2 <= it) {
                    const u32x2 v0 = *(const LAS u32x2*)(VT + (16 * vt + fr) * KS2 + 32 * s2 + 4 * fq), v1 = *(const LAS u32x2*)(VT + (16 * vt + fr) * KS2 + 32 * s2 + 16 + 4 * fq);
                    const u32x4 vf = {v0.x, v0.y, v1.x, v1.y};
                    o[vt] = __builtin_amdgcn_mfma_f32_16x16x32_bf16(__builtin_bit_cast(bf16x8, af[s2]), __builtin_bit_cast(bf16x8, vf), o[vt], 0, 0, 0); }
#pragma unroll
                for (int e = 0; e < 4; ++e) ss[e] += o[vt][e] * o[vt][e]; }
#pragma unroll
            for (int e = 0; e < 4; ++e) { float tt = ss[e]; tt += shfl_xor_(tt, 1); tt += shfl_xor_(tt, 2); tt += shfl_xor_(tt, 4); tt += shfl_xor_(tt, 8); ss[e] = rsqrtf(tt * (1.f / 64.f) + EPS); }
            LAS bf16_t* oo = OUTS + (n & 1) * 64 * RV;
            bf16_t grw[4][4];
#pragma unroll
            for (int vt = 0; vt < 4; ++vt)
#pragma unroll
                for (int e = 0; e < 4; ++e) { const int i2 = 16 * it + 4 * fq + e, v = 16 * vt + fr; grw[vt][e] = rr[i2 * RV + 8 * ((v >> 3) ^ ((i2 >> 1) & 7)) + (v & 7)]; }
#pragma unroll
            for (int vt = 0; vt < 4; ++vt) { const int v = 16 * vt + fr; const float gg = gg4[vt];
#pragma unroll
                for (int e = 0; e < 4; ++e) { const int i2 = 16 * it + 4 * fq + e; const float gr = bf2f(grw[vt][e]);
                    oo[i2 * RV + v] = f2bf(o[vt][e] * ss[e] * gg * gr * sigmoidf_(gr)); } }
        } else {
            f32x4 u0 = (f32x4){0.f, 0.f, 0.f, 0.f}, u1 = u0;
#pragma unroll
            for (int s2 = 0; s2 < 2; ++s2) { const bf16x8 kf = *(const LAS bf16x8*)(KDT + (16 * sdt + fr) * KS2 + 32 * s2 + 8 * fq);
                const bf16x8 va = *(const LAS bf16x8*)(VT + (16 * svt + fr) * KS2 + 32 * s2 + 8 * fq), vb2 = *(const LAS bf16x8*)(VT + (16 * (svt + 1) + fr) * KS2 + 32 * s2 + 8 * fq);
                u0 = __builtin_amdgcn_mfma_f32_16x16x32_bf16(kf, va, u0, 0, 0, 0); u1 = __builtin_amdgcn_mfma_f32_16x16x32_bf16(kf, vb2, u1, 0, 0, 0); }
            const f32x4 dc = *(const LAS f32x4*)(DEC + 16 * sdt + 4 * fq);
            S0 = dc * S0 + u0; S1 = dc * S1 + u1;
            u32x2 w; w.x = pk2(S0[0], S0[1]); w.y = pk2(S0[2], S0[3]); *(LAS u32x2*)(STn + (16 * svt + fr) * QS + 16 * sdt + 4 * fq) = w;
            w.x = pk2(S1[0], S1[1]); w.y = pk2(S1[2], S1[3]); *(LAS u32x2*)(STn + (16 * (svt + 1) + fr) * QS + 16 * sdt + 4 * fq) = w;
        }
        lds_barrier();
    }
#undef GLA_LOAD
#undef GLA_STASH
    { const u32x4 ov = *(const LAS u32x4*)(OUTS + ((SEQ / 64 - 1) & 1) * 64 * RV + lrow * RV + 8 * lpc); *(u32x4*)(MIX + ((size_t)b * SEQ + (size_t)(SEQ / 64 - 1) * 64 + lrow) * DM + 768 + h * 64 + 8 * lpc) = ov; }
    if (wave >= 4) { float* so = out + O_GLAP + (((size_t)l * NB + b) * GH + h) * GDK * GDV;
#pragma unroll
        for (int e = 0; e < 4; ++e) { so[(16 * sdt + 4 * fq + e) * GDV + 16 * svt + fr] = S0[e]; so[(16 * sdt + 4 * fq + e) * GDV + 16 * (svt + 1) + fr] = S1[e]; } }
}
template <bool F32A, bool PAIR, class Epi> DEV void sgemm_wg(const void* Aptr, int lda, const bf16_t* Bt, int ldb, int K, int n0, int n1, int wave, int lane, LAS float* red, Epi epi) {
    const int r32 = lane & 31, hi = lane >> 5, kper = K / 8, kb = wave * kper;
    f32x16 acc0, acc1;
#pragma unroll
    for (int r = 0; r < 16; ++r) { acc0[r] = 0.f; acc1[r] = 0.f; }
    float ss = 0.f;
    const bf16_t* bp0 = Bt + (size_t)(n0 + r32) * ldb + 8 * hi; const bf16_t* bp1 = Bt + (size_t)(n1 + r32) * ldb + 8 * hi;
    __syncthreads();
#pragma unroll 8
    for (int k = kb; k < kb + kper; k += 16) {
        bf16x8 a;
        if (F32A) { const float* ap = (const float*)Aptr + (size_t)r32 * lda + k + 8 * hi; const f32x4 x0 = *(const f32x4*)ap, x1 = *(const f32x4*)(ap + 4);
            ss += (x0.x * x0.x + x0.y * x0.y) + (x0.z * x0.z + x0.w * x0.w) + (x1.x * x1.x + x1.y * x1.y) + (x1.z * x1.z + x1.w * x1.w);
            u32x4 w; w.x = pk2(x0.x, x0.y); w.y = pk2(x0.z, x0.w); w.z = pk2(x1.x, x1.y); w.w = pk2(x1.z, x1.w); a = __builtin_bit_cast(bf16x8, w); }
        else a = *(const bf16x8*)((const bf16_t*)Aptr + (size_t)r32 * lda + k + 8 * hi);
        acc0 = __builtin_amdgcn_mfma_f32_32x32x16_bf16(a, *(const bf16x8*)(bp0 + k), acc0, 0, 0, 0);
        if (PAIR) acc1 = __builtin_amdgcn_mfma_f32_32x32x16_bf16(a, *(const bf16x8*)(bp1 + k), acc1, 0, 0, 0);
    }
    LAS float* ssw = red + 2 * 8 * 1024;
#pragma unroll
    for (int r = 0; r < 16; ++r) { red[(wave * 16 + r) * 64 + lane] = acc0[r]; if (PAIR) red[8 * 1024 + (wave * 16 + r) * 64 + lane] = acc1[r]; }
    if (F32A) { ss += shfl_xor_(ss, 32); if (lane < 32) ssw[wave * 32 + lane] = ss; }
    __syncthreads();
#pragma unroll
    for (int i = 0; i < 2; ++i) { const int e = wave * 64 + lane + 512 * i, r = e >> 6, ln = e & 63, row = crow(r, ln >> 5);
        float v0 = 0.f, v1 = 0.f, sq = 0.f;
#pragma unroll
        for (int w = 0; w < 8; ++w) { v0 += red[(w * 16 + r) * 64 + ln]; if (PAIR) v1 += red[8 * 1024 + (w * 16 + r) * 64 + ln]; if (F32A) sq += ssw[w * 32 + row]; }
        epi(row, ln & 31, v0, v1, sq); }
}
DEV void wg_wait(const unsigned* c0, unsigned n0, const unsigned* c1, unsigned n1, int wave_s) { if (wave_s == 0) { pg8::poll_ge(c0, n0); if (c1) pg8::poll_ge(c1, n1); pg8::acq_agent(); } __syncthreads(); }
DEV void wg_wait8(const unsigned* c, unsigned n, int wave_s) { if (wave_s == 0) {
#pragma unroll 1
        for (int i = 0; i < 8; ++i) pg8::poll_ge(c + 64 * i, n);
        pg8::acq_agent(); } __syncthreads(); }
DEV void wg_post(unsigned* c, int wave_s) { __syncthreads(); if (wave_s == 0 && lane_id() == 0) { __builtin_amdgcn_fence(__ATOMIC_RELEASE, "agent"); asm volatile("s_waitcnt vmcnt(0)" ::: "memory"); __hip_atomic_fetch_add(c, 1u, __ATOMIC_RELAXED, __HIP_MEMORY_SCOPE_AGENT); } }
struct SampleW { const float *s5_c_re, *s5_c_im, *s5_d, *s5_w_glu, *s5_b_glu, *q_norm_g, *w_qb, *kv_norm_g, *w_uk, *w_uv, *w_gate, *b_gate, *gla_norm_g, *state_s5, *state_gla; };
template <int K> DEV float dot_bf16row(const bf16_t* row, const LAS float* x) {
    float a = 0.f;
#pragma unroll 8
    for (int k = 0; k < K; k += 8) { const u32x4 w = *(const u32x4*)(row + k); const f32x4 x0 = *(const LAS f32x4*)(x + k), x1 = *(const LAS f32x4*)(x + k + 4);
        const f32x4 w0 = pg8::unpk_lo(w.x, w.y), w1 = pg8::unpk_lo(w.z, w.w);
        a += (w0[0] * x0[0] + w0[1] * x0[1]) + (w0[2] * x0[2] + w0[3] * x0[3]) + (w1[0] * x1[0] + w1[1] * x1[1]) + (w1[2] * x1[2] + w1[3] * x1[3]); }
    return a;
}
template <int K> DEV float dot_f32row(const float* row, const LAS float* x) {
    float a = 0.f;
#pragma unroll 8
    for (int k = 0; k < K; k += 4) { const f32x4 w = *(const f32x4*)(row + k), xx = *(const LAS f32x4*)(x + k); a += (w[0] * xx[0] + w[1] * xx[1]) + (w[2] * xx[2] + w[3] * xx[3]); }
    return a;
}
DEV void sample_prep_task(int l, int b, int t, LAS unsigned char* sm, unsigned char* ws, float* out, const SampleW& w, const bf16_t* wqb, const bf16_t* wglu) {
    LAS float* u = (LAS float*)sm; LAS float* ys = u + 256; LAS float* cqn = ys + 256; LAS float* qv = cqn + 256; LAS float* red = qv + 768; LAS float* gdec = red + 16; LAS float* hsr = gdec + 128; LAS float* hsi = hsr + 1024;
    const int lane = t & 63, wv = t >> 6; const bool act = t < 256;
    const float* ps = (const float*)(ws + WS_PS) + (size_t)b * DINP;
    bf16_t* mixs = (bf16_t*)(ws + WS_MIXS) + (size_t)b * DM;
    __syncthreads();
    float cq = 0.f, t2 = 0.f;
    if (act) { u[t] = ps[t]; cq = ps[256 + t]; t2 = ps[512 + t];
        const float s1 = wave_sum(cq * cq), s2 = wave_sum(t < 128 ? t2 * t2 : 0.f);
        if (lane == 0) { red[wv] = s1; red[4 + wv] = s2; } }
    __syncthreads();
    const float rq = rsqrtf(((red[0] + red[1]) + (red[2] + red[3])) * (1.f / 256.f) + EPS), rk = rsqrtf(((red[4] + red[5]) + (red[6] + red[7])) * (1.f / 128.f) + EPS);
    if (act) cqn[t] = cq * rq;
#pragma unroll
    for (int i = 0; i < 2; ++i) { const int s = t + 512 * i, g = s >> 6, p = s & 63, lg = l * 16 + g;
        const float2 a = ((const float2*)(ws + WS_S5 + (size_t)lg * S5_SIZE + S5_ABAR))[p];
        const f32x4* bb = (const f32x4*)((const float2*)(ws + WS_S5 + (size_t)lg * S5_SIZE + S5_BBAR) + p * 16);
        const float2 h0 = *(const float2*)(w.state_s5 + ((((size_t)l * SB + b) * S5G + g) * S5P + p) * 2);
        float hr = a.x * h0.x - a.y * h0.y, hi = a.x * h0.y + a.y * h0.x;
#pragma unroll
        for (int c = 0; c < 8; ++c) { const f32x4 b2 = bb[c]; const float u0 = u[g * 16 + 2 * c], u1 = u[g * 16 + 2 * c + 1]; hr += b2[0] * u0 + b2[2] * u1; hi += b2[1] * u0 + b2[3] * u1; }
        hsr[s] = hr; hsi[s] = hi;
        *(float2*)(out + O_S5S + ((((size_t)l * SB + b) * S5G + g) * S5P + p) * 2) = make_float2(hr, hi); }
    __syncthreads();
    qv[t] = dot_bf16row<256>(wqb + (size_t)t * 256, cqn);
    if (act) { const int g = t >> 4, c = t & 15; const float* cr = w.s5_c_re + (((size_t)l * 16 + g) * 16 + c) * 64; const float* ci = w.s5_c_im + (((size_t)l * 16 + g) * 16 + c) * 64;
        const float y = dot_f32row<64>(cr, hsr + g * 64) - dot_f32row<64>(ci, hsi + g * 64) + w.s5_d[l * 256 + t] * u[t]; ys[t] = gelu_tanh(y); }
    else qv[256 + t] = dot_bf16row<256>(wqb + (size_t)(256 + t) * 256, cqn);
    __syncthreads();
    float* qlat = (float*)(ws + WS_QLAT) + (size_t)b * MH * 160;
#pragma unroll
    for (int i = 0; i < 2; ++i) { const int idx = t + 512 * i, h = idx >> 7, lp = idx & 127;
        qlat[h * 160 + lp] = dot_f32row<64>(w.w_uk + (((size_t)l * 128 + lp) * 8 + h) * 64, qv + h * 64) * QSCALE; }
    if (act) { const float z = dot_bf16row<256>(wglu + (size_t)t * 256, ys) + w.s5_b_glu[l * 256 + t]; mixs[t] = f2bf(ys[t] * sigmoidf_(z));
        const float* cosS = (const float*)(ws + WS_COS) + SEQ * 16; const float* sinS = (const float*)(ws + WS_SIN) + SEQ * 16;
        { const int h = t >> 5, j = t & 31, i = j & 15; const float x1 = qv[512 + h * 32 + rope_phys(i)], x2 = qv[512 + h * 32 + rope_phys(i + 16)];
            qlat[h * 160 + 128 + j] = (j < 16 ? x1 * cosS[i] - x2 * sinS[i] : x1 * sinS[i] + x2 * cosS[i]) * QSCALE; }
        float* kvnew = (float*)(ws + WS_KVNEW) + (size_t)b * 160;
        if (t < 128) { const float v = t2 * rk * w.kv_norm_g[l * 128 + t]; kvnew[t] = v; out[O_CKVS + ((size_t)l * SB + b) * KVL + t] = v; }
        else if (t < 160) { const int j = t - 128, i = j & 15; const float x1 = ps[640 + i], x2 = ps[656 + i];
            const float v = j < 16 ? x1 * cosS[i] - x2 * sinS[i] : x1 * sinS[i] + x2 * cosS[i]; kvnew[t] = v; out[O_KRS + ((size_t)l * SB + b) * ROPE + j] = v; }
        if (t < 128) { float z2 = w.b_gate[l * 128 + t];
#pragma unroll
            for (int r = 0; r < 16; ++r) z2 += ps[672 + r] * w.w_gate[((size_t)l * 16 + r) * 128 + t];
            gdec[t] = fexp(log_sigmoid(z2) * (1.f / 16.f)); } }
    __syncthreads();
    if (act) { const int h = t >> 6, v = t & 63; const float vv = ps[1024 + t]; float o = 0.f;
        const float* s0 = w.state_gla + (((size_t)l * SB + b) * GH + h) * GDK * GDV; float* so = out + O_GLAS + (((size_t)l * SB + b) * GH + h) * GDK * GDV;
#pragma unroll 8
        for (int d = 0; d < 32; ++d) { const float sN = gdec[h * 32 + d] * s0[d * 64 + v] + ps[896 + h * 32 + d] * vv; so[d * 64 + v] = sN; o += ps[768 + h * 32 + d] * 0.17677669529663687f * sN; }
        const float r = rsqrtf(wave_sum(o * o) * (1.f / 64.f) + EPS); const float gr = ps[1280 + t];
        mixs[768 + t] = f2bf(o * r * w.gla_norm_g[l * 256 + t] * gr * sigmoidf_(gr)); }
    __syncthreads();
}
DEV void sample_attn_task(int l, int item, int t, LAS unsigned char* sm, unsigned char* ws, const float* cache_ckv, const float* cache_kr, const int* page_table, const float* w_uv) {
    constexpr int KST = 168;
    LAS bf16_t* KB = (LAS bf16_t*)sm; LAS float* WO = (LAS float*)sm;
    LAS bf16_t* QB = (LAS bf16_t*)(sm + 256 * KST * 2); LAS float* QS = (LAS float*)(QB + 32 * KST);     LAS float* OL = QS + 8 * 160; LAS float* WM = OL + 8 * 128; LAS unsigned* FLAG = (LAS unsigned*)(WM + 128);
    const int b = item / NSPLIT, sp = item % NSPLIT, lane = t & 63, h = t >> 6, wv = h, r32 = lane & 31, hi = lane >> 5;
    __syncthreads();
    const int ptv_ = page_table[b * NPAGES + sp * (KPS / PAGE) + (lane & (KPS / PAGE - 1))];
    const float* ql_ = (const float*)(ws + WS_QLAT) + (size_t)b * 1280;
    float qs_[3], qx0_[6], qx1_[6];
#pragma unroll
    for (int j = 0; j < 3; ++j) { const int i = t + 512 * j; qs_[j] = ql_[i < 8 * 160 ? i : 0]; }
#pragma unroll
    for (int j = 0; j < 6; ++j) { const int i = t + 512 * j, row = (2 * i) / KST, col = (2 * i) % KST; const float* qp = ql_ + ((row < 8 && col < 160) ? row * 160 + col : 0); qx0_[j] = qp[0]; qx1_[j] = qp[1]; }
    float m = -INFINITY, lsum = 0.f; f32x16 O[4];
#pragma unroll
    for (int c = 0; c < 4; ++c)
#pragma unroll
        for (int r = 0; r < 16; ++r) O[c][r] = 0.f;
    const LAS bf16_t* vtb = KB + (32 * wv + 4 * hi + ((lane & 15) >> 2)) * KST + 16 * ((lane >> 4) & 1) + 4 * (lane & 3);
    f32x4 pk[16], pr[4];
#define LOAD_PAGE(pg_, P_) do { const bool ok_ = (P_) < KPS / PAGE; const int phys_ = __builtin_amdgcn_readlane(ptv_, ok_ ? (P_) : 0); const int st_ = ok_ ? 512 : 0; \
          \
        const f32x4* s1_ = ok_ ? (const f32x4*)(cache_ckv + ((size_t)l * NPOOL + phys_) * PAGE * KVL) + t : (const f32x4*)cache_ckv; const f32x4* s2_ = ok_ ? (const f32x4*)(cache_kr + ((size_t)l * NPOOL + phys_) * PAGE * ROPE) + t : (const f32x4*)cache_kr; \
        _Pragma("unroll") for (int i_ = 0; i_ < 8; ++i_) pk[8 * (pg_) + i_] = __builtin_nontemporal_load(s1_ + st_ * i_); pr[2 * (pg_)] = __builtin_nontemporal_load(s2_); pr[2 * (pg_) + 1] = __builtin_nontemporal_load(s2_ + st_); } while (0)
    LOAD_PAGE(0, 0); LOAD_PAGE(1, 1);
#pragma unroll
    for (int j = 0; j < 3; ++j) { const int i = t + 512 * j; if (i < 8 * 160) QS[i] = qs_[j]; }
#pragma unroll
    for (int j = 0; j < 6; ++j) { const int i = t + 512 * j, row = (2 * i) / KST, col = (2 * i) % KST; const bool ok = row < 8 && col < 160;
        if (i < 32 * KST / 2) ((LAS unsigned*)QB)[i] = pk2(ok ? qx0_[j] : 0.f, ok ? qx1_[j] : 0.f); }
    for (int it = 0; it < KPS / 256; ++it) {
#pragma unroll
      for (int pg = 0; pg < 2; ++pg) {
#pragma unroll
        for (int i = 0; i < 8; ++i) { const int e = t + 512 * i, key = e >> 5, c4 = e & 31; const f32x4 v = pk[8 * pg + i]; u32x2 w; w.x = pk2(v[0], v[1]); w.y = pk2(v[2], v[3]); *(LAS u32x2*)(KB + (128 * pg + key) * KST + 4 * c4) = w; }
#pragma unroll
        for (int i = 0; i < 2; ++i) { const int e = t + 512 * i, key = e >> 3, c4 = e & 7; const f32x4 v = pr[2 * pg + i]; u32x2 w; w.x = pk2(v[0], v[1]); w.y = pk2(v[2], v[3]); *(LAS u32x2*)(KB + (128 * pg + key) * KST + 128 + 4 * c4) = w; }
        LOAD_PAGE(pg, 2 * it + pg + 2);
        lds_barrier();
        if ((wv >> 2) == pg) {
        f32x16 S;
#pragma unroll
        for (int r = 0; r < 16; ++r) S[r] = 0.f;
        const LAS bf16_t* kr_ = KB + (32 * wv + r32) * KST + 8 * hi;
#pragma unroll
        for (int s2 = 0; s2 < 10; ++s2) S = __builtin_amdgcn_mfma_f32_32x32x16_bf16(*(const LAS bf16x8*)(kr_ + 16 * s2), *(const LAS bf16x8*)(QB + r32 * KST + 8 * hi + 16 * s2), S, 0, 0, 0);
        float mx = S[0];
#pragma unroll
        for (int r = 1; r < 16; ++r) mx = fmaxf(mx, S[r]);
        mx = fmaxf(mx, shfl_xor_(mx, 32));
        const float mn = fmaxf(m, mx), al_ = fexp2(m - mn); float psum = 0.f;
#pragma unroll
        for (int r = 0; r < 16; ++r) { S[r] = fexp2(S[r] - mn); psum += S[r]; }
        psum += shfl_xor_(psum, 32); lsum = lsum * al_ + psum; m = mn;
        u32x4 pb[2];
#pragma unroll
        for (int ks = 0; ks < 2; ++ks) { pb[ks].x = pk2(S[8 * ks + 0], S[8 * ks + 1]); pb[ks].y = pk2(S[8 * ks + 2], S[8 * ks + 3]); pb[ks].z = pk2(S[8 * ks + 4], S[8 * ks + 5]); pb[ks].w = pk2(S[8 * ks + 6], S[8 * ks + 7]); }
#pragma unroll
        for (int c = 0; c < 4; ++c) {
#pragma unroll
            for (int r = 0; r < 16; ++r) O[c][r] *= al_;
#pragma unroll
            for (int ks = 0; ks < 2; ++ks) {
                const attn_body::s16x4 lo = attn_body::vtr((attn_body::lds_cptr)(vtb + (16 * ks) * KST + 32 * c)), hi4 = attn_body::vtr((attn_body::lds_cptr)(vtb + (16 * ks + 8) * KST + 32 * c));
                const bf16x8 af = {lo[0], lo[1], lo[2], lo[3], hi4[0], hi4[1], hi4[2], hi4[3]};
                O[c] = __builtin_amdgcn_mfma_f32_32x32x16_bf16(af, __builtin_bit_cast(bf16x8, pb[ks]), O[c], 0, 0, 0); } }
        } }
    }
#undef LOAD_PAGE
    __syncthreads();
    if (r32 < 8 && hi == 0) { WM[(wv * 8 + r32) * 2] = m; WM[(wv * 8 + r32) * 2 + 1] = lsum; }
#pragma unroll
    for (int c = 0; c < 4; ++c) if (r32 < 8) {
#pragma unroll
        for (int r = 0; r < 16; ++r) WO[(wv * 8 + r32) * 128 + 32 * c + crow(r, hi)] = O[c][r]; }
    __syncthreads();
    float o0 = 0.f, o1 = 0.f;
    { float mx = -INFINITY;
#pragma unroll
      for (int w2 = 0; w2 < 8; ++w2) mx = fmaxf(mx, WM[(w2 * 8 + h) * 2]);
      float L = 0.f;
#pragma unroll
      for (int w2 = 0; w2 < 8; ++w2) { const float f = fexp2(WM[(w2 * 8 + h) * 2] - mx); L += f * WM[(w2 * 8 + h) * 2 + 1]; o0 += f * WO[(w2 * 8 + h) * 128 + lane]; o1 += f * WO[(w2 * 8 + h) * 128 + 64 + lane]; }
      m = mx; lsum = L; }
    float* opl = (float*)(ws + WS_OP) + (size_t)l * SB * NSPLIT * MH * 128; float* mll = (float*)(ws + WS_ML) + (size_t)l * SB * NSPLIT * MH * 2;
    { float* op = opl + (((size_t)b * NSPLIT + sp) * MH + h) * 128;
      __hip_atomic_store(op + lane, o0, __ATOMIC_RELAXED, __HIP_MEMORY_SCOPE_AGENT); __hip_atomic_store(op + 64 + lane, o1, __ATOMIC_RELAXED, __HIP_MEMORY_SCOPE_AGENT);
      if (lane == 0) { float* ml = mll + (((size_t)b * NSPLIT + sp) * MH + h) * 2; __hip_atomic_store(ml, m, __ATOMIC_RELAXED, __HIP_MEMORY_SCOPE_AGENT); __hip_atomic_store(ml + 1, lsum, __ATOMIC_RELAXED, __HIP_MEMORY_SCOPE_AGENT); } }
    asm volatile("s_waitcnt vmcnt(0)" ::: "memory");
    __syncthreads();
    if (t == 0) { unsigned* cnt = (unsigned*)(ws + WS_CTL) + CW_CNT + (l * SB + b) * 64;
        const unsigned old = __hip_atomic_fetch_add(cnt, 1u, __ATOMIC_RELAXED, __HIP_MEMORY_SCOPE_AGENT);
        const unsigned last = old == (unsigned)(NSPLIT - 1) ? 1u : 0u;
        if (last) __builtin_amdgcn_fence(__ATOMIC_ACQUIRE, "agent");
        FLAG[0] = last; }
    __syncthreads();
    if (FLAG[0] != 0u) {
        const float* kn = (const float*)(ws + WS_KVNEW) + (size_t)b * 160;
        float sn = QS[h * 160 + lane] * kn[lane] + QS[h * 160 + 64 + lane] * kn[64 + lane] + (lane < 32 ? QS[h * 160 + 128 + lane] * kn[128 + lane] : 0.f);
        sn = wave_sum(sn);
        const float* ml = mll + ((size_t)b * NSPLIT * MH + h) * 2; const float* op = opl + ((size_t)b * NSPLIT * MH + h) * 128;
        float mx = sn;
        for (int s = 0; s < NSPLIT; ++s) mx = fmaxf(mx, ml[s * MH * 2]);
        const float wn = fexp2(sn - mx); float L = wn, a0 = wn * kn[lane], a1 = wn * kn[64 + lane];
#pragma unroll
        for (int s = 0; s < NSPLIT; ++s) { const float ws_ = fexp2(ml[s * MH * 2] - mx); L += ws_ * ml[s * MH * 2 + 1]; a0 += ws_ * op[s * MH * 128 + lane]; a1 += ws_ * op[s * MH * 128 + 64 + lane]; }
        const float inv = 1.f / L; OL[h * 128 + lane] = a0 * inv; OL[h * 128 + 64 + lane] = a1 * inv;
        asm volatile("s_waitcnt lgkmcnt(0)" ::: "memory");
        float a = 0.f; const float* uv = w_uv + (size_t)l * 128 * 512 + h * 64 + lane;
#pragma unroll 16
        for (int lp = 0; lp < 128; ++lp) a += OL[h * 128 + lp] * uv[(size_t)lp * 512];
        ((bf16_t*)(ws + WS_MIXS))[(size_t)b * DM + 256 + h * 64 + lane] = f2bf(a);
        wg_post((unsigned*)(ws + WS_CTL) + CW_DR + 64 * l, h);
    }
}
#ifndef MK_CUT
#define MK_CUT 0
#endif
__global__ void __launch_bounds__(512, 2) mk_fwd(MKArgs args) {
    extern __shared__ __attribute__((aligned(16))) unsigned char lds[];
    LAS unsigned char* ldsl = (LAS unsigned char*)lds;
    volatile LAS unsigned* MISC = (volatile LAS unsigned*)(ldsl + MISC_OFF);
    const int wave_s = __builtin_amdgcn_readfirstlane((int)threadIdx.x >> 6);
#define PHASE_IDS int tid = wave_s * 64 + lane_id(); asm volatile("" : "+v"(tid)); const int lane = tid & 63, wave = __builtin_amdgcn_readfirstlane(tid >> 6), gw = bx * 8 + wave, gtid = bx * 512 + tid; (void)lane; (void)gw; (void)gtid;
    { const int bx = blockIdx.x; PHASE_IDS
      for (int u = tid; u < (LDS_BYTES - LDSCTL_OFF) / 4; u += 512) ((LAS unsigned*)(ldsl + LDSCTL_OFF))[u] = 0u; }
    __syncthreads();
    XcdBarrier bar = xcd_barrier_post((unsigned*)(args.ws + WS_CTL) + CW_BAR + args.li * XCD_BAR_WORDS, MISC + 8, wave_s == 0 && lane_id() == 0);
    const int lo = args.ph_lo, hi = args.ph_hi; (void)lo; (void)hi;
#if MK_CUT
#define IN(k) (lo <= (k) && (k) < hi)
#else
#define IN(k) true
#endif
#define SEAM(k) do { if (IN(k) && IN((k) + 1)) xcd_barrier(bar, wave_s == 0 && lane_id() == 0); } while (0)
#define PHASE_PTRS const CAS unsigned long long* ap = (const CAS unsigned long long*)__builtin_amdgcn_kernarg_segment_ptr(); asm volatile("" : "+s"(ap)); unsigned char* ws = KPTR(unsigned char, ap, 36); float* out = KPTR(float, ap, 35); int G = (int)gridDim.x, bx = (int)blockIdx.x; unsigned ldsb_ = 0u; asm volatile("" : "+s"(G), "+s"(bx), "+s"(ldsb_)); \
    const int ngw = G * 8, gthreads = G * 512; LAS unsigned char* ldsl = (LAS unsigned char*)lds + ldsb_; (void)ngw; (void)gthreads; (void)ldsl; \
    bf16_t* XB = (bf16_t*)(ws + WS_XB); float* RSX = (float*)(ws + WS_RSX); float* xp = out + O_YP; float* xs = out + O_YS; \
    const float* x_prompt = KPTR(const float, ap, 0); const float* x_sample = KPTR(const float, ap, 1); (void)XB; (void)RSX; (void)xp; (void)xs; (void)x_prompt; (void)x_sample;

#define S5M_LAYER(L, T0, TS) do { const float *a_re_ = KPTR(const float, ap, 10), *a_im_ = KPTR(const float, ap, 11), *ldt_ = KPTR(const float, ap, 12), *c_re_ = KPTR(const float, ap, 15), *c_im_ = KPTR(const float, ap, 16); \
    for (int id = (T0); id < 16 * 63 * 32; id += (TS)) s5_mat_T(a_re_, a_im_, ldt_, c_re_, c_im_, ws, (L) * 16 * 63 * 32 + id); \
    for (int id = (T0); id < 16 * 128 * 32; id += (TS)) s5_mat_Q(a_re_, a_im_, ldt_, ws, (L) * 16 * 128 * 32 + id); \
    for (int id = (T0); id < 16 * 32 * 16 * 16; id += (TS)) s5_mat_P(a_re_, a_im_, ldt_, c_re_, c_im_, ws, (L) * 16 * 32 * 16 * 16 + id); \
    for (int id = (T0); id < 16 * 64; id += (TS)) { const int gi_ = (L) * 16 * 64 + id; ((float2*)(ws + WS_S5 + (size_t)(gi_ >> 6) * S5_SIZE + S5_AL))[gi_ & 63] = ((const float2*)(ws + WS_APOW))[((size_t)(gi_ >> 6) * 33 + 32) * 64 + (gi_ & 63)]; } } while (0)
#ifndef REP_P0
#define REP_P0 1
#endif
#ifndef REP_P2
#define REP_P2 1
#endif
#ifndef REP_P3
#define REP_P3 1
#endif
#ifndef REP_P1
#define REP_P1 1
#endif
#ifndef REP_P5
#define REP_P5 1
#endif
#ifndef REP_GLA
#define REP_GLA 1
#endif
#ifndef REP_S5
#define REP_S5 1
#endif
#ifndef REP_PREP
#define REP_PREP 1
#endif
#ifndef REP_MISC
#define REP_MISC 1
#endif
#ifndef REP_ATTN
#define REP_ATTN 1
#endif
#ifndef REP_DEC
#define REP_DEC 1
#endif
    for (int rep_ = 0; rep_ < REP_P0; ++rep_) {
    if (rep_) xcd_barrier(bar, wave_s == 0 && lane_id() == 0);
    if (IN(0)) { PHASE_PTRS PHASE_IDS
        cvt_layer_wg(0, bx, G, tid, ldsl + RING_OFF, ws, ap);
        for (int id = gtid; id < DEPTH * 16 * 64; id += gthreads) s5_pre_item(KPTR(const float, ap, 10), KPTR(const float, ap, 11), KPTR(const float, ap, 12), KPTR(const float, ap, 13), KPTR(const float, ap, 14), ws, id >> 6, id & 63);
        for (int id = gtid; id < (SEQ + 1) * 16; id += gthreads) rope_item(ws, id);
        for (int id = gtid; id < DEPTH * 16 * 33 * 64; id += gthreads) { const int p = id & 63, tau = (id >> 6) % 33, lg = id / (33 * 64);
            ((float2*)(ws + WS_APOW))[id] = cpow_(KPTR(const float, ap, 10)[lg * 64 + p], KPTR(const float, ap, 11)[lg * 64 + p], expf(KPTR(const float, ap, 12)[lg]), tau); }
        for (int row = gw; row < M; row += ngw) xprep_row(x_prompt, XB, RSX, row, lane);
    }
    SEAM(0);
    if (IN(1)) { PHASE_PTRS PHASE_IDS
        S5M_LAYER(0, gtid, gthreads);
    }
    }

    for (int l = 0; l < DEPTH; ++l) {
        const int pb = 2 + 7 * l;
#define LAYER_PTRS PHASE_PTRS unsigned char* wl = ws + WS_W + (size_t)l * WL_SIZE; const float* xin_s = l == 0 ? x_sample : xs; (void)wl; (void)xin_s;
        for (int rep_ = 0; rep_ < REP_P1; ++rep_) { if (rep_) xcd_barrier(bar, wave_s == 0 && lane_id() == 0);
        if (IN(pb + 0)) { LAYER_PTRS
            const bool rd = G == 256; unsigned* ctl = (unsigned*)(ws + WS_CTL);
            if (rd && l > 0) wg_wait(ctl + CW_WIN + 64 * l, 384u / CVT_CH, nullptr, 0u, wave_s);
            { pg8::Gemm g{XB, (const bf16_t*)(wl + WL_IN), M, DINP, DM}; pg8::Order1 S; S.init(M, DINP, G, bx); S.redeal = rd; S.x = bx & 7; S.r = bx >> 3; S.wv = wave_s;
              S.rdy = ctl + CW_P6 + (l > 0 ? l - 1 : 0) * 64 * 64; S.need = l > 0 ? 32u : 0u;
              pg8::EpiWin E{RSX, (bf16_t*)(ws + WS_U5), (bf16_t*)(ws + WS_CQB), (float*)(ws + WS_RSCQ), (float*)(ws + WS_T2F), (bf16_t*)(ws + WS_T2B), (float*)(ws + WS_RSKV), (float*)(ws + WS_QKF), (bf16_t*)(ws + WS_GVB), (bf16_t*)(ws + WS_GRB), (LAS float*)(ldsl + XCH_OFF) + 1024};
              pg8::gemm_phase<pg8::EpiWin, pg8::Order1, true, true>(ldsl + RING_OFF, g, S, E, wave_s); }
            { PHASE_IDS float* PS = (float*)(ws + WS_PS);
              const int k0_ = rd ? bx - 128 : G - 1 - bx;
              if (rd && l > 0 && k0_ >= 0 && k0_ < DINP / 32) wg_wait(ctl + CW_S6 + 64 * (l - 1), DM / 32, nullptr, 0u, wave_s);
              for (int k = k0_; k >= 0 && k < DINP / 32; k += G)
                sgemm_wg<true, false>(xin_s, DM, (const bf16_t*)(wl + WL_IN), DM, DM, 32 * k, 0, wave, lane, (LAS float*)(ldsl + RING_OFF), [&](int row, int c, float v, float, float ssq) { PS[(size_t)row * DINP + 32 * k + c] = v * rsqrtf(ssq * (1.f / DM) + EPS); }); }
        }
        }
        SEAM(pb + 0);
        for (int rep_ = 0; rep_ < REP_P2; ++rep_) { if (rep_) xcd_barrier(bar, wave_s == 0 && lane_id() == 0);
        if (IN(pb + 1)) { LAYER_PTRS
            constexpr int NGLA = NB * GH;
            if (bx < NGLA && G > NGLA) xcd_barrier<true>(bar, wave_s == 0 && lane_id() == 0);
            if (bx >= NGLA) { pg8::Gemm g{(const bf16_t*)(ws + WS_CQB), (const bf16_t*)(wl + WL_QB), M, 768, 256}; pg8::StaticOrder S; S.init(M, 768, G - NGLA, bx - NGLA);
              pg8::EpiQ E{(const float*)(ws + WS_RSCQ), (const float*)(ws + WS_COS), (const float*)(ws + WS_SIN), (bf16_t*)(ws + WS_QN), (bf16_t*)(ws + WS_QP)};
              pg8::gemm_phase<pg8::EpiQ, pg8::StaticOrder, true, true>(ldsl + RING_OFF, g, S, E, wave_s); }
            if (bx >= NGLA) { pg8::Gemm g{(const bf16_t*)(ws + WS_T2B), (const bf16_t*)(wl + WL_KV), M, 1024, 256}; pg8::StaticOrder S; S.init(M, 1024, G - NGLA, bx - NGLA);
              pg8::EpiKV E{(const float*)(ws + WS_RSKV), (bf16_t*)(ws + WS_KN), (bf16_t*)(ws + WS_VB)};
              pg8::gemm_phase<pg8::EpiKV, pg8::StaticOrder, true, true>(ldsl + RING_OFF, g, S, E, wave_s); }
            for (int r2_ = 0; r2_ < REP_GLA; ++r2_) { PHASE_IDS for (int k = bx; k < NB * GH; k += G) { gla_task(l, k >> 2, k & 3, wave, lane, ldsl + RING_OFF, ws, out, KPTR(const float, ap, 27), KPTR(const float, ap, 25) + (size_t)l * 16 * 128, KPTR(const float, ap, 26) + l * 128);
                wg_post((unsigned*)(ws + WS_CTL) + CW_GL + (l * NB + (k >> 2)) * 64, wave_s); } }
            for (int r2_ = 0; r2_ < REP_S5 + REP_PREP - 1; ++r2_) { PHASE_IDS if (r2_ == 0 || REP_S5 > 1) for (int k = (2 * G - 33 - bx) % G; k < NB * 16; k += G) s5_task(l, k >> 4, k & 15, wave, lane, ldsl + RING_OFF, ws, out, KPTR(const float, ap, 17));
            { const SampleW sw{KPTR(const float, ap, 15), KPTR(const float, ap, 16), KPTR(const float, ap, 17), KPTR(const float, ap, 18), KPTR(const float, ap, 19), KPTR(const float, ap, 20), KPTR(const float, ap, 21), KPTR(const float, ap, 22), KPTR(const float, ap, 23), KPTR(const float, ap, 24), KPTR(const float, ap, 25), KPTR(const float, ap, 26), KPTR(const float, ap, 27), KPTR(const float, ap, 5), KPTR(const float, ap, 6)};
              if (r2_ == 0 || REP_PREP > 1) for (int b = G - 1 - bx; b < SB; b += G) sample_prep_task(l, b, tid, ldsl + RING_OFF, ws, out, sw, (const bf16_t*)(wl + WL_QB), (const bf16_t*)(wl + WL_GLU)); } }
            if (bx >= NGLA) { volatile LAS unsigned* LQ = (volatile LAS unsigned*)(ldsl + LDSCTL_OFF + 512); unsigned* q2 = (unsigned*)(ws + WS_CTL) + CW_Q2 + 64 * l;
              for (;;) {
                  if (wave_s == 0 && lane_id() == 0) LQ[1] = __hip_atomic_fetch_add(q2, 1u, __ATOMIC_RELAXED, __HIP_MEMORY_SCOPE_AGENT);
                  __syncthreads(); const unsigned blk = LQ[1]; __syncthreads();
                  if (blk >= (unsigned)(M / 64)) break;
                  { PHASE_IDS
                    misc_rows4(l, (int)blk * 64 + wave * 8, lane, ws, out, KPTR(const float, ap, 22) + l * 128); misc_rows4(l, (int)blk * 64 + wave * 8 + 4, lane, ws, out, KPTR(const float, ap, 22) + l * 128); } } }
            if ((bx >= NGLA || G <= NGLA) && IN(pb + 2)) xcd_barrier<true>(bar, wave_s == 0 && lane_id() == 0);
            if (l + 1 < DEPTH && bx >= NB * GH && G > NB * GH) { PHASE_IDS const int t0_ = gtid - NB * GH * 512, ts_ = (G - NB * GH) * 512;
              if (CVT_Q0 > 0) cvt_layer_wg(l + 1, bx - NB * GH, G - NB * GH, tid, ldsl + RING_OFF, ws, ap, 0, CVT_Q0);
              S5M_LAYER(l + 1, t0_, ts_); }
        }
        }
        if (IN(pb + 1) && IN(pb + 2)) xcd_barrier_wait(bar, wave_s == 0 && lane_id() == 0);
        for (int rep_ = 0; rep_ < REP_P3; ++rep_) { if (rep_) xcd_barrier(bar, wave_s == 0 && lane_id() == 0);
        if (IN(pb + 2)) { LAYER_PTRS
            { volatile LAS unsigned* LQ = (volatile LAS unsigned*)(ldsl + LDSCTL_OFF + 512);
              unsigned* qd = (unsigned*)(ws + WS_CTL) + CW_Q3 + 128 * l; unsigned* qa = qd + 64;
              const bool dclass = (bx >> 3) == 19 || (bx >> 3) == 27;
              constexpr unsigned ND = SB * NSPLIT, NA = NB * MH * 8 + M / 256;
              for (;;) {
                  if (wave_s == 0 && lane_id() == 0) { unsigned kind = 2u, idx = 0u;
                      if (dclass) { idx = __hip_atomic_fetch_add(qd, 1u, __ATOMIC_RELAXED, __HIP_MEMORY_SCOPE_AGENT); if (idx < ND) kind = 0u; else { idx = __hip_atomic_fetch_add(qa, 1u, __ATOMIC_RELAXED, __HIP_MEMORY_SCOPE_AGENT); if (idx < NA) kind = 1u; } }
                      else { idx = __hip_atomic_fetch_add(qa, 1u, __ATOMIC_RELAXED, __HIP_MEMORY_SCOPE_AGENT); if (idx < NA) kind = 1u; else { idx = __hip_atomic_fetch_add(qd, 1u, __ATOMIC_RELAXED, __HIP_MEMORY_SCOPE_AGENT); if (idx < ND) kind = 0u; } }
                      LQ[0] = kind; LQ[1] = idx; }
                  __syncthreads();
                  const unsigned kind = LQ[0], idx = LQ[1];
                  __syncthreads();
                  if (kind == 2u) break;
                  if (kind == 0u) { PHASE_IDS sample_attn_task(l, (int)idx, tid, ldsl + RING_OFF, ws, KPTR(const float, ap, 2), KPTR(const float, ap, 3), (const int*)KPTR(const float, ap, 4), KPTR(const float, ap, 24)); }
                  else if (idx < (unsigned)(M / 256)) {
                      pg8::Gemm g{(const bf16_t*)(ws + WS_Y5), (const bf16_t*)(wl + WL_GLU), M, 256, 256}; const pg8::OneUnitPub S{(int)idx, 0, (unsigned*)(ws + WS_CTL) + CW_MX + (l * 64 + (int)idx) * 64};
                      pg8::EpiGlu E{(const bf16_t*)(ws + WS_Y5), KPTR(const float, ap, 19) + l * 256, (bf16_t*)(ws + WS_MIX)};
                      pg8::gemm_phase<pg8::EpiGlu, pg8::OneUnitPub, true, true>(ldsl + RING_OFF, g, S, E, wave_s); }
                  else { const int ia = (int)idx - M / 256, qb = 7 - (ia >> 6), bh = ia & 63;
                      attn_body::attn_unit<8>(wave_s, bh / attn_body::NHEAD, bh % attn_body::NHEAD, qb, (const attn_body::bf16*)(ws + WS_QN), (const attn_body::bf16*)(ws + WS_QP), (const attn_body::bf16*)(ws + WS_KN), (const attn_body::bf16*)(ws + WS_KP), (const attn_body::bf16*)(ws + WS_VB), (attn_body::bf16*)(ws + WS_MIX), (char*)lds + RING_OFF);
                      pg8::pub_wave((unsigned*)(ws + WS_CTL) + CW_MX + (l * 64 + (bh / attn_body::NHEAD) * 8 + qb) * 64); }
              } }
        }
        }
        if ((int)gridDim.x != 256) SEAM(pb + 2);
        if (IN(pb + 3)) { LAYER_PTRS
            const bool mrg = G == 256; unsigned* ctl = (unsigned*)(ws + WS_CTL);
            const int pm4 = 8 * (bx & 7) + 7 - (bx >> 5), pn4 = (bx >> 3) & 3;
            if (mrg) wg_wait(ctl + CW_MX + (l * 64 + pm4) * 64, 9u * 8u, ctl + CW_GL + (l * NB + (bx & 7)) * 64, (unsigned)GH, wave_s);
            { pg8::Gemm g{(const bf16_t*)(ws + WS_MIX), (const bf16_t*)(wl + WL_OUT), M, DM, DM}; pg8::Order6 S; S.init(M, DM, G, bx); S.redeal = mrg; S.pm0 = pm4; S.pn0 = pn4; S.cnt = ctl + CW_P4 + l * 64 * 64;
              pg8::EpiResidT<true> E{l == 0 ? x_prompt : nullptr, XB, RSX};
              pg8::gemm_phase<pg8::EpiResidT<true>, pg8::Order6, true, true>(ldsl + RING_OFF, g, S, E, wave_s); }
            if (l + 1 < DEPTH) { volatile LAS unsigned* LQ = (volatile LAS unsigned*)(ldsl + LDSCTL_OFF + 512); unsigned* qc = ctl + CW_Q3 + 128 * l + 32;
              constexpr unsigned NC = (CVT_TILES_PER_LAYER - CVT_Q0 + CVT_CH - 1) / CVT_CH;
              for (;;) {
                  if (wave_s == 0 && lane_id() == 0) LQ[1] = __hip_atomic_fetch_add(qc, 1u, __ATOMIC_RELAXED, __HIP_MEMORY_SCOPE_AGENT);
                  __syncthreads(); const unsigned idx = LQ[1]; __syncthreads();
                  if (idx >= NC) break;
                  { PHASE_IDS const int tb_ = CVT_Q0 + CVT_CH * (int)idx; cvt_layer_wg(l + 1, 0, 1, tid, ldsl + RING_OFF, ws, ap, tb_, tb_ + CVT_CH < CVT_TILES_PER_LAYER ? tb_ + CVT_CH : CVT_TILES_PER_LAYER); }
                  if (mrg && CVT_CH * (idx + 1) <= 384u) wg_post(ctl + CW_WIN + 64 * (l + 1), wave_s); } }
            if (mrg && G - 1 - bx < DM / 32) wg_wait(ctl + CW_DR + 64 * l, (unsigned)SB, nullptr, 0u, wave_s);
            { PHASE_IDS for (int k = G - 1 - bx; k < DM / 32; k += G) {
                sgemm_wg<false, false>(ws + WS_MIXS, DM, (const bf16_t*)(wl + WL_OUT), DM, DM, 32 * k, 0, wave, lane, (LAS float*)(ldsl + RING_OFF), [&](int row, int c, float v, float, float) { const size_t o = (size_t)row * DM + 32 * k + c; xs[o] = xin_s[o] + v; });
                if (mrg) wg_post(ctl + CW_S4 + 64 * l, wave_s); } }
        }
        if ((int)gridDim.x != 256) SEAM(pb + 3);
        for (int rep_ = 0; rep_ < REP_P5; ++rep_) { if (rep_) xcd_barrier(bar, wave_s == 0 && lane_id() == 0);
        if (IN(pb + 4)) { LAYER_PTRS
            const bool rd = G == 256; unsigned* ctl = (unsigned*)(ws + WS_CTL);
            if (rd) wg_wait8(ctl + CW_P4 + (l * 64 + 8 * (bx & 7)) * 64, 4u * 8u, wave_s);
            { pg8::Gemm g{XB, (const bf16_t*)(wl + WL_FFI), M, DFF2, DM}; pg8::Order5 S; S.init(M, DFF2, G, bx); S.redeal = rd; S.x = bx & 7; S.r = bx >> 3; S.grp = ctl + CW_G5 + l * 16 * 64;
              pg8::EpiFfi E{RSX, KPTR(const float, ap, 31) + (size_t)l * 3 * DFF, KPTR(const float, ap, 32) + (size_t)l * DFF, (bf16_t*)(ws + WS_H), (float*)(ws + WS_FV), (float*)(ws + WS_FG), (float*)(ws + WS_LG), out + O_CONVP + (size_t)l * NB * 2 * DFF, (LAS float*)(ldsl + XCH_OFF)};
              pg8::gemm_phase<pg8::EpiFfi, pg8::Order5, true, true>(ldsl + RING_OFF, g, S, E, wave_s); }
            { PHASE_IDS const float* cw = KPTR(const float, ap, 31) + (size_t)l * 3 * DFF; const float* cbs = KPTR(const float, ap, 32) + (size_t)l * DFF; const float* stc = KPTR(const float, ap, 7) + (size_t)l * SB * 2 * DFF;
              bf16_t* HS = (bf16_t*)(ws + WS_HS); float* oc = out + O_CONVS + (size_t)l * SB * 2 * DFF;
              if (rd && G - 1 - bx < DFF / 32) wg_wait(ctl + CW_S4 + 64 * l, DM / 32, nullptr, 0u, wave_s);
              for (int k = G - 1 - bx; k < DFF / 32; k += G) { const int pv = 256 * (k >> 2) + 32 * (k & 3);
                sgemm_wg<true, true>(xs, DM, (const bf16_t*)(wl + WL_FFI), DM, DM, pv, pv + 128, wave, lane, (LAS float*)(ldsl + RING_OFF), [&](int row, int cc, float v, float gt, float ssq) {
                    const float r = rsqrtf(ssq * (1.f / DM) + EPS); const int c = 32 * k + cc; const float g0 = gt * r, b0 = stc[((size_t)row * 2 + 0) * DFF + c], b1 = stc[((size_t)row * 2 + 1) * DFF + c];
                    const float conv = cbs[c] + cw[c] * b0 + cw[DFF + c] * b1 + cw[2 * DFF + c] * g0;
                    HS[(size_t)row * DFF + c] = f2bf(gelu_tanh(conv) * v * r); oc[((size_t)row * 2 + 0) * DFF + c] = b1; oc[((size_t)row * 2 + 1) * DFF + c] = g0; });
                if (rd) wg_post(ctl + CW_S5 + 64 * l, wave_s); } }
        }
        }
        if ((int)gridDim.x != 256) SEAM(pb + 4);
        if (IN(pb + 6)) { LAYER_PTRS
            const bool rd = G == 256; unsigned* ctl = (unsigned*)(ws + WS_CTL);
            const int r6_ = bx >> 3, g6_ = r6_ >= 16 ? 0 : 1, j6_ = r6_ & 15, pm6 = 8 * (bx & 7) + 4 * g6_ + (j6_ & 3), pn6 = j6_ >> 2;
            if (rd) wg_wait(ctl + CW_G5 + (l * 16 + 2 * (bx & 7) + g6_) * 64, 88u * 8u, g6_ ? ctl + CW_G5 + (l * 16 + 2 * (bx & 7)) * 64 : nullptr, 88u * 8u, wave_s);
            { PHASE_IDS const float* cw = KPTR(const float, ap, 31) + (size_t)l * 3 * DFF; const float* cbs = KPTR(const float, ap, 32) + (size_t)l * DFF;
              const float* FV = (const float*)(ws + WS_FV); const float* FG = (const float*)(ws + WS_FG); const float* LG = (const float*)(ws + WS_LG); bf16_t* H = (bf16_t*)(ws + WS_H);
#pragma unroll 1
              for (int i = 0;; ++i) { const int pm = __builtin_amdgcn_readfirstlane(rd ? (i == 0 ? pm6 : -1) : pg8::static_pm(M, DM, G, bx, i)); if (pm < 0) break; const bool first = (pm & 7) == 0;
#pragma unroll
                  for (int k = 0; k < 2 * DFF / 512; ++k) { const int id = tid + 512 * k, rr = id >= DFF ? 1 : 0, c = id - rr * DFF;
                      const float g0 = FG[((size_t)pm * 2 + rr) * DFF + c], lg1 = first ? 0.f : LG[((size_t)(pm - 1) * 2 + 1) * DFF + c], lg0 = first ? 0.f : LG[((size_t)(pm - 1) * 2 + 0) * DFF + c];
                      const float gm1 = rr == 1 ? FG[((size_t)pm * 2 + 0) * DFF + c] : lg1, gm2 = rr == 1 ? lg1 : lg0;
                      const float conv = cbs[c] + cw[c] * gm2 + cw[DFF + c] * gm1 + cw[2 * DFF + c] * g0;
                      H[((size_t)pm * 256 + rr) * DFF + c] = f2bf(gelu_tanh(conv) * FV[((size_t)pm * 2 + rr) * DFF + c]); } }
              __syncthreads(); }
            { pg8::Gemm g{(const bf16_t*)(ws + WS_H), (const bf16_t*)(wl + WL_FFO), M, DM, DFF}; pg8::Order6 S; S.init(M, DM, G, bx); S.redeal = rd; S.pm0 = pm6; S.pn0 = pn6; S.cnt = ctl + CW_P6 + l * 64 * 64;
              pg8::EpiResidT<true> E{nullptr, XB, RSX};
              pg8::gemm_phase<pg8::EpiResidT<true>, pg8::Order6, true, true>(ldsl + RING_OFF, g, S, E, wave_s); }
            { PHASE_IDS const int k0_ = rd ? bx - 128 : G - 1 - bx;
              if (rd && k0_ >= 0 && k0_ < DM / 32) wg_wait(ctl + CW_S5 + 64 * l, DFF / 32, nullptr, 0u, wave_s);
              for (int k = k0_; k >= 0 && k < DM / 32; k += G) {
                sgemm_wg<false, false>(ws + WS_HS, DFF, (const bf16_t*)(wl + WL_FFO), DFF, DFF, 32 * k, 0, wave, lane, (LAS float*)(ldsl + RING_OFF), [&](int row, int c, float v, float, float) { xs[(size_t)row * DM + 32 * k + c] += v; });
                if (rd) wg_post(ctl + CW_S6 + 64 * l, wave_s); } }
        }
        if ((int)gridDim.x != 256) SEAM(pb + 6);
    }
    if (IN(N_PHASES - 1)) { PHASE_PTRS PHASE_IDS
        const float* g = KPTR(const float, ap, 34);
        const bool mrg = G == 256; unsigned* ctl = (unsigned*)(ws + WS_CTL);
        const int r6_ = bx >> 3, g6_ = r6_ >= 16 ? 0 : 1, j6_ = r6_ & 15, rb_ = 256 * (8 * (bx & 7) + 4 * g6_ + (j6_ & 3)) + 64 * (j6_ >> 2) + 8 * wave;
        if (mrg) wg_wait(ctl + CW_P6 + ((DEPTH - 1) * 64 + (rb_ >> 8)) * 64, 4u * 8u, bx < 4 ? ctl + CW_S6 + 64 * (DEPTH - 1) : nullptr, DM / 32, wave_s);
        const int nit_ = mrg ? (bx < 4 ? 5 : 4) : (M + SB - gw + 2 * ngw - 1) / (2 * ngw);
#pragma unroll 1
        for (int it_ = 0; it_ < nit_; ++it_) {
            f32x4 v[2][4]; float s2[2] = {0.f, 0.f};
            const int rowA_ = mrg ? (it_ < 4 ? rb_ + 2 * it_ : M + 8 * bx + wave) : gw + 2 * it_ * ngw, rowB_ = mrg ? (it_ < 4 ? rowA_ + 1 : M + SB) : rowA_ + ngw;
#pragma unroll
            for (int q = 0; q < 2; ++q) { const int row = q ? rowB_ : rowA_;
                if (row < M) {
#pragma unroll
                    for (int j2 = 0; j2 < 4; ++j2) { const u32x2 w = *(const u32x2*)(XB + (size_t)row * DM + 256 * j2 + 4 * lane); v[q][j2] = pg8::unpk_lo(w.x, w.y); }
                } else if (row < M + SB) {
#pragma unroll
                    for (int j2 = 0; j2 < 4; ++j2) v[q][j2] = *(const f32x4*)(xs + (size_t)(row - M) * DM + 256 * j2 + 4 * lane);
                } else {
#pragma unroll
                    for (int j2 = 0; j2 < 4; ++j2) v[q][j2] = (f32x4){0.f, 0.f, 0.f, 0.f}; } }
#pragma unroll
            for (int q = 0; q < 2; ++q) { const int row = q ? rowB_ : rowA_;
#pragma unroll
                for (int j2 = 0; j2 < 4; ++j2) s2[q] += (v[q][j2].x * v[q][j2].x + v[q][j2].y * v[q][j2].y) + (v[q][j2].z * v[q][j2].z + v[q][j2].w * v[q][j2].w);
                const float r = rsqrtf(wave_sum(s2[q]) * (1.f / DM) + EPS);
                if (row < M + SB) { float* yo = row < M ? xp + (size_t)row * DM : xs + (size_t)(row - M) * DM;
#pragma unroll
                    for (int j2 = 0; j2 < 4; ++j2) { const f32x4 gg = *(const f32x4*)(g + 256 * j2 + 4 * lane); *(f32x4*)(yo + 256 * j2 + 4 * lane) = v[q][j2] * r * gg; } } }
        }
    }
#undef IN
#undef SEAM
}

#include <string.h>
extern "C" void kernel_launch(void* const* d_in, const int* in_sizes, int n_in, void* d_out, int out_size, void* d_ws, size_t ws_size, hipStream_t stream) {
    static int grid = 0;
    if (grid == 0) {
        if (n_in != 35 || (size_t)out_size != O_END || ws_size < WS_END) { fprintf(stderr, "kernel_launch: unexpected sizes n_in %d out %d ws %zu (need %zu)\n", n_in, out_size, ws_size, (size_t)WS_END); grid = -1; return; }
        int dev = 0, cus = 0, per_cu = 0;
        if (hipGetDevice(&dev) != hipSuccess || hipDeviceGetAttribute(&cus, hipDeviceAttributeMultiprocessorCount, dev) != hipSuccess) { grid = -1; return; }
        if (hipFuncSetAttribute((const void*)mk_fwd, hipFuncAttributeMaxDynamicSharedMemorySize, LDS_BYTES) != hipSuccess) { fprintf(stderr, "kernel_launch: hipFuncSetAttribute failed\n"); grid = -1; return; }
        if (hipOccupancyMaxActiveBlocksPerMultiprocessor(&per_cu, (const void*)mk_fwd, 512, LDS_BYTES) != hipSuccess || per_cu < 1) fprintf(stderr, "kernel_launch: occupancy query reports %d\n", per_cu);
        (void)hipGetLastError();
        grid = cus;
    }
    if (grid < 0) return;
    if (hipMemsetAsync((char*)d_ws + WS_CTL, 0, CTL_BYTES, stream) != hipSuccess) { fprintf(stderr, "kernel_launch: memset failed\n"); return; }
    MKArgs a; memset(&a, 0, sizeof a);
    for (int i = 0; i < 35; ++i) a.in[i] = (const float*)d_in[i];
    a.out = (float*)d_out; a.ws = (unsigned char*)d_ws;
    const int nl = MK_CUT ? N_PHASES : 1;
    for (int li = 0; li < nl; ++li) {
        a.ph_lo = MK_CUT ? li : 0; a.ph_hi = MK_CUT ? li + 1 : N_PHASES; a.li = li;
        hipLaunchKernelGGL(mk_fwd, dim3(grid), dim3(512), LDS_BYTES, stream, a);
        const hipError_t le = hipPeekAtLastError();
        if (le != hipSuccess) { fprintf(stderr, "kernel_launch: launch %d failed: %s\n", li, hipGetErrorName(le)); break; }
    }
}
```
